# Optimizing an MI355X kernel written in HIP

```python
import jax
import jax.numpy as jnp
from jax import lax
import numpy as np

D_MODEL = 1024
BATCH = 8
SEQ = 2048
DEPTH = 1

PLE_DIM = 256
SGU_WIDTH = D_MODEL
SGU_CHUNK = 128
SGU_GROUPS = 8
SGU_GROUP_WIDTH = SGU_WIDTH // SGU_GROUPS
V_DIM = 128
MLA_HEADS = D_MODEL // V_DIM
QK_NOPE = 128
QK_ROPE = 64
QK_DIM = QK_NOPE + QK_ROPE
Q_LORA = 384
KV_LORA = 256
ROPE_THETA = 10000.0
Q_BLOCK = 128
N_EXPERTS = 64
N_GROUPS = 8
EXPERTS_PER_GROUP = N_EXPERTS // N_GROUPS
TOPK_GROUPS = 4
TOP_K = 8
EXPERT_FF = 256
SHARED_FF = 256
ROUTED_SCALE = 2.5

NORM_EPS = 1e-6
LN_EPS = 1e-5
NEG_INF = -1e30

kernel_name = 'hybrid_sgu_mla_moe_block'


def _in_sizes():
    return [SGU_WIDTH, SGU_WIDTH, Q_LORA, KV_LORA, QK_ROPE, SGU_WIDTH, MLA_HEADS * V_DIM]


def _in_offsets():
    offs, acc = [], 0
    for s in _in_sizes()[:-1]:
        acc += s
        offs.append(acc)
    return offs


def rms_norm(x, g):
    xf = x.astype(jnp.float32)
    y = xf * lax.rsqrt(jnp.mean(xf * xf, axis=-1, keepdims=True) + NORM_EPS)
    return (y * g.astype(jnp.float32)).astype(x.dtype)


def layer_norm(x, g, b):
    xf = x.astype(jnp.float32)
    mu = jnp.mean(xf, axis=-1, keepdims=True)
    xc = xf - mu
    var = jnp.mean(xc * xc, axis=-1, keepdims=True)
    y = xc * lax.rsqrt(var + LN_EPS) * g.astype(jnp.float32) + b.astype(jnp.float32)
    return y.astype(x.dtype)


def rope_tables(positions, dtype):
    half = QK_ROPE // 2
    inv_freq = 1.0 / (ROPE_THETA ** (jnp.arange(half, dtype=jnp.float32) * (2.0 / QK_ROPE)))
    ang = positions.astype(jnp.float32)[..., None] * inv_freq
    return jnp.cos(ang)[:, :, None, :].astype(dtype), jnp.sin(ang)[:, :, None, :].astype(dtype)


def apply_rope(x, cos, sin):
    half = x.shape[-1] // 2
    x1, x2 = x[..., :half], x[..., half:]
    return jnp.concatenate([x1 * cos - x2 * sin, x2 * cos + x1 * sin], axis=-1)


def spatial_gating(u, v, ln_g, ln_b, w_sp, b_sp):
    B, S, _ = u.shape
    v = layer_norm(v, ln_g, ln_b)
    causal = jnp.tril(jnp.ones((SGU_CHUNK, SGU_CHUNK), dtype=bool))
    w = jnp.where(causal[None], w_sp, 0.0).astype(v.dtype)
    vc = v.reshape(B, S // SGU_CHUNK, SGU_CHUNK, SGU_GROUPS, SGU_GROUP_WIDTH)
    mixed = jnp.einsum('gij,bnjgc->bnigc', w, vc) + b_sp.T[:, :, None].astype(v.dtype)
    return u * mixed.reshape(B, S, SGU_WIDTH)


def mla_attention(q_lat, kv_lat, k_rope, cos, sin, g_qa, w_qb, g_kva, w_kvb,
                  g_q_nope, g_k_nope, g_q_rope, g_k_rope):
    B, S, _ = q_lat.shape
    H = MLA_HEADS
    q = (rms_norm(q_lat, g_qa) @ w_qb).reshape(B, S, H, QK_DIM)
    kv = (rms_norm(kv_lat, g_kva) @ w_kvb).reshape(B, S, H, QK_NOPE + V_DIM)
    q_nope = rms_norm(q[..., :QK_NOPE], g_q_nope)
    q_pe = apply_rope(rms_norm(q[..., QK_NOPE:], g_q_rope), cos, sin)
    k_nope = rms_norm(kv[..., :QK_NOPE], g_k_nope)
    v = kv[..., QK_NOPE:]
    k_pe = apply_rope(rms_norm(k_rope, g_k_rope)[:, :, None, :], cos, sin)
    k = jnp.concatenate([k_nope, jnp.broadcast_to(k_pe, (B, S, H, QK_ROPE))], axis=-1)
    qh = jnp.concatenate([q_nope, q_pe], axis=-1) * (QK_DIM ** -0.5)
    n_blk = S // Q_BLOCK
    q_blocks = qh.reshape(B, n_blk, Q_BLOCK, H, QK_DIM).transpose(1, 0, 3, 2, 4)
    kh = k.transpose(0, 2, 1, 3)
    vh = v.transpose(0, 2, 1, 3)
    kpos = jnp.arange(S)

    def block(args):
        q_i, i = args
        s = jnp.einsum('bhqd,bhkd->bhqk', q_i, kh).astype(jnp.float32)
        qpos = i * Q_BLOCK + jnp.arange(Q_BLOCK)
        s = jnp.where(kpos[None, :] <= qpos[:, None], s, NEG_INF)
        prob = jax.nn.softmax(s, axis=-1).astype(vh.dtype)
        return jnp.einsum('bhqk,bhkd->bhqd', prob, vh)

    o = lax.map(block, (q_blocks, jnp.arange(n_blk)))
    return o.transpose(1, 0, 3, 2, 4).reshape(B, S, H * V_DIM)


def moe(h, w_router, b_router, w_gate, w_up, w_down, w_sh_gate, w_sh_up, w_sh_down):
    B, S, D = h.shape
    t = h.reshape(B * S, D)
    scores = jax.nn.sigmoid((t @ w_router).astype(jnp.float32))
    sel = scores + b_router.astype(jnp.float32)
    grp = sel.reshape(-1, N_GROUPS, EXPERTS_PER_GROUP)
    group_score = lax.top_k(grp, 2)[0].sum(-1)
    _, gidx = lax.top_k(group_score, TOPK_GROUPS)
    gmask = jax.nn.one_hot(gidx, N_GROUPS, dtype=jnp.float32).sum(1) > 0
    emask = jnp.repeat(gmask, EXPERTS_PER_GROUP, axis=1)
    _, eidx = lax.top_k(jnp.where(emask, sel, -jnp.inf), TOP_K)
    w = jnp.take_along_axis(scores, eidx, axis=1)
    w = w / jnp.sum(w, axis=-1, keepdims=True) * ROUTED_SCALE
    combine = (jax.nn.one_hot(eidx, N_EXPERTS, dtype=jnp.float32) * w[..., None]).sum(1).astype(t.dtype)
    y = (jax.nn.silu(t @ w_sh_gate) * (t @ w_sh_up)) @ w_sh_down
    for g in range(N_GROUPS):
        sl = slice(g * EXPERTS_PER_GROUP, (g + 1) * EXPERTS_PER_GROUP)
        a = jax.nn.silu(jnp.einsum('td,edf->tef', t, w_gate[sl])) * jnp.einsum('td,edf->tef', t, w_up[sl])
        y = y + jnp.einsum('tef,efd->td', a * combine[:, sl, None], w_down[sl])
    return y.reshape(B, S, D)


def setup_inputs(seed: int = 0) -> dict:
    key = jax.random.key(seed)
    ks = iter(jax.random.split(key, 48))
    f32 = jnp.float32
    L = DEPTH

    def nrm(shape, fan_in):
        return jax.random.normal(next(ks), shape, f32) * (fan_in ** -0.5)

    def gain(shape):
        return 1.0 + 0.05 * jax.random.normal(next(ks), shape, f32)

    def small(shape, s):
        return s * jax.random.normal(next(ks), shape, f32)

    in_width = sum(_in_sizes())
    x = jax.random.normal(next(ks), (BATCH, SEQ, D_MODEL), f32)
    p = jax.random.normal(next(ks), (L, BATCH, SEQ, PLE_DIM), f32)
    offsets = jax.random.randint(next(ks), (BATCH, 1), 0, 4096, dtype=jnp.int32)
    positions = offsets + jnp.arange(SEQ, dtype=jnp.int32)[None, :]
    return {
        'x': x,
        'p': p,
        'positions': positions,
        'g_mix': gain((L, D_MODEL)),
        'w_in': nrm((L, D_MODEL, in_width), D_MODEL),
        'sgu_ln_g': gain((L, SGU_WIDTH)),
        'sgu_ln_b': small((L, SGU_WIDTH), 0.02),
        'sgu_w': nrm((L, SGU_GROUPS, SGU_CHUNK, SGU_CHUNK), SGU_CHUNK),
        'sgu_b': small((L, SGU_GROUPS, SGU_CHUNK), 0.02),
        'mla_g_qa': gain((L, Q_LORA)),
        'mla_w_qb': nrm((L, Q_LORA, MLA_HEADS * QK_DIM), Q_LORA),
        'mla_g_kva': gain((L, KV_LORA)),
        'mla_w_kvb': nrm((L, KV_LORA, MLA_HEADS * (QK_NOPE + V_DIM)), KV_LORA),
        'qk_g_q_nope': gain((L, QK_NOPE)),
        'qk_g_k_nope': gain((L, QK_NOPE)),
        'qk_g_q_rope': gain((L, QK_ROPE)),
        'qk_g_k_rope': gain((L, QK_ROPE)),
        'w_o': nrm((L, D_MODEL, D_MODEL), D_MODEL),
        'g_ffn': gain((L, D_MODEL)),
        'w_router': nrm((L, D_MODEL, N_EXPERTS), D_MODEL),
        'b_router': small((L, N_EXPERTS), 0.01),
        'w_exp_gate': nrm((L, N_EXPERTS, D_MODEL, EXPERT_FF), D_MODEL),
        'w_exp_up': nrm((L, N_EXPERTS, D_MODEL, EXPERT_FF), D_MODEL),
        'w_exp_down': nrm((L, N_EXPERTS, EXPERT_FF, D_MODEL), EXPERT_FF),
        'w_sh_gate': nrm((L, D_MODEL, SHARED_FF), D_MODEL),
        'w_sh_up': nrm((L, D_MODEL, SHARED_FF), D_MODEL),
        'w_sh_down': nrm((L, SHARED_FF, D_MODEL), SHARED_FF),
        'g_ple_in': gain((L, D_MODEL)),
        'w_ple_gate': nrm((L, D_MODEL, D_MODEL), D_MODEL),
        'w_ple_proj': nrm((L, PLE_DIM, D_MODEL), PLE_DIM),
        'g_ple_out': gain((L, D_MODEL)),
    }


def reference(x, p, positions, g_mix, w_in, sgu_ln_g, sgu_ln_b, sgu_w, sgu_b,
              mla_g_qa, mla_w_qb, mla_g_kva, mla_w_kvb,
              qk_g_q_nope, qk_g_k_nope, qk_g_q_rope, qk_g_k_rope,
              w_o, g_ffn, w_router, b_router, w_exp_gate, w_exp_up, w_exp_down,
              w_sh_gate, w_sh_up, w_sh_down, g_ple_in, w_ple_gate, w_ple_proj, g_ple_out):
    cos, sin = rope_tables(positions, x.dtype)
    offs = _in_offsets()
    for l in range(DEPTH):
        h = rms_norm(x, g_mix[l])
        z = h @ w_in[l]
        u, v, q_lat, kv_lat, k_rope, gate_a, gate_b = jnp.split(z, offs, axis=-1)
        y_a = spatial_gating(jax.nn.gelu(u), jax.nn.gelu(v), sgu_ln_g[l], sgu_ln_b[l], sgu_w[l], sgu_b[l])
        y_b = mla_attention(q_lat, kv_lat, k_rope, cos, sin, mla_g_qa[l], mla_w_qb[l],
                            mla_g_kva[l], mla_w_kvb[l], qk_g_q_nope[l], qk_g_k_nope[l],
                            qk_g_q_rope[l], qk_g_k_rope[l])
        merged = jax.nn.sigmoid(gate_a) * y_a + jax.nn.sigmoid(gate_b) * y_b
        x = x + merged @ w_o[l]
        x = x + moe(rms_norm(x, g_ffn[l]), w_router[l], b_router[l], w_exp_gate[l], w_exp_up[l],
                    w_exp_down[l], w_sh_gate[l], w_sh_up[l], w_sh_down[l])
        ple_gate = jax.nn.sigmoid(rms_norm(x, g_ple_in[l]) @ w_ple_gate[l])
        x = x + ple_gate * rms_norm(p[l] @ w_ple_proj[l], g_ple_out[l])
    return x
```

```cpp
#include <hip/hip_runtime.h>
#include <hip/hip_bf16.h>
#include <cstdio>
#include <cstdint>

#define LAS __attribute__((address_space(3)))
#define GAS __attribute__((address_space(1)))
typedef unsigned short bf16_t;
typedef short bf16x8 __attribute__((ext_vector_type(8)));
typedef short s16x4 __attribute__((ext_vector_type(4)));
typedef float f32x4 __attribute__((ext_vector_type(4)));
typedef float f32x2 __attribute__((ext_vector_type(2)));
typedef float f32x16 __attribute__((ext_vector_type(16)));
typedef unsigned u32x4 __attribute__((ext_vector_type(4)));
typedef unsigned u32x2 __attribute__((ext_vector_type(2)));

constexpr int T_ = 16384, DM = 1024, NB = 8, SEQ = 2048, NH = 8;
constexpr int NZ = 4864;
constexpr int QLAT = 384, KVLAT = 256, ROPE = 64, LATW = 768;
constexpr int QW = 1536, KVW = 2048;
constexpr int NEXP = 64, EFF = 256, NLIST = 65;
constexpr int PLE = 256;
constexpr float NORM_EPS = 1e-6f, LN_EPS = 1e-5f;
constexpr int NTHREADS = 512, NWAVES = 8;

constexpr size_t MiB = 1u << 20, KiB = 1u << 10;
constexpr size_t WS_CTL = 0, CTL_BYTES = 1 * MiB;
constexpr size_t WS_RSTD0 = 1 * MiB, WS_LNMU = WS_RSTD0 + 64 * KiB, WS_LNRS = WS_LNMU + 64 * KiB, WS_RSTD2 = WS_LNRS + 64 * KiB,
                 WS_RSTD3 = WS_RSTD2 + 64 * KiB, WS_RSTDPE = WS_RSTD3 + 64 * KiB;
constexpr size_t WS_COS = 2 * MiB, WS_SIN = 4 * MiB;
constexpr size_t WS_WIN = 6 * MiB;
constexpr size_t WS_WQB = WS_WIN + (size_t)NZ * DM * 2;
constexpr size_t WS_WKVB = WS_WQB + (size_t)QW * QLAT * 2;
constexpr size_t WS_WO = WS_WKVB + (size_t)KVW * KVLAT * 2;
constexpr size_t WS_SGUW = WS_WO + (size_t)DM * DM * 2;
constexpr size_t WS_WSHGU = WS_SGUW + (size_t)8 * 128 * 128 * 2;
constexpr size_t WS_WSHD = WS_WSHGU + (size_t)512 * DM * 2;
constexpr size_t WS_WPG = WS_WSHD + (size_t)DM * EFF * 2;
constexpr size_t WS_WPP = WS_WPG + (size_t)DM * DM * 2;
constexpr size_t WS_WSMALL_END = WS_WPP + (size_t)DM * PLE * 2;
static_assert(WS_WSMALL_END <= 26 * MiB, "small weights");
constexpr size_t WS_TOKE = 26 * MiB, WS_TOKW = WS_TOKE + 512 * KiB;
constexpr int LIST_CAP = 164096;
constexpr size_t WS_ROWID = 27 * MiB, WS_RDEST = 28 * MiB, WS_RW = 29 * MiB, WS_RS = 30 * MiB, WS_TILEL = 31 * MiB;
constexpr size_t S0 = 32 * MiB, S1 = 64 * MiB, S2 = 96 * MiB, S3 = 128 * MiB, S4 = 160 * MiB, S5 = 192 * MiB, S6 = 224 * MiB, S7 = 256 * MiB;
constexpr size_t WS_XB = S0, WS_YAG = S0, WS_HSH = S0;
constexpr size_t WS_GU = S1, WS_GV = S2, WS_SA = S3, WS_LAT = S4, WS_SB = S7;
constexpr size_t WS_QN = S6, WS_KVN = S6 + 12 * MiB, WS_KPE = S6 + 20 * MiB;
constexpr size_t WS_QRAW = S1, WS_KVRAW = S1 + 48 * MiB;
constexpr size_t WS_X1B = S1;
constexpr size_t WS_WGU = S3;
constexpr size_t WS_WD = S5;
constexpr size_t WS_ACT = S6;
constexpr size_t WS_YBUF = 47 * MiB;
constexpr size_t WS_X2B = S6, WS_PERAW = S7;
constexpr size_t WS_PB = 296 * MiB;
constexpr size_t WS_END = 304 * MiB;
static_assert(WS_KVRAW + (size_t)T_ * KVW * 2 <= S5 && WS_YBUF + (size_t)(T_ * 9 + 1) * 512 * 2 <= S5 && WS_HSH + (size_t)T_ * EFF * 2 <= WS_YBUF && WS_ACT + (size_t)147456 * 512 <= WS_PB, "map");
constexpr int CW_CNT = 64;
constexpr int CW_FILL = 192;
constexpr int CW_BAR = 4096;

__device__ __forceinline__ unsigned f2bf(float f) { unsigned u = __builtin_bit_cast(unsigned, f); return (u + 0x7fffu + ((u >> 16) & 1u)) >> 16; }
__device__ __forceinline__ float bf2f(unsigned h) { return __builtin_bit_cast(float, h << 16); }
__device__ __forceinline__ unsigned pk2(float lo, float hi) { unsigned r; asm volatile("v_cvt_pk_bf16_f32 %0, %1, %2" : "=v"(r) : "v"(lo), "v"(hi)); return r; }
__device__ __forceinline__ float bflo(unsigned w) { return __builtin_bit_cast(float, w << 16); }
__device__ __forceinline__ float bfhi(unsigned w) { return __builtin_bit_cast(float, w & 0xffff0000u); }
__device__ __forceinline__ float wave_sum(float v) {
#pragma unroll
    for (int o = 1; o < 64; o <<= 1) v += __shfl_xor(v, o);
    return v;
}
__device__ __forceinline__ float fast_sigmoid(float x) { return __builtin_amdgcn_rcpf(1.0f + __builtin_amdgcn_exp2f(-1.4426950408889634f * x)); }
__device__ __forceinline__ float gelu_tanh(float x) {
    const float u = 1.5957691216057308f * (x + 0.044715f * x * x * x);
    return x * fast_sigmoid(u);
}
__device__ __forceinline__ float silu(float x) { return x * fast_sigmoid(x); }

struct Params {
    const float* in[31];
    float* out;
    unsigned char* ws;
};
enum { I_X = 0, I_P, I_POS, I_GMIX, I_WIN, I_LNG, I_LNB, I_SGUW, I_SGUB, I_GQA, I_WQB, I_GKVA, I_WKVB, I_GQN, I_GKN, I_GQR, I_GKR, I_WO, I_GFFN, I_WR, I_BR,
       I_WEG, I_WEU, I_WED, I_WSG, I_WSU, I_WSD, I_GPI, I_WPG, I_WPP, I_GPO };
namespace pg8 {
constexpr int BM = 256, BK = 64, HALF = 128, HTB = HALF * BK * 2  , STAGE_BYTES = 8 * HTB;

__device__ __forceinline__ int lds_byte(int r, int c) { const int st = (r >> 4) * 2 + (c >> 5), rr = r & 15, cc = c & 31, ob = rr * 64 + cc * 2; return st * 1024 + (ob ^ (((ob >> 9) & 1) << 5)); }
__device__ __forceinline__ void stage_rc(int b, int& R, int& C) { const int st = b / 1024, sb = b % 1024, swz = sb ^ (((sb >> 9) & 1) << 5); R = (st >> 1) * 16 + swz / 64; C = (st & 1) * 32 + (swz % 64) / 2; }
__device__ __forceinline__ int perm32(int rho) { const int n = rho >> 4, i = rho & 15; return 8 * (i >> 2) + 4 * n + (i & 3); }

struct Unit { const char* A; const char* B; int pm, pn; };
struct Shape { int ldaB, ldbB, nt; const char* Abase; };

template <class Epi, class Sched, bool GATHER>
__device__ __forceinline__ void gemm_phase(LAS unsigned char* lds, const Shape sh, const Sched& S, const Epi& E) {
    const int tid = threadIdx.x, wid = __builtin_amdgcn_readfirstlane(tid >> 6), lane = tid & 63, wr = wid >> 2, wc = wid & 3, fr = lane & 15, fq = lane >> 4;
    const int nt = sh.nt;
    int Rr[2], Cc[2];
    unsigned voffB[2], voffA[2];
#pragma unroll
    for (int i = 0; i < 2; ++i) { stage_rc(tid * 16 + i * 8192, Rr[i], Cc[i]); const int Rb = Epi::PERM ? ((Rr[i] & ~31) + perm32(Rr[i] & 31)) : Rr[i];
        voffB[i] = (unsigned)(Rb * sh.ldbB + Cc[i] * 2); voffA[i] = (unsigned)(Rr[i] * sh.ldaB + Cc[i] * 2); }
    const size_t kstep = (size_t)(BK * 2);
    const size_t hstepB = (size_t)HALF * sh.ldbB, hstepA = (size_t)HALF * sh.ldaB;
    const unsigned ldsw = (unsigned)wid * 1024u;
    const int aoff = lds_byte(wr * 64 + fr, fq * 8), boff = lds_byte(wc * 32 + fr, fq * 8);
#define PG8_SA(b, h) (((b) * 2 + (h)) * HTB)
#define PG8_SB(b, h) ((4 + (b) * 2 + (h)) * HTB)
#define PG8_STAGE(bufoff, gbase, voff) do { _Pragma("unroll") for (int _i = 0; _i < 2; ++_i) \
        __builtin_amdgcn_global_load_lds((const unsigned*)((const char*)(gbase) + (voff)[_i]), (LAS unsigned*)(lds + (bufoff) + ldsw + _i * 8192), 16, 0, 0); } while (0)
#define PG8_STAGE_A(bufoff, gbase, h, oarr) do { if (GATHER) { PG8_STAGE(bufoff, gbase, (oarr)[h]); } else { PG8_STAGE(bufoff, (gbase) + (h) * hstepA, voffA); } } while (0)
#define PG8_LDA(dst, b, h) do { _Pragma("unroll") for (int m = 0; m < 4; ++m) _Pragma("unroll") for (int k = 0; k < 2; ++k) dst[m][k] = *(const LAS bf16x8*)(lds + PG8_SA(b, h) + aoff + m * 2048 + k * 1024); } while (0)
#define PG8_LDB(dst, b, h) do { _Pragma("unroll") for (int n = 0; n < 2; ++n) _Pragma("unroll") for (int k = 0; k < 2; ++k) dst[n][k] = *(const LAS bf16x8*)(lds + PG8_SB(b, h) + boff + n * 2048 + k * 1024); } while (0)
#define PG8_MMA(ai, bj, At, Bt) do { __builtin_amdgcn_s_setprio(1); _Pragma("unroll") for (int m = 0; m < 4; ++m) _Pragma("unroll") for (int n = 0; n < 2; ++n) _Pragma("unroll") for (int k = 0; k < 2; ++k) \
        acc[ai][bj][m][n] = __builtin_amdgcn_mfma_f32_16x16x32_bf16(Bt[n][k], At[m][k], acc[ai][bj][m][n], 0, 0, 0); __builtin_amdgcn_s_setprio(0); } while (0)
#define PG8_WAIT_V(n) asm volatile("s_waitcnt vmcnt(" #n ")" ::: "memory")
#define PG8_WAIT_L(n) asm volatile("s_waitcnt lgkmcnt(" #n ")" ::: "memory")
#define PG8_BAR __builtin_amdgcn_s_barrier()
#define PG8_SCHED __builtin_amdgcn_sched_barrier(0)
#define PG8_AOFF(o, u) do { _Pragma("unroll") for (int _h = 0; _h < 2; ++_h) _Pragma("unroll") for (int _i = 0; _i < 2; ++_i) { \
        if (GATHER) o[_h][_i] = (unsigned)(((const int*)(u).A)[_h * HALF + Rr[_i]]) * (unsigned)sh.ldaB + (unsigned)(Cc[_i] * 2); \
        else o[_h][_i] = 0u; } } while (0)
    Unit cur, nxt; int ui = 0;
    if (!S.next(0, cur)) return;
    f32x4 acc[2][2][4][2];
#pragma unroll
    for (int a = 0; a < 2; ++a)
#pragma unroll
        for (int b = 0; b < 2; ++b)
#pragma unroll
            for (int m = 0; m < 4; ++m)
#pragma unroll
                for (int n = 0; n < 2; ++n) acc[a][b][m][n] = (f32x4){0.f, 0.f, 0.f, 0.f};
    bf16x8 At[4][2], B0[2][2], B1[2][2];
    unsigned oC[2][2], oN[2][2];
    PG8_AOFF(oC, cur);
    const char* cA = GATHER ? sh.Abase : cur.A; const char* cB = cur.B;
    PG8_STAGE(PG8_SB(0, 0), cB, voffB); PG8_STAGE(PG8_SB(0, 1), cB + hstepB, voffB); PG8_STAGE_A(PG8_SA(0, 0), cA, 0, oC); PG8_STAGE_A(PG8_SA(0, 1), cA, 1, oC);
    if (wr == 1) PG8_BAR;
    PG8_WAIT_V(2); PG8_BAR;
    PG8_STAGE(PG8_SB(1, 0), cB + kstep, voffB); PG8_STAGE_A(PG8_SA(1, 0), cA + kstep, 0, oC); PG8_STAGE(PG8_SB(1, 1), cB + hstepB + kstep, voffB);
    PG8_WAIT_V(6); PG8_BAR;
    for (;;) {
        const bool has_next = S.next(ui + 1, nxt);
        const char* nA = GATHER ? cA : (has_next ? nxt.A : cA); const char* nB = has_next ? nxt.B : cB;
        if (GATHER) { if (has_next) { PG8_AOFF(oN, nxt); } else {
#pragma unroll
            for (int h = 0; h < 2; ++h)
#pragma unroll
                for (int i = 0; i < 2; ++i) oN[h][i] = oC[h][i]; } }
        for (int t = 0; t < nt; t += 2) {
            const bool last = (t == nt - 2);
            const char* a1 = cA + (size_t)(t + 1) * kstep;
            const char* a2 = last ? nA : cA + (size_t)(t + 2) * kstep; const char* b2 = last ? nB : cB + (size_t)(t + 2) * kstep;
            const char* a3 = a2 + kstep; const char* b3 = b2 + kstep;
            unsigned o2[2][2];
#pragma unroll
            for (int h = 0; h < 2; ++h)
#pragma unroll
                for (int i = 0; i < 2; ++i) o2[h][i] = (GATHER && last) ? oN[h][i] : oC[h][i];
            PG8_LDB(B0, 0, 0); PG8_LDB(B1, 0, 1); PG8_SCHED; PG8_LDA(At, 0, 0); PG8_STAGE_A(PG8_SA(1, 1), a1, 1, oC);
            PG8_WAIT_V(8); PG8_WAIT_L(0); PG8_BAR; PG8_MMA(0, 0, At, B0); PG8_MMA(0, 1, At, B1); PG8_BAR; PG8_SCHED;
            PG8_LDA(At, 0, 1); PG8_STAGE(PG8_SB(0, 0), b2, voffB); PG8_STAGE(PG8_SB(0, 1), b2 + hstepB, voffB); PG8_STAGE_A(PG8_SA(0, 0), a2, 0, o2);
            PG8_WAIT_V(8); PG8_WAIT_L(0); PG8_BAR; PG8_MMA(1, 0, At, B0); PG8_MMA(1, 1, At, B1); PG8_BAR; PG8_SCHED;
            PG8_LDB(B0, 1, 0); PG8_LDB(B1, 1, 1); PG8_SCHED; PG8_LDA(At, 1, 0); PG8_STAGE_A(PG8_SA(0, 1), a2, 1, o2);
            PG8_WAIT_V(8); PG8_WAIT_L(0); PG8_BAR; PG8_MMA(0, 0, At, B0); PG8_MMA(0, 1, At, B1); PG8_BAR; PG8_SCHED;
            PG8_LDA(At, 1, 1); PG8_STAGE(PG8_SB(1, 0), b3, voffB); PG8_STAGE(PG8_SB(1, 1), b3 + hstepB, voffB); PG8_STAGE_A(PG8_SA(1, 0), a3, 0, o2);
            PG8_WAIT_V(8); PG8_WAIT_L(0); PG8_BAR; PG8_MMA(1, 0, At, B0); PG8_MMA(1, 1, At, B1); PG8_BAR; PG8_SCHED;
        }
        if (wr == 0) PG8_BAR;
        E(acc, cur, wr, wc, fr, fq);
        if (!has_next) break;
#pragma unroll
        for (int a = 0; a < 2; ++a)
#pragma unroll
            for (int b = 0; b < 2; ++b)
#pragma unroll
                for (int m = 0; m < 4; ++m)
#pragma unroll
                    for (int n = 0; n < 2; ++n) acc[a][b][m][n] = (f32x4){0.f, 0.f, 0.f, 0.f};
        cur = nxt; cA = nA; cB = nB; ++ui;
        if (GATHER) {
#pragma unroll
            for (int h = 0; h < 2; ++h)
#pragma unroll
                for (int i = 0; i < 2; ++i) oC[h][i] = oN[h][i]; }
        if (wr == 1) PG8_BAR;
    }
    PG8_WAIT_V(0);
    PG8_BAR;
#undef PG8_SA
#undef PG8_SB
#undef PG8_STAGE
#undef PG8_STAGE_A
#undef PG8_LDA
#undef PG8_LDB
#undef PG8_MMA
#undef PG8_WAIT_V
#undef PG8_WAIT_L
#undef PG8_BAR
#undef PG8_SCHED
#undef PG8_AOFF
}
}
__device__ __forceinline__ int vcu_of(int bx, int G) { return (G % 8 == 0) ? (bx % 8) * (G / 8) + bx / 8 : bx; }

struct DenseSched {
    const char* A; const char* B; int nM, nN, G, c, ldaB, ldbB;
    __device__ __forceinline__ bool next(int i, pg8::Unit& u) const {
        const int L = i * G + c; if (L >= nM * nN) return false;
        const int nig = 8 * nN, gid = L / nig, fm = gid * 8, gsz = (nM - fm) < 8 ? (nM - fm) : 8;
        u.pm = fm + ((L % nig) % gsz); u.pn = (L % nig) / gsz;
        u.A = A + (size_t)u.pm * 256 * ldaB; u.B = B + (size_t)u.pn * 256 * ldbB; return true;
    }
};

__device__ __forceinline__ void store8bf(bf16_t* p, f32x4 a, f32x4 b) { u32x4 w; w.x = pk2(a[0], a[1]); w.y = pk2(a[2], a[3]); w.z = pk2(b[0], b[1]); w.w = pk2(b[2], b[3]); *(u32x4*)p = w; }

struct EpiG1 {
    static constexpr bool PERM = true;
    const float* rstd; bf16_t* gu; bf16_t* gv; bf16_t* sa; bf16_t* sb; bf16_t* lat;
    __device__ __forceinline__ void operator()(const f32x4 (&acc)[2][2][4][2], const pg8::Unit& u, int wr, int wc, int fr, int fq) const {
        const int pn = u.pn; const int seg = pn >> 2;
        bf16_t* base; int ldc, colt;
        if (seg == 0) { base = gu; ldc = DM; colt = pn * 256; } else if (seg == 1) { base = gv; ldc = DM; colt = (pn - 4) * 256; }
        else if (seg == 2) { base = sa; ldc = DM; colt = (pn - 8) * 256; } else if (seg == 3) { base = sb; ldc = DM; colt = (pn - 12) * 256; }
        else { base = lat; ldc = LATW; colt = (pn - 16) * 256; }
        const int act = seg < 2 ? 1 : (seg < 4 ? 2 : 0);
        const int row0 = u.pm * 256 + wr * 64 + fr, col0 = colt + wc * 32 + 8 * fq;
#pragma unroll
        for (int ai = 0; ai < 2; ++ai)
#pragma unroll
            for (int m = 0; m < 4; ++m) { const int row = row0 + ai * 128 + m * 16; const float rs = rstd[row]; bf16_t* rowp = base + (size_t)row * ldc + col0;
#pragma unroll
                for (int bj = 0; bj < 2; ++bj) { f32x4 v0 = acc[ai][bj][m][0] * rs, v1 = acc[ai][bj][m][1] * rs;
                    if (act == 1) {
#pragma unroll
                        for (int j = 0; j < 4; ++j) { v0[j] = gelu_tanh(v0[j]); v1[j] = gelu_tanh(v1[j]); } }
                    else if (act == 2) {
#pragma unroll
                        for (int j = 0; j < 4; ++j) { v0[j] = fast_sigmoid(v0[j]); v1[j] = fast_sigmoid(v1[j]); } }
                    store8bf(rowp + bj * 128, v0, v1); } }
    }
};
struct EpiBf16 {
    static constexpr bool PERM = true;
    bf16_t* O; int ldc;
    __device__ __forceinline__ void operator()(const f32x4 (&acc)[2][2][4][2], const pg8::Unit& u, int wr, int wc, int fr, int fq) const {
        const int row0 = u.pm * 256 + wr * 64 + fr, col0 = u.pn * 256 + wc * 32 + 8 * fq;
#pragma unroll
        for (int ai = 0; ai < 2; ++ai)
#pragma unroll
            for (int m = 0; m < 4; ++m) { bf16_t* rowp = O + (size_t)(row0 + ai * 128 + m * 16) * ldc + col0;
#pragma unroll
                for (int bj = 0; bj < 2; ++bj) store8bf(rowp + bj * 128, acc[ai][bj][m][0], acc[ai][bj][m][1]); }
    }
};
struct EpiG4 {
    static constexpr bool PERM = false;
    const float* x; float* out; bf16_t* x1b;
    __device__ __forceinline__ void operator()(const f32x4 (&acc)[2][2][4][2], const pg8::Unit& u, int wr, int wc, int fr, int fq) const {
        const int row0 = u.pm * 256 + wr * 64 + fr, col0 = u.pn * 256 + wc * 32 + 4 * fq;
#pragma unroll
        for (int ai = 0; ai < 2; ++ai)
#pragma unroll
            for (int m = 0; m < 4; ++m) { const size_t off = (size_t)(row0 + ai * 128 + m * 16) * DM + col0;
#pragma unroll
                for (int bj = 0; bj < 2; ++bj)
#pragma unroll
                    for (int n = 0; n < 2; ++n) { const size_t o = off + bj * 128 + n * 16; const f32x4 v = *(const f32x4*)(x + o) + acc[ai][bj][m][n];
                        *(f32x4*)(out + o) = v; u32x2 w; w.x = pk2(v[0], v[1]); w.y = pk2(v[2], v[3]); *(u32x2*)(x1b + o) = w; } }
    }
};
struct EpiG5 {
    static constexpr bool PERM = false;
    float* out; const bf16_t* pe; const float* rstd3; const float* rstdpe; const float* gout;
    __device__ __forceinline__ void operator()(const f32x4 (&acc)[2][2][4][2], const pg8::Unit& u, int wr, int wc, int fr, int fq) const {
        const int row0 = u.pm * 256 + wr * 64 + fr, col0 = u.pn * 256 + wc * 32 + 4 * fq;
        f32x4 gv[2][2];
#pragma unroll
        for (int bj = 0; bj < 2; ++bj)
#pragma unroll
            for (int n = 0; n < 2; ++n) gv[bj][n] = *(const f32x4*)(gout + col0 + bj * 128 + n * 16);
#pragma unroll
        for (int ai = 0; ai < 2; ++ai)
#pragma unroll
            for (int m = 0; m < 4; ++m) { const int row = row0 + ai * 128 + m * 16; const size_t off = (size_t)row * DM + col0; const float r3 = rstd3[row], rp = rstdpe[row];
#pragma unroll
                for (int bj = 0; bj < 2; ++bj)
#pragma unroll
                    for (int n = 0; n < 2; ++n) { const size_t o = off + bj * 128 + n * 16; const u32x2 pw = *(const u32x2*)(pe + o); const f32x4 xv = *(const f32x4*)(out + o);
                        const f32x4 a = acc[ai][bj][m][n]; f32x4 r;
                        r[0] = xv[0] + fast_sigmoid(a[0] * r3) * (bflo(pw.x) * rp * gv[bj][n][0]);
                        r[1] = xv[1] + fast_sigmoid(a[1] * r3) * (bfhi(pw.x) * rp * gv[bj][n][1]);
                        r[2] = xv[2] + fast_sigmoid(a[2] * r3) * (bflo(pw.y) * rp * gv[bj][n][2]);
                        r[3] = xv[3] + fast_sigmoid(a[3] * r3) * (bfhi(pw.y) * rp * gv[bj][n][3]);
                        *(f32x4*)(out + o) = r; } }
    }
};

struct MoeGuSched {
    unsigned char* ws; int ntiles, G, c;
    __device__ __forceinline__ bool next(int i, pg8::Unit& u) const {
        const int L = i * G + c; if (L >= ntiles * 2) return false;
        const int rt = L >> 1, pn = L & 1, li = __builtin_amdgcn_readfirstlane(((const int*)(ws + WS_TILEL))[rt]);
        u.pm = rt; u.pn = pn | (li == 64 ? 256 : 0); u.A = (const char*)((const int*)(ws + WS_ROWID) + rt * 256);
        u.B = (const char*)(li == 64 ? ws + WS_WSHGU : ws + WS_WGU + (size_t)li * 512 * DM * 2) + (size_t)pn * 256 * DM * 2; return true;
    }
};
struct EpiGu {
    static constexpr bool PERM = true;
    unsigned char* ws; int off64;
    __device__ __forceinline__ void operator()(const f32x4 (&acc)[2][2][4][2], const pg8::Unit& u, int wr, int wc, int fr, int fq) const {
        bf16_t* base = (u.pn & 256) ? (bf16_t*)(ws + WS_HSH) - (size_t)off64 * EFF : (bf16_t*)(ws + WS_ACT);
        const float* rs = (const float*)(ws + WS_RS); const float* rw = (const float*)(ws + WS_RW);
        const int row0 = u.pm * 256 + wr * 64 + fr, col0 = (u.pn & 1) * 128 + wc * 32 + 8 * fq;
#pragma unroll
        for (int ai = 0; ai < 2; ++ai)
#pragma unroll
            for (int m = 0; m < 4; ++m) { const int idx = row0 + ai * 128 + m * 16; const float s = rs[idx], w = rw[idx];
                f32x4 g0 = acc[ai][0][m][0] * s, g1 = acc[ai][0][m][1] * s, u0 = acc[ai][1][m][0] * (s * w), u1 = acc[ai][1][m][1] * (s * w);
#pragma unroll
                for (int j = 0; j < 4; ++j) { g0[j] = silu(g0[j]) * u0[j]; g1[j] = silu(g1[j]) * u1[j]; }
                store8bf(base + (size_t)idx * EFF + col0, g0, g1); }
    }
};
struct MoeDownSched {
    unsigned char* ws; int ntiles, G, c, half, off64;
    __device__ __forceinline__ bool next(int i, pg8::Unit& u) const {
        const int L = i * G + c; if (L >= ntiles * 2) return false;
        const int rt = L >> 1, pn = half * 2 + (L & 1), li = __builtin_amdgcn_readfirstlane(((const int*)(ws + WS_TILEL))[rt]);
        u.pm = rt; u.pn = pn;
        u.A = (const char*)((li == 64) ? ws + WS_HSH + (size_t)(rt * 256 - off64) * EFF * 2 : ws + WS_ACT + (size_t)rt * 256 * EFF * 2);
        u.B = (const char*)(li == 64 ? ws + WS_WSHD : ws + WS_WD + (size_t)li * DM * EFF * 2) + (size_t)pn * 256 * EFF * 2; return true;
    }
};
struct EpiDown {
    static constexpr bool PERM = true;
    unsigned char* ws;
    __device__ __forceinline__ void operator()(const f32x4 (&acc)[2][2][4][2], const pg8::Unit& u, int wr, int wc, int fr, int fq) const {
        bf16_t* ybuf = (bf16_t*)(ws + WS_YBUF); const int* rdest = (const int*)(ws + WS_RDEST);
        const unsigned row0 = (unsigned)(u.pm * 256 + wr * 64 + fr), col0 = (unsigned)((u.pn & 1) * 256 + wc * 32 + 8 * fq);
#pragma unroll
        for (int ai = 0; ai < 2; ++ai)
#pragma unroll
            for (int m = 0; m < 4; ++m) { int d = rdest[row0 + ai * 128 + m * 16]; d = d < 0 ? T_ * 9 : d;
                const unsigned o = (unsigned)d * 512u + col0;
#pragma unroll
                for (int bj = 0; bj < 2; ++bj) store8bf(ybuf + o + bj * 128, acc[ai][bj][m][0], acc[ai][bj][m][1]);
                asm volatile("" ::: "memory"); }
    }
};
struct Ctx {
    LAS unsigned char* lds; unsigned char* ws; int tid, lane, wave, vcu, G;
};
#define LDS_WAIT() asm volatile("s_waitcnt lgkmcnt(0)" ::: "memory")

__device__ __forceinline__ void tr_item(const float* W, int ldw, int k0, int src0, bf16_t* WT, int ldt, int dst0, const float* gain, LAS float* scr, int lane) {
#pragma unroll 8
    for (int i = 0; i < 32; ++i) { const int kk = 2 * i + (lane >> 5); float v = W[(size_t)(k0 + kk) * ldw + src0 + (lane & 31)]; if (gain) v *= gain[k0 + kk]; scr[kk * 33 + (lane & 31)] = v; }
    LDS_WAIT(); asm volatile("" ::: "memory");
    const int c = lane & 7;
#pragma unroll
    for (int j = 0; j < 4; ++j) { const int n = (lane >> 3) + 8 * j; const LAS float* s = scr + (8 * c) * 33 + n;
        u32x4 o; o.x = pk2(s[0 * 33], s[1 * 33]); o.y = pk2(s[2 * 33], s[3 * 33]); o.z = pk2(s[4 * 33], s[5 * 33]); o.w = pk2(s[6 * 33], s[7 * 33]);
        *(u32x4*)(WT + (size_t)(dst0 + n) * ldt + k0 + 8 * c) = o; }
    LDS_WAIT(); asm volatile("" ::: "memory");
}
struct TrJob { const float* W; int ldw, K, ncols, src0; bf16_t* WT; int dst0; const float* gain; };
__device__ __forceinline__ int trjob_items(const TrJob& j) { return (j.K / 64) * (j.ncols / 32); }
__device__ __forceinline__ void trjob_run(const TrJob& j, int item, LAS float* scr, int lane) {
    const int nblk = j.ncols / 32, kb = item / nblk, nb = item % nblk;
    tr_item(j.W, j.ldw, kb * 64, j.src0 + nb * 32, j.WT, j.K, j.dst0 + nb * 32, j.gain, scr, lane);
}

__device__ __forceinline__ void phase_prep0(const Params& P, const Ctx& C) {
    LAS float* scr = (LAS float*)(C.lds + C.wave * 16384);
    unsigned char* ws = C.ws;
    const int gw = C.vcu * NWAVES + C.wave, NGW = C.G * NWAVES, lane = C.lane;
    constexpr int NJ = 17;
    TrJob J[NJ];
    bf16_t* WinT = (bf16_t*)(ws + WS_WIN);
    J[0] = {P.in[I_WIN], 4800, DM, 2048, 0, WinT, 0, P.in[I_GMIX]};
    J[1] = {P.in[I_WIN], 4800, DM, 2048, 2752, WinT, 2048, P.in[I_GMIX]};
    J[2] = {P.in[I_WIN], 4800, DM, 704, 2048, WinT, 4096, P.in[I_GMIX]};
    J[3] = {P.in[I_WQB], QW, QLAT, QW, 0, (bf16_t*)(ws + WS_WQB), 0, P.in[I_GQA]};
    J[4] = {P.in[I_WKVB], KVW, KVLAT, KVW, 0, (bf16_t*)(ws + WS_WKVB), 0, P.in[I_GKVA]};
    J[5] = {P.in[I_WO], DM, DM, DM, 0, (bf16_t*)(ws + WS_WO), 0, nullptr};
    bf16_t* Wshgu = (bf16_t*)(ws + WS_WSHGU);
    J[6] = {P.in[I_WSG], EFF, DM, 128, 0, Wshgu, 0, P.in[I_GFFN]};
    J[7] = {P.in[I_WSG], EFF, DM, 128, 128, Wshgu, 256, P.in[I_GFFN]};
    J[8] = {P.in[I_WSU], EFF, DM, 128, 0, Wshgu, 128, P.in[I_GFFN]};
    J[9] = {P.in[I_WSU], EFF, DM, 128, 128, Wshgu, 384, P.in[I_GFFN]};
    J[10] = {P.in[I_WSD], DM, EFF, DM, 0, (bf16_t*)(ws + WS_WSHD), 0, nullptr};
    J[11] = {P.in[I_WPG], DM, DM, DM, 0, (bf16_t*)(ws + WS_WPG), 0, P.in[I_GPI]};
    J[12] = {P.in[I_WPP], DM, PLE, DM, 0, (bf16_t*)(ws + WS_WPP), 0, nullptr};
    int total = 0;
#pragma unroll
    for (int j = 0; j < 13; ++j) total += trjob_items(J[j]);
    constexpr int ED_ITEMS = (EFF / 64) * (DM / 32);
    const int total2 = total + NEXP * ED_ITEMS;
    for (int it = gw; it < total2; it += NGW) {
        if (it < total) { int r = it;
#pragma unroll
            for (int j = 0; j < 13; ++j) { const int n = trjob_items(J[j]); if (r >= 0 && r < n) trjob_run(J[j], r, scr, lane); r -= n; }
        } else { const int r = it - total, e = r / ED_ITEMS, item = r % ED_ITEMS;
            TrJob j{P.in[I_WED] + (size_t)e * EFF * DM, DM, EFF, DM, 0, (bf16_t*)(ws + WS_WD) + (size_t)e * DM * EFF, 0, nullptr}; trjob_run(j, item, scr, lane); }
    }
    { const int gt = C.vcu * NTHREADS + C.tid, NT = C.G * NTHREADS; u32x4 z = {0u, 0u, 0u, 0u};
      for (int i = gt; i < 64 * DM / 8; i += NT) *(u32x4*)(WinT + (size_t)4800 * DM + (size_t)i * 8) = z;
      bf16_t* sw = (bf16_t*)(ws + WS_SGUW); const float* w = P.in[I_SGUW];
      for (int i = gt; i < 8 * 128 * 128; i += NT) { const int r = (i >> 7) & 127, c = i & 127; sw[i] = (bf16_t)f2bf(c <= r ? w[i] : 0.f); }
      bf16_t* pb = (bf16_t*)(ws + WS_PB); const float* p = P.in[I_P];
      for (int i = gt; i < T_ * PLE / 8; i += NT) { const f32x4 a = *(const f32x4*)(p + (size_t)i * 8), b = *(const f32x4*)(p + (size_t)i * 8 + 4); store8bf(pb + (size_t)i * 8, a, b); }
    }
    bf16_t* xb = (bf16_t*)(ws + WS_XB); float* rstd0 = (float*)(ws + WS_RSTD0); float* cs = (float*)(ws + WS_COS); float* sn = (float*)(ws + WS_SIN);
    const int* pos = (const int*)P.in[I_POS];
    for (int m = gw; m < T_; m += NGW) {
        const f32x4* xr = (const f32x4*)(P.in[I_X] + (size_t)m * DM) + lane;
        f32x4 v[4]; float s = 0.f;
#pragma unroll
        for (int j = 0; j < 4; ++j) { v[j] = xr[64 * j]; s += (v[j][0] * v[j][0] + v[j][1] * v[j][1]) + (v[j][2] * v[j][2] + v[j][3] * v[j][3]); }
        s = wave_sum(s);
        if (lane == 0) rstd0[m] = 1.0f / sqrtf(s * (1.0f / DM) + NORM_EPS);
        u32x2* o8 = (u32x2*)(xb + (size_t)m * DM) + lane;
#pragma unroll
        for (int j = 0; j < 4; ++j) { u32x2 w; w.x = pk2(v[j][0], v[j][1]); w.y = pk2(v[j][2], v[j][3]); o8[64 * j] = w; }
        if (lane < 32) { const float inv_freq = 1.0f / powf(10000.0f, (float)lane * (2.0f / ROPE)); const float ang = (float)pos[m] * inv_freq;
            cs[m * 32 + lane] = cosf(ang); sn[m * 32 + lane] = sinf(ang); }
    }
}
__device__ __forceinline__ void phase_prep_wgu(const Params& P, const Ctx& C) {
    LAS float* scr = (LAS float*)(C.lds + C.wave * 16384);
    const int gw = C.vcu * NWAVES + C.wave, NGW = C.G * NWAVES;
    constexpr int ITEMS = (DM / 64) * (128 / 32);
    const int total = NEXP * 4 * ITEMS;
    for (int it = gw; it < total; it += NGW) {
        const int e = it / (4 * ITEMS), r = it % (4 * ITEMS), q = r / ITEMS, item = r % ITEMS;
        const float* W = ((q & 1) ? P.in[I_WEU] : P.in[I_WEG]) + (size_t)e * DM * EFF;
        TrJob j{W, EFF, DM, 128, (q >> 1) * 128, (bf16_t*)(C.ws + WS_WGU) + (size_t)e * 512 * DM, q * 128, P.in[I_GFFN]};
        trjob_run(j, item, scr, C.lane);
    }
}

__device__ __forceinline__ void phase_latnorm(const Params& P, const Ctx& C) {
    unsigned char* ws = C.ws; const int gw = C.vcu * NWAVES + C.wave, NGW = C.G * NWAVES, lane = C.lane;
    const bf16_t* lat = (const bf16_t*)(ws + WS_LAT); const bf16_t* gv = (const bf16_t*)(ws + WS_GV);
    bf16_t* qn = (bf16_t*)(ws + WS_QN); bf16_t* kvn = (bf16_t*)(ws + WS_KVN); bf16_t* kpe = (bf16_t*)(ws + WS_KPE);
    float* lnmu = (float*)(ws + WS_LNMU); float* lnrs = (float*)(ws + WS_LNRS);
    const float* cs = (const float*)(ws + WS_COS); const float* sn = (const float*)(ws + WS_SIN);
    const float gkr = P.in[I_GKR][lane];
    for (int m = gw; m < T_; m += NGW) {
        const bf16_t* lr = lat + (size_t)m * LATW;
        unsigned q[3]; float s = 0.f;
#pragma unroll
        for (int j = 0; j < 3; ++j) { q[j] = ((const unsigned*)lr)[lane + 64 * j]; const float a = bflo(q[j]), b = bfhi(q[j]); s += a * a + b * b; }
        s = wave_sum(s); const float rq = 1.0f / sqrtf(s * (1.0f / QLAT) + NORM_EPS);
#pragma unroll
        for (int j = 0; j < 3; ++j) ((unsigned*)(qn + (size_t)m * QLAT))[lane + 64 * j] = pk2(bflo(q[j]) * rq, bfhi(q[j]) * rq);
        const u32x2 kv = ((const u32x2*)(lr + QLAT))[lane];
        float s2 = bflo(kv.x) * bflo(kv.x) + bfhi(kv.x) * bfhi(kv.x) + bflo(kv.y) * bflo(kv.y) + bfhi(kv.y) * bfhi(kv.y);
        s2 = wave_sum(s2); const float rk = 1.0f / sqrtf(s2 * (1.0f / KVLAT) + NORM_EPS);
        u32x2 ko; ko.x = pk2(bflo(kv.x) * rk, bfhi(kv.x) * rk); ko.y = pk2(bflo(kv.y) * rk, bfhi(kv.y) * rk);
        ((u32x2*)(kvn + (size_t)m * KVLAT))[lane] = ko;
        const float kr = bf2f(lr[QLAT + KVLAT + lane]);
        const float s3 = wave_sum(kr * kr); const float kn = kr * (1.0f / sqrtf(s3 * (1.0f / ROPE) + NORM_EPS)) * gkr;
        const float other = __shfl_xor(kn, 32);
        const float c = cs[m * 32 + (lane & 31)], sv = sn[m * 32 + (lane & 31)];
        const float ro = lane < 32 ? kn * c - other * sv : kn * c + other * sv;
        kpe[(size_t)m * ROPE + lane] = (bf16_t)f2bf(ro);
        const u32x4* gr = (const u32x4*)(gv + (size_t)m * DM) + lane; const u32x4 g0 = gr[0], g1 = gr[64];
        float f[16]; f[0] = bflo(g0.x); f[1] = bfhi(g0.x); f[2] = bflo(g0.y); f[3] = bfhi(g0.y); f[4] = bflo(g0.z); f[5] = bfhi(g0.z); f[6] = bflo(g0.w); f[7] = bfhi(g0.w);
        f[8] = bflo(g1.x); f[9] = bfhi(g1.x); f[10] = bflo(g1.y); f[11] = bfhi(g1.y); f[12] = bflo(g1.z); f[13] = bfhi(g1.z); f[14] = bflo(g1.w); f[15] = bfhi(g1.w);
        float sm = 0.f;
#pragma unroll
        for (int j = 0; j < 16; ++j) sm += f[j];
        const float mu = wave_sum(sm) * (1.0f / DM); float sq = 0.f;
#pragma unroll
        for (int j = 0; j < 16; ++j) { const float d = f[j] - mu; sq += d * d; }
        const float var = wave_sum(sq) * (1.0f / DM);
        if (lane == 0) { lnmu[m] = mu; lnrs[m] = 1.0f / sqrtf(var + LN_EPS); }
    }
}

__device__ __forceinline__ void phase_qkprep(const Params& P, const Ctx& C) {
    unsigned char* ws = C.ws; const int gw = C.vcu * NWAVES + C.wave, NGW = C.G * NWAVES, lane = C.lane;
    bf16_t* qraw = (bf16_t*)(ws + WS_QRAW); bf16_t* kvraw = (bf16_t*)(ws + WS_KVRAW);
    const float* cs = (const float*)(ws + WS_COS); const float* sn = (const float*)(ws + WS_SIN);
    const float scale = 0.07216878364870322f;
    const float gqn0 = P.in[I_GQN][2 * lane], gqn1 = P.in[I_GQN][2 * lane + 1], gkn0 = P.in[I_GKN][2 * lane], gkn1 = P.in[I_GKN][2 * lane + 1], gqr = P.in[I_GQR][lane];
    for (int it = gw; it < T_ * NH; it += NGW) {
        const int m = it >> 3, h = it & 7;
        bf16_t* qh = qraw + (size_t)m * QW + h * 192;
        const unsigned qw = ((const unsigned*)qh)[lane]; const float a = bflo(qw), b = bfhi(qw);
        const float rn = 1.0f / sqrtf(wave_sum(a * a + b * b) * (1.0f / 128) + NORM_EPS);
        ((unsigned*)qh)[lane] = pk2(a * rn * gqn0 * scale, b * rn * gqn1 * scale);
        const float r = bf2f(qh[128 + lane]); const float rr = 1.0f / sqrtf(wave_sum(r * r) * (1.0f / ROPE) + NORM_EPS); const float rv = r * rr * gqr;
        const float other = __shfl_xor(rv, 32); const float c = cs[m * 32 + (lane & 31)], sv = sn[m * 32 + (lane & 31)];
        const float ro = (lane < 32 ? rv * c - other * sv : rv * c + other * sv) * scale;
        qh[128 + lane] = (bf16_t)f2bf(ro);
        bf16_t* kh = kvraw + (size_t)m * KVW + h * 256;
        const unsigned kw = ((const unsigned*)kh)[lane]; const float ka = bflo(kw), kb = bfhi(kw);
        const float kn = 1.0f / sqrtf(wave_sum(ka * ka + kb * kb) * (1.0f / 128) + NORM_EPS);
        ((unsigned*)kh)[lane] = pk2(ka * kn * gkn0, kb * kn * gkn1);
    }
}
__device__ __forceinline__ void phase_sgu(const Params& P, const Ctx& C) {
    unsigned char* ws = C.ws; const int tid = C.tid, lane = C.lane, wid = C.wave;
    const bf16_t* gu = (const bf16_t*)(ws + WS_GU); const bf16_t* gv = (const bf16_t*)(ws + WS_GV); const bf16_t* sa = (const bf16_t*)(ws + WS_SA);
    bf16_t* yag = (bf16_t*)(ws + WS_YAG); const bf16_t* sw = (const bf16_t*)(ws + WS_SGUW);
    const float* lnmu = (const float*)(ws + WS_LNMU); const float* lnrs = (const float*)(ws + WS_LNRS);
    const float* lng = P.in[I_LNG]; const float* lnb = P.in[I_LNB]; const float* sgub = P.in[I_SGUB];
    constexpr int VTS = 136;
    LAS bf16_t* VT = (LAS bf16_t*)C.lds;
    const int wi = wid >> 1, wcn = wid & 1, r32 = lane & 31, hi = lane >> 5;
    for (int unit = C.vcu; unit < NB * 16 * 8; unit += C.G) {
        const int g = unit & 7, n = (unit >> 3) & 15, b = unit >> 7;
        const size_t t0 = (size_t)b * SEQ + n * 128;
#pragma unroll
        for (int q = 0; q < 4; ++q) { const int chunk = tid + 512 * q, j = chunk >> 4, c0 = (chunk & 15) * 8;
            const u32x4 w = *(const u32x4*)(gv + (t0 + j) * DM + g * 128 + c0); const float mu = lnmu[t0 + j], rs = lnrs[t0 + j];
            const f32x4 ga = *(const f32x4*)(lng + g * 128 + c0), gb = *(const f32x4*)(lng + g * 128 + c0 + 4), ba = *(const f32x4*)(lnb + g * 128 + c0), bb = *(const f32x4*)(lnb + g * 128 + c0 + 4);
            float f[8] = {bflo(w.x), bfhi(w.x), bflo(w.y), bfhi(w.y), bflo(w.z), bfhi(w.z), bflo(w.w), bfhi(w.w)};
#pragma unroll
            for (int e = 0; e < 8; ++e) { const float gg = e < 4 ? ga[e] : gb[e - 4], bv = e < 4 ? ba[e] : bb[e - 4]; VT[(c0 + e) * VTS + j] = (bf16_t)f2bf((f[e] - mu) * rs * gg + bv); } }
        __syncthreads();
        f32x16 acc0 = {}, acc1 = {};
        const bf16_t* wrow = sw + (size_t)g * 128 * 128 + (size_t)(wi * 32 + r32) * 128 + hi * 8;
        const LAS bf16_t* v0p = VT + (wcn * 64 + r32) * VTS + hi * 8; const LAS bf16_t* v1p = v0p + 32 * VTS;
        for (int ks = 0; ks < 2 * wi + 2; ++ks) {
            const bf16x8 a = *(const bf16x8*)(wrow + ks * 16);
            const bf16x8 b0 = *(const LAS bf16x8*)(v0p + ks * 16), b1 = *(const LAS bf16x8*)(v1p + ks * 16);
            acc0 = __builtin_amdgcn_mfma_f32_32x32x16_bf16(a, b0, acc0, 0, 0, 0);
            acc1 = __builtin_amdgcn_mfma_f32_32x32x16_bf16(a, b1, acc1, 0, 0, 0);
        }
#pragma unroll
        for (int r = 0; r < 16; ++r) { const int i = wi * 32 + (r & 3) + 8 * (r >> 2) + 4 * hi; const float bias = sgub[g * 128 + i];
            const size_t o0 = (t0 + i) * DM + g * 128 + wcn * 64 + r32, o1 = o0 + 32;
            yag[o0] = (bf16_t)f2bf(bf2f(sa[o0]) * bf2f(gu[o0]) * (acc0[r] + bias));
            yag[o1] = (bf16_t)f2bf(bf2f(sa[o1]) * bf2f(gu[o1]) * (acc1[r] + bias)); }
        __syncthreads();
    }
}

namespace att {
constexpr int QBLK = 32, KVBLK = 64, QB = 256;
constexpr int SHM_V = KVBLK * 128 * 2, SHM_KN = KVBLK * 128 * 2, SHM_KR = KVBLK * 64 * 2;
constexpr int LDS_V = 0, LDS_KN = 2 * SHM_V, LDS_KR = LDS_KN + 2 * SHM_KN, LDS_WS = LDS_KR + 2 * SHM_KR, LDS_BYTES = LDS_WS + NWAVES * 64 * 4;
#define KSWZ(row, colB) ((row) * 256 + ((colB) ^ (((row) & 7) << 4)))
#define KRSWZ(row, chunk) ((row) * 128 + ((((chunk) ^ ((row) >> 1)) & 7) << 4))
#define SBAR() __builtin_amdgcn_sched_barrier(0)
__device__ __forceinline__ int v_st(int k, int c) { const int kk = (k & ~0xC) | ((k & 4) << 1) | ((k & 8) >> 1); return ((kk >> 3) * 4 + (c >> 5)) * 512 + ((kk & 7) * 32 + (c & 31)) * 2; }
__device__ __forceinline__ int v_rd_base(int lane) { return ((lane & 3) << 3) | (((lane >> 2) & 3) << 6) | (((lane >> 4) & 1) << 5) | (((lane >> 5) & 1) << 8); }
constexpr int v_rd_off(int d0, int ks, int half) { return d0 * 512 + ks * 4096 + half * 2048; }
__device__ __forceinline__ int crow(int r, int hi) { return (r & 3) + 8 * (r >> 2) + 4 * hi; }

__device__ __forceinline__ void attn_block(int b, int h, int qb, const bf16_t* Q, const bf16_t* KV, const bf16_t* KPE, const bf16_t* SBG, bf16_t* MRG, LAS char* lds) {
    const int tid = threadIdx.x, wid = __builtin_amdgcn_readfirstlane(tid >> 6), lane = tid & 63, r32 = lane & 31, hi = lane >> 5;
    LAS char* V_lds = lds + LDS_V; LAS char* KN_lds = lds + LDS_KN; LAS char* KR_lds = lds + LDS_KR;
    LAS float* wsf = (LAS float*)(lds + LDS_WS) + wid * 64; LAS float* li_l = wsf; LAS float* al_l = wsf + 32;
    const int P0 = qb * QB, NT = (P0 + QB) / KVBLK;
    const unsigned tb = (unsigned)b * SEQ;
    const int qlo = P0 + wid * QBLK;
    bf16x8 qr[12];
    { const bf16_t* qp = Q + (unsigned)((tb + qlo + r32) * QW + h * 192 + hi * 8);
#pragma unroll
      for (int d0 = 0; d0 < 12; ++d0) qr[d0] = *(const bf16x8*)(qp + d0 * 16); }
    bf16x8 st_k0, st_k1, st_v0, st_v1, st_r;
#define SLOAD(k0) do { int t3_ = tid; asm volatile("" : "+v"(t3_)); const unsigned kvo = (tb + (t3_ >> 4)) * KVW + h * 256 + (t3_ & 15) * 8, kro = (tb + (t3_ >> 3)) * ROPE + (t3_ & 7) * 8; \
        const bf16_t* p_ = KV + (unsigned)(kvo + (unsigned)(k0) * KVW); st_k0 = *(const bf16x8*)p_; st_k1 = *(const bf16x8*)(p_ + 32 * KVW); \
        st_v0 = *(const bf16x8*)(p_ + 128); st_v1 = *(const bf16x8*)(p_ + 32 * KVW + 128); st_r = *(const bf16x8*)(KPE + (unsigned)(kro + (unsigned)(k0) * ROPE)); } while (0)
#define SWRITE(bf) do { int t2_ = tid; asm volatile("" : "+v"(t2_)); const int sr_ = t2_ >> 4, sc_ = (t2_ & 15) * 8, rr_ = t2_ >> 3, rc_ = t2_ & 7; \
        const int kws = KSWZ(sr_, sc_ * 2), vst0 = v_st(sr_, sc_), vst1 = v_st(32 + sr_, sc_), krs = KRSWZ(rr_, rc_); \
        *(LAS bf16x8*)(KN_lds + (bf) * SHM_KN + kws) = st_k0; *(LAS bf16x8*)(KN_lds + (bf) * SHM_KN + kws + 32 * 256) = st_k1; \
        *(LAS bf16x8*)(V_lds + (bf) * SHM_V + vst0) = st_v0; *(LAS bf16x8*)(V_lds + (bf) * SHM_V + vst1) = st_v1; *(LAS bf16x8*)(KR_lds + (bf) * SHM_KR + krs) = st_r; } while (0)
    SLOAD(0); SWRITE(0);
    __syncthreads();
    float m_reg = -1e30f, l_reg = 0.f; f32x16 o[4] = {};
    const int vb0 = (int)(unsigned)(uintptr_t)V_lds + v_rd_base(lane);
    constexpr float C2 = 1.4426950408889634f;
    for (int t = 0; t < NT; ++t) {
        const int bf = t & 1, kb = t * KVBLK;
        if (t + 1 < NT) SLOAD(kb + KVBLK);
        if (kb <= qlo + QBLK - 1) {
            f32x16 p0 = {}, p1 = {};
            int l2_ = lane; asm volatile("" : "+v"(l2_)); const int r32 = l2_ & 31, hi = l2_ >> 5;
            { LAS const char* kn = KN_lds + bf * SHM_KN;
              LAS const char* kbp[4];
#pragma unroll
              for (int dd = 0; dd < 4; ++dd) kbp[dd] = kn + KSWZ(r32, (dd * 16 + hi * 8) * 2);
#pragma unroll
              for (int d0 = 0; d0 < 8; ++d0) { LAS const char* a = kbp[d0 & 3] + (d0 >> 2) * 128;
                  const bf16x8 b0 = *(LAS const bf16x8*)a, b1 = *(LAS const bf16x8*)(a + 32 * 256);
                  p0 = __builtin_amdgcn_mfma_f32_32x32x16_bf16(b0, qr[d0], p0, 0, 0, 0);
                  p1 = __builtin_amdgcn_mfma_f32_32x32x16_bf16(b1, qr[d0], p1, 0, 0, 0); }
              LAS const char* kr = KR_lds + bf * SHM_KR;
#pragma unroll
              for (int d0 = 0; d0 < 4; ++d0) { LAS const char* a = kr + KRSWZ(r32, 2 * d0 + hi);
                  const bf16x8 b0 = *(LAS const bf16x8*)a, b1 = *(LAS const bf16x8*)(a + 32 * 128);
                  p0 = __builtin_amdgcn_mfma_f32_32x32x16_bf16(b0, qr[8 + d0], p0, 0, 0, 0);
                  p1 = __builtin_amdgcn_mfma_f32_32x32x16_bf16(b1, qr[8 + d0], p1, 0, 0, 0); } }
            if (kb + KVBLK - 1 > qlo) {
                const int dq = qlo + r32 - 4 * hi - kb; const float NEG = -__builtin_inff();
#pragma unroll
                for (int r = 0; r < 16; ++r) { const int c = (r & 3) + 8 * (r >> 2); if (dq - c < 0) p0[r] = NEG; if (dq - c - 32 < 0) p1[r] = NEG; } }
            float pmax = p0[0];
#pragma unroll
            for (int r = 1; r < 16; ++r) pmax = fmaxf(pmax, p0[r]);
#pragma unroll
            for (int r = 0; r < 16; ++r) pmax = fmaxf(pmax, p1[r]);
            { auto sw = __builtin_amdgcn_permlane32_swap(__float_as_uint(pmax), __float_as_uint(pmax), false, false); pmax = fmaxf(__uint_as_float(sw[0]), __uint_as_float(sw[1])); }
            const float mn = fmaxf(m_reg, pmax); const float alpha = __builtin_amdgcn_exp2f((m_reg - mn) * C2); m_reg = mn;
            const float mnL = -mn * C2; float ps = 0.f;
#pragma unroll
            for (int r = 0; r < 16; ++r) { p0[r] = __builtin_amdgcn_exp2f(fmaf(p0[r], C2, mnL)); p1[r] = __builtin_amdgcn_exp2f(fmaf(p1[r], C2, mnL)); ps += p0[r] + p1[r]; }
            { auto sw = __builtin_amdgcn_permlane32_swap(__float_as_uint(ps), __float_as_uint(ps), false, false); ps = __uint_as_float(sw[0]) + __uint_as_float(sw[1]); }
            l_reg = l_reg * alpha + ps;
            bf16x8 pa0, pa1, pa2, pa3;
#define PK4(Pv, B_, OUT) do { unsigned a0 = pk2(Pv[B_ + 0], Pv[B_ + 1]), a1 = pk2(Pv[B_ + 2], Pv[B_ + 3]); unsigned b0 = pk2(Pv[B_ + 4], Pv[B_ + 5]), b1 = pk2(Pv[B_ + 6], Pv[B_ + 7]); \
        auto r0 = __builtin_amdgcn_permlane32_swap(a0, b0, false, false); auto r1 = __builtin_amdgcn_permlane32_swap(a1, b1, false, false); \
        u32x4 w = {r0[0], r1[0], r0[1], r1[1]}; OUT = *reinterpret_cast<bf16x8*>(&w); } while (0)
            PK4(p0, 0, pa0); PK4(p0, 8, pa1); PK4(p1, 0, pa2); PK4(p1, 8, pa3);
#undef PK4
            if (__any(alpha < 1.f)) { if (hi == 0) al_l[r32] = alpha; asm volatile("s_waitcnt lgkmcnt(0)" ::: "memory");
#pragma unroll
                for (int d_ = 0; d_ < 4; ++d_)
#pragma unroll
                    for (int r = 0; r < 16; ++r) o[d_][r] *= al_l[crow(r, hi)]; }
#define TRRD(dst, off) asm volatile("ds_read_b64_tr_b16 %0, %1 offset:%2" : "=&v"(dst) : "v"(vb0), "i"(off) : "memory")
#define PV_D0(VB, d0) do { s16x4 l0, l1, l2, l3, h0, h1, h2, h3; constexpr int b_ = VB * SHM_V + v_rd_off(d0, 0, 0); \
        TRRD(l0, b_); TRRD(h0, b_ + 2048); TRRD(l1, b_ + 4096); TRRD(h1, b_ + 6144); TRRD(l2, b_ + 8192); TRRD(h2, b_ + 10240); TRRD(l3, b_ + 12288); TRRD(h3, b_ + 14336); \
        asm volatile("s_waitcnt lgkmcnt(0)" ::: "memory"); SBAR(); \
        o[d0] = __builtin_amdgcn_mfma_f32_32x32x16_bf16(pa0, (bf16x8){l0[0], l0[1], l0[2], l0[3], h0[0], h0[1], h0[2], h0[3]}, o[d0], 0, 0, 0); \
        o[d0] = __builtin_amdgcn_mfma_f32_32x32x16_bf16(pa1, (bf16x8){l1[0], l1[1], l1[2], l1[3], h1[0], h1[1], h1[2], h1[3]}, o[d0], 0, 0, 0); \
        o[d0] = __builtin_amdgcn_mfma_f32_32x32x16_bf16(pa2, (bf16x8){l2[0], l2[1], l2[2], l2[3], h2[0], h2[1], h2[2], h2[3]}, o[d0], 0, 0, 0); \
        o[d0] = __builtin_amdgcn_mfma_f32_32x32x16_bf16(pa3, (bf16x8){l3[0], l3[1], l3[2], l3[3], h3[0], h3[1], h3[2], h3[3]}, o[d0], 0, 0, 0); } while (0)
            if (bf == 0) { PV_D0(0, 0); PV_D0(0, 1); PV_D0(0, 2); PV_D0(0, 3); } else { PV_D0(1, 0); PV_D0(1, 1); PV_D0(1, 2); PV_D0(1, 3); }
#undef PV_D0
#undef TRRD
        }
        if (t + 1 < NT) SWRITE(bf ^ 1);
        __syncthreads();
    }
#undef SLOAD
#undef SWRITE
    if (hi == 0) li_l[r32] = l_reg; asm volatile("s_waitcnt lgkmcnt(0)" ::: "memory");
    int hi2 = hi; asm volatile("" : "+v"(hi2));
#pragma unroll
    for (int r = 0; r < 16; ++r) { const int orow = crow(r, hi2); const float rl = __builtin_amdgcn_rcpf(li_l[orow]);
        const unsigned base = (tb + qlo + orow) * DM + h * 128 + r32;
#pragma unroll
        for (int d0 = 0; d0 < 4; ++d0) { const unsigned a = base + d0 * 32; MRG[a] = (bf16_t)f2bf(bf2f(MRG[a]) + bf2f(SBG[a]) * (o[d0][r] * rl)); }
        asm volatile("" ::: "memory"); }
    __syncthreads();
}
#undef KSWZ
#undef KRSWZ
#undef SBAR
}

__device__ __forceinline__ void phase_attn(const Params& P, const Ctx& C) {
    unsigned char* ws = C.ws;
    const bf16_t* Q = (const bf16_t*)(ws + WS_QRAW); const bf16_t* KV = (const bf16_t*)(ws + WS_KVRAW); const bf16_t* KPE = (const bf16_t*)(ws + WS_KPE);
    const bf16_t* SBG = (const bf16_t*)(ws + WS_SB); bf16_t* MRG = (bf16_t*)(ws + WS_YAG);
    for (int item = C.vcu; item < NB * NH * 4; item += C.G) {
        const int bh = item >> 2, x = item & 3, b = bh >> 3, h = bh & 7;
#pragma unroll 1
        for (int pass = 0; pass < 2; ++pass) att::attn_block(b, h, pass ? 7 - x : x, Q, KV, KPE, SBG, MRG, (LAS char*)C.lds);
    }
}
__device__ __forceinline__ void phase_router(const Params& P, const Ctx& C) {
    unsigned char* ws = C.ws; const int gw = C.vcu * NWAVES + C.wave, NGW = C.G * NWAVES, lane = C.lane;
    LAS float* hb = (LAS float*)(C.lds + C.wave * 4096);
    const float* x1 = P.out; const float* wr = P.in[I_WR]; const float* gf = P.in[I_GFFN];
    float* rstd2 = (float*)(ws + WS_RSTD2); int* tok_e = (int*)(ws + WS_TOKE); float* tok_w = (float*)(ws + WS_TOKW);
    unsigned* cnt = (unsigned*)(ws + WS_CTL) + CW_CNT;
    const float br = P.in[I_BR][lane];
    f32x4 g4[4];
#pragma unroll
    for (int j = 0; j < 4; ++j) g4[j] = ((const f32x4*)gf)[lane + 64 * j];
    for (int m = gw; m < T_; m += NGW) {
        const f32x4* xr = (const f32x4*)(x1 + (size_t)m * DM) + lane;
        f32x4 v[4]; float s = 0.f;
#pragma unroll
        for (int j = 0; j < 4; ++j) { v[j] = xr[64 * j]; s += (v[j][0] * v[j][0] + v[j][1] * v[j][1]) + (v[j][2] * v[j][2] + v[j][3] * v[j][3]); }
        s = wave_sum(s); const float rs = 1.0f / sqrtf(s * (1.0f / DM) + NORM_EPS);
        if (lane == 0) rstd2[m] = rs;
#pragma unroll
        for (int j = 0; j < 4; ++j) ((LAS f32x4*)hb)[lane + 64 * j] = v[j] * g4[j] * rs;
        LDS_WAIT(); asm volatile("" ::: "memory");
        float a0 = 0.f, a1 = 0.f, a2 = 0.f, a3 = 0.f;
        for (int k = 0; k < DM; k += 4) { const f32x4 hv = *(const LAS f32x4*)(hb + k);
            a0 = fmaf(hv[0], wr[(size_t)(k + 0) * NEXP + lane], a0); a1 = fmaf(hv[1], wr[(size_t)(k + 1) * NEXP + lane], a1);
            a2 = fmaf(hv[2], wr[(size_t)(k + 2) * NEXP + lane], a2); a3 = fmaf(hv[3], wr[(size_t)(k + 3) * NEXP + lane], a3); }
        const float logit = (a0 + a1) + (a2 + a3);
        const float score = 1.0f / (1.0f + expf(-logit)); const float sel = score + br;
        float m1 = sel, m2 = -__builtin_inff();
#pragma unroll
        for (int o = 1; o < 8; o <<= 1) { const float p1 = __shfl_xor(m1, o), p2 = __shfl_xor(m2, o); const float hi1 = fmaxf(m1, p1), lo1 = fminf(m1, p1); m2 = fmaxf(lo1, fmaxf(m2, p2)); m1 = hi1; }
        const float gs = m1 + m2;
        int grank = 0; const int mygrp = lane >> 3;
#pragma unroll
        for (int g = 0; g < 8; ++g) { const float og = __shfl(gs, g * 8); grank += (og > gs || (og == gs && g < mygrp)) ? 1 : 0; }
        const bool gsel = grank < 4;
        const float msel = gsel ? sel : -__builtin_inff();
        int rank = 0;
        for (int j = 0; j < 64; ++j) { const float oj = __shfl(msel, j); rank += (oj > msel || (oj == msel && j < lane)) ? 1 : 0; }
        const bool chosen = rank < 8;
        const float wsum = wave_sum(chosen ? score : 0.f);
        if (chosen) { tok_e[m * 8 + rank] = lane; tok_w[m * 8 + rank] = score / wsum * 2.5f; atomicAdd(cnt + lane, 1u); }
        LDS_WAIT(); asm volatile("" ::: "memory");
    }
}
__device__ __forceinline__ void phase_lists(const Params& P, const Ctx& C) {
    unsigned char* ws = C.ws; const int tid = C.tid;
    LAS int* offs = (LAS int*)C.lds;
    unsigned* ctl = (unsigned*)(ws + WS_CTL); const unsigned* cnt = ctl + CW_CNT; unsigned* fill = ctl + CW_FILL;
    int* rowid = (int*)(ws + WS_ROWID); int* rdest = (int*)(ws + WS_RDEST); float* rw = (float*)(ws + WS_RW); float* rs = (float*)(ws + WS_RS); int* tile_list = (int*)(ws + WS_TILEL);
    const int* tok_e = (const int*)(ws + WS_TOKE); const float* tok_w = (const float*)(ws + WS_TOKW); const float* rstd2 = (const float*)(ws + WS_RSTD2);
    if (tid == 0) { int o = 0; for (int e = 0; e < NLIST; ++e) { offs[e] = o; const int c = (e == 64) ? T_ : (int)__hip_atomic_load(cnt + e, __ATOMIC_RELAXED, __HIP_MEMORY_SCOPE_AGENT); o += (c + 255) & ~255; } offs[NLIST] = o; }
    __syncthreads();
    const int gt = C.vcu * NTHREADS + tid, NT = C.G * NTHREADS;
    for (int i = gt; i < T_ * 8; i += NT) { const int m = i >> 3, k = i & 7, e = tok_e[i];
        const int pos = (int)atomicAdd(fill + e, 1u), idx = offs[e] + pos;
        rowid[idx] = m; rdest[idx] = m * 9 + k; rw[idx] = tok_w[i]; rs[idx] = rstd2[m]; }
    for (int m = gt; m < T_; m += NT) { const int idx = offs[64] + m; rowid[idx] = m; rdest[idx] = m * 9 + 8; rw[idx] = 1.0f; rs[idx] = rstd2[m]; }
    for (int e = C.vcu; e < NEXP; e += C.G) { const int c = (int)__hip_atomic_load(cnt + e, __ATOMIC_RELAXED, __HIP_MEMORY_SCOPE_AGENT);
        for (int i = offs[e] + c + tid; i < offs[e + 1]; i += NTHREADS) { rowid[i] = 0; rdest[i] = -1; rw[i] = 0.f; rs[i] = 0.f; } }
    const int ntiles = offs[NLIST] >> 8;
    for (int rt = gt; rt < ntiles; rt += NT) { int li = 0;
        for (int e = 0; e < NLIST; ++e) if (rt * 256 >= offs[e]) li = e;
        tile_list[rt] = li; }
    if (gt == 0) { ctl[CW_FILL + 80] = (unsigned)ntiles; ctl[CW_FILL + 81] = (unsigned)offs[64]; }
    __syncthreads();
}
__device__ __forceinline__ void phase_combine(const Params& P, const Ctx& C, int half) {
    const int gw = C.vcu * NWAVES + C.wave, NGW = C.G * NWAVES, lane = C.lane;
    const bf16_t* ybuf = (const bf16_t*)(C.ws + WS_YBUF); float* out = P.out;
    for (int m = gw; m < T_; m += NGW) {
        float* op = out + (size_t)m * DM + half * 512 + lane * 8;
        f32x4 a = *(const f32x4*)op, b = *(const f32x4*)(op + 4);
        const bf16_t* yp = ybuf + (size_t)m * 9 * 512 + lane * 8;
#pragma unroll
        for (int k = 0; k < 9; ++k) { const u32x4 w = *(const u32x4*)(yp + k * 512);
            a[0] += bflo(w.x); a[1] += bfhi(w.x); a[2] += bflo(w.y); a[3] += bfhi(w.y); b[0] += bflo(w.z); b[1] += bfhi(w.z); b[2] += bflo(w.w); b[3] += bfhi(w.w); }
        *(f32x4*)op = a; *(f32x4*)(op + 4) = b;
    }
}
__device__ __forceinline__ void phase_finalize_rows(const Params& P, const Ctx& C) {
    unsigned char* ws = C.ws; const int gw = C.vcu * NWAVES + C.wave, NGW = C.G * NWAVES, lane = C.lane;
    bf16_t* x2b = (bf16_t*)(ws + WS_X2B); const bf16_t* pe = (const bf16_t*)(ws + WS_PERAW); float* rstd3 = (float*)(ws + WS_RSTD3); float* rstdpe = (float*)(ws + WS_RSTDPE);
    for (int m = gw; m < T_; m += NGW) {
        const f32x4* xr = (const f32x4*)(P.out + (size_t)m * DM) + lane;
        f32x4 v[4]; float s = 0.f;
#pragma unroll
        for (int j = 0; j < 4; ++j) { v[j] = xr[64 * j]; s += (v[j][0] * v[j][0] + v[j][1] * v[j][1]) + (v[j][2] * v[j][2] + v[j][3] * v[j][3]); }
        s = wave_sum(s);
        u32x2* o8 = (u32x2*)(x2b + (size_t)m * DM) + lane;
#pragma unroll
        for (int j = 0; j < 4; ++j) { u32x2 w; w.x = pk2(v[j][0], v[j][1]); w.y = pk2(v[j][2], v[j][3]); o8[64 * j] = w; }
        const u32x4* pr = (const u32x4*)(pe + (size_t)m * DM) + lane; const u32x4 g0 = pr[0], g1 = pr[64];
        float q = bflo(g0.x) * bflo(g0.x) + bfhi(g0.x) * bfhi(g0.x) + bflo(g0.y) * bflo(g0.y) + bfhi(g0.y) * bfhi(g0.y) + bflo(g0.z) * bflo(g0.z) + bfhi(g0.z) * bfhi(g0.z) + bflo(g0.w) * bflo(g0.w) + bfhi(g0.w) * bfhi(g0.w);
        q += bflo(g1.x) * bflo(g1.x) + bfhi(g1.x) * bfhi(g1.x) + bflo(g1.y) * bflo(g1.y) + bfhi(g1.y) * bfhi(g1.y) + bflo(g1.z) * bflo(g1.z) + bfhi(g1.z) * bfhi(g1.z) + bflo(g1.w) * bflo(g1.w) + bfhi(g1.w) * bfhi(g1.w);
        q = wave_sum(q);
        if (lane == 0) { rstd3[m] = 1.0f / sqrtf(s * (1.0f / DM) + NORM_EPS); rstdpe[m] = 1.0f / sqrtf(q * (1.0f / DM) + NORM_EPS); }
    }
}
#define XB_TMO      128
#define XB_XCNT(j)  (256  + 64 * (j))
#define XB_XSUB(j)  (1280 + 64 * (j))
#define XB_XGEN(j)  (2304 + 64 * (j))
#define XB_TOP      3328
#define XB_TOPGEN   3392
#define XCD_BAR_WORDS 3456
#define XB_SPIN_CAP (1u << 20)
__device__ __forceinline__ unsigned xb_ld(unsigned* p)              { return __hip_atomic_load(p, __ATOMIC_RELAXED, __HIP_MEMORY_SCOPE_AGENT); }
__device__ __forceinline__ unsigned xb_add(unsigned* p, unsigned v) { return __hip_atomic_fetch_add(p, v, __ATOMIC_RELAXED, __HIP_MEMORY_SCOPE_AGENT); }
__device__ __forceinline__ unsigned xb_xcc_id() { return (unsigned)__builtin_amdgcn_s_getreg((3 << 11) | 20) & 0xFu; }
#define XB_SPIN(cond, bar) do { unsigned _sp = 0; while (cond) { __builtin_amdgcn_s_sleep(1); \
    if ((++_sp & 255u) == 0u) { if (xb_ld(&(bar)[XB_TMO])) break; if (_sp > XB_SPIN_CAP) { atomicAdd(&(bar)[XB_TMO], 1u); break; } } } } while (0)
struct XcdBarrier { unsigned* bar; unsigned x; volatile LAS unsigned* st; };
__device__ __forceinline__ XcdBarrier xcd_barrier_post(unsigned* bar, volatile LAS unsigned* st) {
    XcdBarrier b; b.bar = bar; b.x = xb_xcc_id(); b.st = st;
    if (threadIdx.x == 0) (void)xb_add(&bar[XB_XCNT(b.x)], 1u);
    return b;
}
__device__ __forceinline__ void xcd_barrier_complete(unsigned* bar, unsigned x, unsigned& nloc, unsigned& nx) {
    const unsigned G = gridDim.x * gridDim.y * gridDim.z;
    unsigned sum, cnt, mine, sp = 0u;
    for (;;) {
        sum = 0u; cnt = 0u; mine = 0u;
#pragma unroll
        for (unsigned j = 0; j < 16; ++j) { const unsigned c = xb_ld(&bar[XB_XCNT(j)]); sum += c; cnt += (c > 0u) ? 1u : 0u; mine = (j == x) ? c : mine; }
        if (sum == G) break;
        __builtin_amdgcn_s_sleep(1);
        if ((++sp & 255u) == 0u) { if (xb_ld(&bar[XB_TMO])) break; if (sp > XB_SPIN_CAP) { atomicAdd(&bar[XB_TMO], 1u); break; } }
    }
    nloc = mine > 0u ? mine : 1u; nx = cnt > 0u ? cnt : 1u;
}
__device__ __forceinline__ void xcd_barrier(const XcdBarrier& b) {
    asm volatile("s_waitcnt vmcnt(0)" ::: "memory");
    __syncthreads();
    if (threadIdx.x == 0) {
        unsigned* bar = b.bar;
        __builtin_amdgcn_s_waitcnt(0);
        unsigned nloc = b.st[0], nx = b.st[1];
        if (nloc == 0u) { xcd_barrier_complete(bar, b.x, nloc, nx); b.st[0] = nloc; b.st[1] = nx; }
        const unsigned old = xb_add(&bar[XB_XSUB(b.x)], 1u);
        const unsigned gen = old / nloc;
        if (old + 1u == (gen + 1u) * nloc) {
            __builtin_amdgcn_fence(__ATOMIC_RELEASE, "agent");
            asm volatile("s_waitcnt vmcnt(0)" ::: "memory");
            const unsigned og = xb_add(&bar[XB_TOP], 1u);
            const unsigned tg = og / nx;
            if (og + 1u == (tg + 1u) * nx) xb_add(&bar[XB_TOPGEN], 1u);
            else XB_SPIN(xb_ld(&bar[XB_TOPGEN]) == tg, bar);
            __builtin_amdgcn_fence(__ATOMIC_ACQUIRE, "agent");
            xb_add(&bar[XB_XGEN(b.x)], 1u);
            asm volatile("s_waitcnt vmcnt(0)" ::: "memory");
        } else {
            XB_SPIN(xb_ld(&bar[XB_XGEN(b.x)]) == gen, bar);
            __builtin_amdgcn_fence(__ATOMIC_ACQUIRE, "agent");
            asm volatile("s_waitcnt vmcnt(0)" ::: "memory");
        }
    }
    __syncthreads();
}

constexpr int RING_BYTES = 131072, MISC_OFF = RING_BYTES + 320, LDS_BYTES = 147456;
constexpr int N_PHASES = 17;
#ifndef MK_N_LAUNCHES
#define MK_N_LAUNCHES 1
#endif
struct Args { Params P; int ph_lo, ph_hi; };

__global__ void __launch_bounds__(NTHREADS, 2) fwd_kernel(Args args) {
    extern __shared__ __attribute__((aligned(16))) unsigned char lds_raw[];
    Ctx C; C.lds = (LAS unsigned char*)lds_raw; C.ws = args.P.ws; C.tid = threadIdx.x; C.lane = C.tid & 63; C.wave = __builtin_amdgcn_readfirstlane(C.tid >> 6);
    C.G = gridDim.x; C.vcu = vcu_of(blockIdx.x, C.G);
    const Params& P = args.P;
    unsigned char* ws = C.ws;
    volatile LAS unsigned* MISC = (volatile LAS unsigned*)(C.lds + MISC_OFF);
    for (int u = C.tid; u < (LDS_BYTES - RING_BYTES) / 4; u += NTHREADS) ((LAS unsigned*)(C.lds + RING_BYTES))[u] = 0u;
    __syncthreads();
    const int lo = args.ph_lo, hi = args.ph_hi;
    XcdBarrier bar; bar.bar = (unsigned*)(ws + WS_CTL) + CW_BAR; bar.x = 0; bar.st = nullptr;
    if (hi - lo > 1) bar = xcd_barrier_post((unsigned*)(ws + WS_CTL) + CW_BAR, MISC + 8);
#ifdef ONLY_PHASE
#define IN(k) ((k) == ONLY_PHASE && lo <= (k) && (k) < hi)
#else
#define IN(k) (lo <= (k) && (k) < hi)
#endif
#define SEAM(k) do { if (IN(k) && IN((k) + 1)) xcd_barrier(bar); } while (0)
    if (IN(0)) { phase_prep0(P, C); } SEAM(0);
    if (IN(1)) {
        DenseSched S{(const char*)(ws + WS_XB), (const char*)(ws + WS_WIN), T_ / 256, NZ / 256, C.G, C.vcu, DM * 2, DM * 2};
        EpiG1 E{(const float*)(ws + WS_RSTD0), (bf16_t*)(ws + WS_GU), (bf16_t*)(ws + WS_GV), (bf16_t*)(ws + WS_SA), (bf16_t*)(ws + WS_SB), (bf16_t*)(ws + WS_LAT)};
        pg8::gemm_phase<EpiG1, DenseSched, false>(C.lds, pg8::Shape{DM * 2, DM * 2, DM / 64, nullptr}, S, E);
    } SEAM(1);
    if (IN(2)) { phase_latnorm(P, C); } SEAM(2);
    if (IN(3)) { phase_sgu(P, C); } SEAM(3);
    if (IN(4)) {
        { DenseSched S{(const char*)(ws + WS_QN), (const char*)(ws + WS_WQB), T_ / 256, QW / 256, C.G, C.vcu, QLAT * 2, QLAT * 2};
          EpiBf16 E{(bf16_t*)(ws + WS_QRAW), QW};
          pg8::gemm_phase<EpiBf16, DenseSched, false>(C.lds, pg8::Shape{QLAT * 2, QLAT * 2, QLAT / 64, nullptr}, S, E); }
        { DenseSched S{(const char*)(ws + WS_KVN), (const char*)(ws + WS_WKVB), T_ / 256, KVW / 256, C.G, C.vcu, KVLAT * 2, KVLAT * 2};
          EpiBf16 E{(bf16_t*)(ws + WS_KVRAW), KVW};
          pg8::gemm_phase<EpiBf16, DenseSched, false>(C.lds, pg8::Shape{KVLAT * 2, KVLAT * 2, KVLAT / 64, nullptr}, S, E); }
    } SEAM(4);
    if (IN(5)) { phase_qkprep(P, C); } SEAM(5);
    if (IN(6)) { phase_attn(P, C); } SEAM(6);
    if (IN(7)) {
        phase_prep_wgu(P, C);
        __syncthreads();
        DenseSched S{(const char*)(ws + WS_YAG), (const char*)(ws + WS_WO), T_ / 256, DM / 256, C.G, C.vcu, DM * 2, DM * 2};
        EpiG4 E{P.in[I_X], P.out, (bf16_t*)(ws + WS_X1B)};
        pg8::gemm_phase<EpiG4, DenseSched, false>(C.lds, pg8::Shape{DM * 2, DM * 2, DM / 64, nullptr}, S, E);
    } SEAM(7);
    if (IN(8)) { phase_router(P, C); } SEAM(8);
    if (IN(9)) { phase_lists(P, C); } SEAM(9);
    const unsigned* ctl = (const unsigned*)(ws + WS_CTL);
    if (IN(10)) {
        const int ntiles = (int)__hip_atomic_load(ctl + CW_FILL + 80, __ATOMIC_RELAXED, __HIP_MEMORY_SCOPE_AGENT), off64 = (int)__hip_atomic_load(ctl + CW_FILL + 81, __ATOMIC_RELAXED, __HIP_MEMORY_SCOPE_AGENT);
        MoeGuSched S{ws, ntiles, C.G, C.vcu};
        EpiGu E{ws, off64};
        pg8::gemm_phase<EpiGu, MoeGuSched, true>(C.lds, pg8::Shape{DM * 2, DM * 2, DM / 64, (const char*)(ws + WS_X1B)}, S, E);
    } SEAM(10);
#define DOWN_PHASE(pd, half) do { if (IN(pd)) { \
        const int ntiles = (int)__hip_atomic_load(ctl + CW_FILL + 80, __ATOMIC_RELAXED, __HIP_MEMORY_SCOPE_AGENT), off64 = (int)__hip_atomic_load(ctl + CW_FILL + 81, __ATOMIC_RELAXED, __HIP_MEMORY_SCOPE_AGENT); \
        MoeDownSched S{ws, ntiles, C.G, C.vcu, half, off64}; \
        EpiDown E{ws}; \
        pg8::gemm_phase<EpiDown, MoeDownSched, false>(C.lds, pg8::Shape{EFF * 2, EFF * 2, EFF / 64, nullptr}, S, E); } } while (0)
    DOWN_PHASE(11, 0); SEAM(11);
    if (IN(12)) { phase_combine(P, C, 0); } SEAM(12);
    DOWN_PHASE(13, 1); SEAM(13);
    if (IN(14)) {
        phase_combine(P, C, 1);
        DenseSched S{(const char*)(ws + WS_PB), (const char*)(ws + WS_WPP), T_ / 256, DM / 256, C.G, C.vcu, PLE * 2, PLE * 2};
        EpiBf16 E{(bf16_t*)(ws + WS_PERAW), DM};
        pg8::gemm_phase<EpiBf16, DenseSched, false>(C.lds, pg8::Shape{PLE * 2, PLE * 2, PLE / 64, nullptr}, S, E);
    } SEAM(14);
    if (IN(15)) { phase_finalize_rows(P, C); } SEAM(15);
    if (IN(16)) {
        DenseSched S{(const char*)(ws + WS_X2B), (const char*)(ws + WS_WPG), T_ / 256, DM / 256, C.G, C.vcu, DM * 2, DM * 2};
        EpiG5 E{P.out, (const bf16_t*)(ws + WS_PERAW), (const float*)(ws + WS_RSTD3), (const float*)(ws + WS_RSTDPE), P.in[I_GPO]};
        pg8::gemm_phase<EpiG5, DenseSched, false>(C.lds, pg8::Shape{DM * 2, DM * 2, DM / 64, nullptr}, S, E);
    }
#undef IN
#undef SEAM
}

extern "C" void kernel_launch(void* const* d_in, const int* in_sizes, int n_in, void* d_out, int out_size, void* d_ws, size_t ws_size, hipStream_t stream) {
    static int grid = 0;
    if (grid == 0) {
        if (n_in != 31 || in_sizes[0] != T_ * DM || out_size != T_ * DM || ws_size < WS_END) { fprintf(stderr, "kernel_launch: unexpected shapes (n_in %d, in0 %d, out %d, ws %zu, need %zu)\n", n_in, n_in > 0 ? in_sizes[0] : -1, out_size, ws_size, (size_t)WS_END); grid = -1; return; }
        int dev = 0, cus = 0;
        if (hipGetDevice(&dev) != hipSuccess || hipDeviceGetAttribute(&cus, hipDeviceAttributeMultiprocessorCount, dev) != hipSuccess) { grid = -1; return; }
        if (hipFuncSetAttribute((const void*)fwd_kernel, hipFuncAttributeMaxDynamicSharedMemorySize, LDS_BYTES) != hipSuccess) { fprintf(stderr, "kernel_launch: hipFuncSetAttribute failed\n"); grid = -1; return; }
        grid = cus;
    }
    if (grid < 0) return;
    (void)hipMemsetAsync((char*)d_ws + WS_CTL, 0, CTL_BYTES, stream);
    Args a{};
    for (int i = 0; i < 31; ++i) a.P.in[i] = (const float*)d_in[i];
    a.P.out = (float*)d_out; a.P.ws = (unsigned char*)d_ws;
    constexpr int NL = MK_N_LAUNCHES;
    for (int li = 0; li < NL; ++li) {
        a.ph_lo = (NL == N_PHASES) ? li : (li * N_PHASES) / NL; a.ph_hi = (NL == N_PHASES) ? li + 1 : ((li + 1) * N_PHASES) / NL;
        hipLaunchKernelGGL(fwd_kernel, dim3(grid), dim3(NTHREADS), LDS_BYTES, stream, a);
    }
}
```

```cpp
#include <hip/hip_runtime.h>
#include <hip/hip_bf16.h>
#include <cstdio>
#include <cstdint>

#define LAS __attribute__((address_space(3)))
#define GAS __attribute__((address_space(1)))
typedef unsigned short bf16_t;
typedef short bf16x8 __attribute__((ext_vector_type(8)));
typedef short s16x4 __attribute__((ext_vector_type(4)));
typedef float f32x4 __attribute__((ext_vector_type(4)));
typedef float f32x2 __attribute__((ext_vector_type(2)));
typedef float f32x16 __attribute__((ext_vector_type(16)));
typedef unsigned u32x4 __attribute__((ext_vector_type(4)));
typedef unsigned u32x2 __attribute__((ext_vector_type(2)));

constexpr int T_ = 16384, DM = 1024, NB = 8, SEQ = 2048, NH = 8;
constexpr int NZ = 4864;
constexpr int QLAT = 384, KVLAT = 256, ROPE = 64, LATW = 768;
constexpr int QW = 1536, KVW = 2048;
constexpr int NEXP = 64, EFF = 256, NLIST = 65;
constexpr int PLE = 256;
constexpr float NORM_EPS = 1e-6f, LN_EPS = 1e-5f;
constexpr int NTHREADS = 512, NWAVES = 8;

constexpr size_t MiB = 1u << 20, KiB = 1u << 10;
constexpr size_t WS_CTL = 0, CTL_BYTES = 64 * KiB;
constexpr size_t WS_RSTD0 = 1 * MiB, WS_LNMU = WS_RSTD0 + 64 * KiB, WS_LNRS = WS_LNMU + 64 * KiB, WS_RSTD2 = WS_LNRS + 64 * KiB,
                 WS_RSTD3 = WS_RSTD2 + 64 * KiB, WS_RSTDPE = WS_RSTD3 + 64 * KiB;
constexpr size_t WS_PESTAT = 1 * MiB + 512 * KiB;
constexpr size_t WS_COS = 2 * MiB + 512 * KiB, WS_SIN = 4 * MiB + 512 * KiB;
static_assert(WS_RSTDPE + 64 * KiB <= WS_PESTAT && WS_PESTAT + (size_t)T_ * 64 <= WS_COS && WS_SIN + 2 * MiB <= 6 * MiB + 512 * KiB, "small map");
constexpr size_t WS_WIN = 6 * MiB + 512 * KiB;
constexpr size_t WS_WQB = WS_WIN + (size_t)NZ * DM * 2;
constexpr size_t WS_WKVB = WS_WQB + (size_t)QW * QLAT * 2;
constexpr size_t WS_WO = WS_WKVB + (size_t)KVW * KVLAT * 2;
constexpr size_t WS_SGUW = WS_WO + (size_t)DM * DM * 2;
constexpr size_t WS_WSHGU = WS_SGUW + (size_t)8 * 128 * 128 * 2;
constexpr size_t WS_WSHD = WS_WSHGU + (size_t)512 * DM * 2;
constexpr size_t WS_WPG = WS_WSHD + (size_t)DM * EFF * 2;
constexpr size_t WS_WPP = WS_WPG + (size_t)DM * DM * 2;
constexpr size_t WS_WSMALL_END = WS_WPP + (size_t)DM * PLE * 2;
static_assert(WS_WSMALL_END <= 25 * MiB, "small weights");
constexpr size_t WS_WRH = 25 * MiB, WS_WRL = 25 * MiB + 128 * KiB;
constexpr size_t WS_TOKE = 26 * MiB, WS_TOKW = WS_TOKE + 512 * KiB;
constexpr int LIST_CAP = 164096;
constexpr size_t WS_ENT = 27 * MiB, WS_INV = 30 * MiB, WS_TILEL = 31 * MiB;
constexpr size_t S0 = 32 * MiB, S1 = 64 * MiB, S2 = 96 * MiB, S3 = 128 * MiB, S4 = 160 * MiB, S5 = 192 * MiB, S6 = 224 * MiB, S7 = 256 * MiB;
constexpr size_t WS_XB = S0, WS_YAG = S0, WS_HSH = S0;
constexpr size_t WS_GU = S1, WS_GV = S2, WS_SA = S3, WS_LAT = S5, WS_SB = S7;
constexpr size_t WS_GVSTAT = S6, WS_LATSTAT = S6 + 2 * MiB, WS_KPE = S6 + 20 * MiB;
constexpr size_t WS_QRAW = S1, WS_KVRAW = S1 + 48 * MiB;
constexpr size_t WS_X1B = S1;
constexpr size_t WS_WGU = S3;
constexpr size_t WS_WD = S5;
constexpr size_t WS_ACT = S6;
constexpr size_t WS_YBUF = 47 * MiB;
constexpr size_t WS_X2B = S6, WS_PERAW = S7;
constexpr size_t WS_PB = 296 * MiB;
constexpr size_t WS_END = 304 * MiB;
static_assert(WS_KVRAW + (size_t)T_ * KVW * 2 <= S5 && WS_YBUF + (size_t)(T_ * 9) * 1024 <= S5 && WS_HSH + (size_t)T_ * EFF * 2 <= WS_YBUF && WS_ACT + (size_t)147456 * 512 <= WS_PB, "map");
constexpr int CW_CNT = 8192;
constexpr int CW_FILL = 192;
constexpr int CW_LSH = 512;
constexpr int CW_BAR = 4096;

__device__ __forceinline__ unsigned f2bf(float f) { unsigned u = __builtin_bit_cast(unsigned, f); return (u + 0x7fffu + ((u >> 16) & 1u)) >> 16; }
__device__ __forceinline__ float bf2f(unsigned h) { return __builtin_bit_cast(float, h << 16); }
__device__ __forceinline__ unsigned pk2(float lo, float hi) { unsigned r; asm volatile("v_cvt_pk_bf16_f32 %0, %1, %2" : "=v"(r) : "v"(lo), "v"(hi)); return r; }
__device__ __forceinline__ float bflo(unsigned w) { return __builtin_bit_cast(float, w << 16); }
__device__ __forceinline__ float bfhi(unsigned w) { return __builtin_bit_cast(float, w & 0xffff0000u); }
__device__ __forceinline__ float wave_sum(float v) {
#pragma unroll
    for (int o = 1; o < 64; o <<= 1) v += __shfl_xor(v, o);
    return v;
}
__device__ __forceinline__ float fast_sigmoid(float x) { return __builtin_amdgcn_rcpf(1.0f + __builtin_amdgcn_exp2f(-1.4426950408889634f * x)); }
__device__ __forceinline__ float gelu_tanh(float x) {
    const float u = 1.5957691216057308f * (x + 0.044715f * x * x * x);
    return x * fast_sigmoid(u);
}
__device__ __forceinline__ float silu(float x) { return x * fast_sigmoid(x); }

struct Params {
    const float* in[31];
    float* out;
    unsigned char* ws;
};
enum { I_X = 0, I_P, I_POS, I_GMIX, I_WIN, I_LNG, I_LNB, I_SGUW, I_SGUB, I_GQA, I_WQB, I_GKVA, I_WKVB, I_GQN, I_GKN, I_GQR, I_GKR, I_WO, I_GFFN, I_WR, I_BR,
       I_WEG, I_WEU, I_WED, I_WSG, I_WSU, I_WSD, I_GPI, I_WPG, I_WPP, I_GPO };
namespace pg8 {
constexpr int BM = 256, BK = 64, HALF = 128, HTB = HALF * BK * 2  , STAGE_BYTES = 8 * HTB;

__device__ __forceinline__ int lds_byte(int r, int c) { const int st = (r >> 4) * 2 + (c >> 5), rr = r & 15, cc = c & 31, ob = rr * 64 + cc * 2; return st * 1024 + (ob ^ (((ob >> 9) & 1) << 5)); }
__device__ __forceinline__ void stage_rc(int b, int& R, int& C) { const int st = b / 1024, sb = b % 1024, swz = sb ^ (((sb >> 9) & 1) << 5); R = (st >> 1) * 16 + swz / 64; C = (st & 1) * 32 + (swz % 64) / 2; }
__device__ __forceinline__ int perm32(int rho) { const int n = rho >> 4, i = rho & 15; return 8 * (i >> 2) + 4 * n + (i & 3); }

struct Unit { const char* A; const char* B; int pm, pn; };
struct Shape { int ldaB, ldbB, nt; const char* Abase; };

template <class Epi, class Sched, bool GATHER>
__device__ __forceinline__ void gemm_phase(LAS unsigned char* lds, const Shape sh, const Sched& S, const Epi& E) {
    const int tid = threadIdx.x, wid = __builtin_amdgcn_readfirstlane(tid >> 6), lane = tid & 63, wr = wid >> 2, wc = wid & 3, fr = lane & 15, fq = lane >> 4;
    const int nt = sh.nt;
    int Rr[2], Cc[2];
    unsigned voffB[2], voffA[2];
#pragma unroll
    for (int i = 0; i < 2; ++i) { stage_rc(tid * 16 + i * 8192, Rr[i], Cc[i]); const int Rb = Epi::PERM ? ((Rr[i] & ~31) + perm32(Rr[i] & 31)) : Rr[i];
        voffB[i] = (unsigned)(Rb * sh.ldbB + Cc[i] * 2); voffA[i] = (unsigned)(Rr[i] * sh.ldaB + Cc[i] * 2); }
    const size_t kstep = (size_t)(BK * 2);
    const size_t hstepB = (size_t)HALF * sh.ldbB, hstepA = (size_t)HALF * sh.ldaB;
    const unsigned ldsw = (unsigned)wid * 1024u;
    const int aoff = lds_byte(wr * 64 + fr, fq * 8), boff = lds_byte(wc * 32 + fr, fq * 8);
#define PG8_SA(b, h) (((b) * 2 + (h)) * HTB)
#define PG8_SB(b, h) ((4 + (b) * 2 + (h)) * HTB)
#define PG8_STAGE(bufoff, gbase, voff) do { _Pragma("unroll") for (int _i = 0; _i < 2; ++_i) \
        __builtin_amdgcn_global_load_lds((const unsigned*)((const char*)(gbase) + (voff)[_i]), (LAS unsigned*)(lds + (bufoff) + ldsw + _i * 8192), 16, 0, 0); } while (0)
#define PG8_STAGE_A(bufoff, gbase, h, oarr) do { if (GATHER) { PG8_STAGE(bufoff, gbase, (oarr)[h]); } else { PG8_STAGE(bufoff, (gbase) + (h) * hstepA, voffA); } } while (0)
#define PG8_LDA(dst, b, h) do { _Pragma("unroll") for (int m = 0; m < 4; ++m) _Pragma("unroll") for (int k = 0; k < 2; ++k) dst[m][k] = *(const LAS bf16x8*)(lds + PG8_SA(b, h) + aoff + m * 2048 + k * 1024); } while (0)
#define PG8_LDB(dst, b, h) do { _Pragma("unroll") for (int n = 0; n < 2; ++n) _Pragma("unroll") for (int k = 0; k < 2; ++k) dst[n][k] = *(const LAS bf16x8*)(lds + PG8_SB(b, h) + boff + n * 2048 + k * 1024); } while (0)
#define PG8_MMA(ai, bj, At, Bt) do { __builtin_amdgcn_s_setprio(1); _Pragma("unroll") for (int m = 0; m < 4; ++m) _Pragma("unroll") for (int n = 0; n < 2; ++n) _Pragma("unroll") for (int k = 0; k < 2; ++k) \
        acc[ai][bj][m][n] = __builtin_amdgcn_mfma_f32_16x16x32_bf16(Bt[n][k], At[m][k], acc[ai][bj][m][n], 0, 0, 0); __builtin_amdgcn_s_setprio(0); } while (0)
#define PG8_WAIT_V(n) asm volatile("s_waitcnt vmcnt(" #n ")" ::: "memory")
#define PG8_WAIT_L(n) asm volatile("s_waitcnt lgkmcnt(" #n ")" ::: "memory")
#define PG8_BAR __builtin_amdgcn_s_barrier()
#define PG8_SCHED __builtin_amdgcn_sched_barrier(0)
#define PG8_AOFF(o, u) do { _Pragma("unroll") for (int _h = 0; _h < 2; ++_h) _Pragma("unroll") for (int _i = 0; _i < 2; ++_i) { \
        if (GATHER) o[_h][_i] = (unsigned)(((const int*)(u).A)[(_h * HALF + Rr[_i]) * 4]) * (unsigned)sh.ldaB + (unsigned)(Cc[_i] * 2); \
        else o[_h][_i] = 0u; } } while (0)
    Unit cur, nxt; int ui = 0;
    if (!S.next(0, cur)) return;
    f32x4 acc[2][2][4][2];
#pragma unroll
    for (int a = 0; a < 2; ++a)
#pragma unroll
        for (int b = 0; b < 2; ++b)
#pragma unroll
            for (int m = 0; m < 4; ++m)
#pragma unroll
                for (int n = 0; n < 2; ++n) acc[a][b][m][n] = (f32x4){0.f, 0.f, 0.f, 0.f};
    bf16x8 At[4][2], B0[2][2], B1[2][2];
    unsigned oC[2][2], oN[2][2];
    PG8_AOFF(oC, cur);
    const char* cA = GATHER ? sh.Abase : cur.A; const char* cB = cur.B;
    PG8_STAGE(PG8_SB(0, 0), cB, voffB); PG8_STAGE(PG8_SB(0, 1), cB + hstepB, voffB); PG8_STAGE_A(PG8_SA(0, 0), cA, 0, oC); PG8_STAGE_A(PG8_SA(0, 1), cA, 1, oC);
    if (wr == 1) PG8_BAR;
    PG8_WAIT_V(2); PG8_BAR;
    PG8_STAGE(PG8_SB(1, 0), cB + kstep, voffB); PG8_STAGE_A(PG8_SA(1, 0), cA + kstep, 0, oC); PG8_STAGE(PG8_SB(1, 1), cB + hstepB + kstep, voffB);
    PG8_WAIT_V(6); PG8_BAR;
    for (;;) {
        const bool has_next = S.next(ui + 1, nxt);
        const char* nA = GATHER ? cA : (has_next ? nxt.A : cA); const char* nB = has_next ? nxt.B : cB;
        if (GATHER) { if (has_next) { PG8_AOFF(oN, nxt); } else {
#pragma unroll
            for (int h = 0; h < 2; ++h)
#pragma unroll
                for (int i = 0; i < 2; ++i) oN[h][i] = oC[h][i]; } }
#pragma unroll 1
        for (int t = 0; t < nt; t += 2) {
            const bool last = (t == nt - 2);
            const char* a1 = cA + (size_t)(t + 1) * kstep;
            const char* a2 = last ? nA : cA + (size_t)(t + 2) * kstep; const char* b2 = last ? nB : cB + (size_t)(t + 2) * kstep;
            const char* a3 = a2 + kstep; const char* b3 = b2 + kstep;
            unsigned o2[2][2];
#pragma unroll
            for (int h = 0; h < 2; ++h)
#pragma unroll
                for (int i = 0; i < 2; ++i) o2[h][i] = (GATHER && last) ? oN[h][i] : oC[h][i];
            PG8_LDB(B0, 0, 0); PG8_LDB(B1, 0, 1); PG8_SCHED; PG8_LDA(At, 0, 0); PG8_STAGE_A(PG8_SA(1, 1), a1, 1, oC);
            PG8_WAIT_V(8); PG8_WAIT_L(0); PG8_BAR; PG8_MMA(0, 0, At, B0); PG8_MMA(0, 1, At, B1); PG8_BAR; PG8_SCHED;
            PG8_LDA(At, 0, 1); PG8_STAGE(PG8_SB(0, 0), b2, voffB); PG8_STAGE(PG8_SB(0, 1), b2 + hstepB, voffB); PG8_STAGE_A(PG8_SA(0, 0), a2, 0, o2);
            PG8_WAIT_V(8); PG8_WAIT_L(0); PG8_BAR; PG8_MMA(1, 0, At, B0); PG8_MMA(1, 1, At, B1); PG8_BAR; PG8_SCHED;
            PG8_LDB(B0, 1, 0); PG8_LDB(B1, 1, 1); PG8_SCHED; PG8_LDA(At, 1, 0); PG8_STAGE_A(PG8_SA(0, 1), a2, 1, o2);
            PG8_WAIT_V(8); PG8_WAIT_L(0); PG8_BAR; PG8_MMA(0, 0, At, B0); PG8_MMA(0, 1, At, B1); PG8_BAR; PG8_SCHED;
            PG8_LDA(At, 1, 1); PG8_STAGE(PG8_SB(1, 0), b3, voffB); PG8_STAGE(PG8_SB(1, 1), b3 + hstepB, voffB); PG8_STAGE_A(PG8_SA(1, 0), a3, 0, o2);
            PG8_WAIT_V(8); PG8_WAIT_L(0); PG8_BAR; PG8_MMA(1, 0, At, B0); PG8_MMA(1, 1, At, B1); PG8_BAR; PG8_SCHED;
        }
        if (wr == 0) PG8_BAR;
        E(acc, cur, wr, wc, fr, fq);
        if (!has_next) break;
#pragma unroll
        for (int a = 0; a < 2; ++a)
#pragma unroll
            for (int b = 0; b < 2; ++b)
#pragma unroll
                for (int m = 0; m < 4; ++m)
#pragma unroll
                    for (int n = 0; n < 2; ++n) acc[a][b][m][n] = (f32x4){0.f, 0.f, 0.f, 0.f};
        cur = nxt; cA = nA; cB = nB; ++ui;
        if (GATHER) {
#pragma unroll
            for (int h = 0; h < 2; ++h)
#pragma unroll
                for (int i = 0; i < 2; ++i) oC[h][i] = oN[h][i]; }
        if (wr == 1) PG8_BAR;
    }
    PG8_WAIT_V(0);
    PG8_BAR;
#undef PG8_SA
#undef PG8_SB
#undef PG8_STAGE
#undef PG8_STAGE_A
#undef PG8_LDA
#undef PG8_LDB
#undef PG8_MMA
#undef PG8_WAIT_V
#undef PG8_WAIT_L
#undef PG8_BAR
#undef PG8_SCHED
#undef PG8_AOFF
}
}
__device__ __forceinline__ int vcu_of(int bx, int G) { return (G % 8 == 0) ? (bx % 8) * (G / 8) + bx / 8 : bx; }

struct DenseSched {
    const char* A; const char* B; int nM, nN, G, c, ldaB, ldbB;
    __device__ __forceinline__ bool next(int i, pg8::Unit& u) const {
        const int L = i * G + c; if (L >= nM * nN) return false;
        const int nig = 8 * nN, gid = L / nig, fm = gid * 8, gsz = (nM - fm) < 8 ? (nM - fm) : 8;
        u.pm = fm + ((L % nig) % gsz); u.pn = (L % nig) / gsz;
        u.A = A + (size_t)u.pm * 256 * ldaB; u.B = B + (size_t)u.pn * 256 * ldbB; return true;
    }
};

__device__ __forceinline__ void store8bf(bf16_t* p, f32x4 a, f32x4 b) { u32x4 w; w.x = pk2(a[0], a[1]); w.y = pk2(a[2], a[3]); w.z = pk2(b[0], b[1]); w.w = pk2(b[2], b[3]); *(u32x4*)p = w; }

struct EpiG1 {
    static constexpr bool PERM = true;
    unsigned char* ws;
    __device__ __forceinline__ void operator()(const f32x4 (&acc)[2][2][4][2], const pg8::Unit& u, int wr, int wc, int fr, int fq) const {
        const float* rstd = (const float*)(ws + WS_RSTD0);
        const int pn = u.pn; const int seg = pn < 8 ? 0 : (pn >> 2) - 1;
        const int row0 = u.pm * 256 + wr * 64 + fr;
        if (seg == 0) {
            bf16_t* gs = (bf16_t*)(ws + WS_GU); const int col0 = pn * 128 + wc * 32 + 8 * fq;
#pragma unroll
            for (int ai = 0; ai < 2; ++ai)
#pragma unroll
                for (int m = 0; m < 4; ++m) { const int row = row0 + ai * 128 + m * 16; const float rs = rstd[row];
                    f32x4 a0 = acc[ai][0][m][0] * rs, a1 = acc[ai][0][m][1] * rs, g0 = acc[ai][1][m][0] * rs, g1 = acc[ai][1][m][1] * rs;
#pragma unroll
                    for (int j = 0; j < 4; ++j) { a0[j] = gelu_tanh(a0[j]) * fast_sigmoid(g0[j]); a1[j] = gelu_tanh(a1[j]) * fast_sigmoid(g1[j]); }
                    store8bf(gs + (size_t)row * DM + col0, a0, a1); }
            return; }
        bf16_t* base; int ldc, colt;
        if (seg == 1) { base = (bf16_t*)(ws + WS_GV); ldc = DM; colt = (pn - 8) * 256; }
        else if (seg == 2) { base = (bf16_t*)(ws + WS_SB); ldc = DM; colt = (pn - 12) * 256; }
        else { base = (bf16_t*)(ws + WS_LAT); ldc = LATW; colt = (pn - 16) * 256; }
        const int act = seg == 1 ? 1 : (seg == 2 ? 2 : 0);
        const int col0 = colt + wc * 32 + 8 * fq;
        float* gvstat = (float*)(ws + WS_GVSTAT); float* latstat = (float*)(ws + WS_LATSTAT);
#pragma unroll
        for (int ai = 0; ai < 2; ++ai)
#pragma unroll
            for (int m = 0; m < 4; ++m) { const int row = row0 + ai * 128 + m * 16; const float rs = rstd[row]; bf16_t* rowp = base + (size_t)row * ldc + col0;
                float s1 = 0.f, q0 = 0.f, q1 = 0.f;
#pragma unroll
                for (int bj = 0; bj < 2; ++bj) { f32x4 v0 = acc[ai][bj][m][0] * rs, v1 = acc[ai][bj][m][1] * rs;
                    if (act == 1) {
#pragma unroll
                        for (int j = 0; j < 4; ++j) { v0[j] = gelu_tanh(v0[j]); v1[j] = gelu_tanh(v1[j]); } }
                    else if (act == 2) {
#pragma unroll
                        for (int j = 0; j < 4; ++j) { v0[j] = fast_sigmoid(v0[j]); v1[j] = fast_sigmoid(v1[j]); } }
                    store8bf(rowp + bj * 128, v0, v1);
                    if (seg == 1 || seg == 3) { const float sq = (v0[0] * v0[0] + v0[1] * v0[1]) + (v0[2] * v0[2] + v0[3] * v0[3]) + (v1[0] * v1[0] + v1[1] * v1[1]) + (v1[2] * v1[2] + v1[3] * v1[3]);
                        s1 += (v0[0] + v0[1]) + (v0[2] + v0[3]) + (v1[0] + v1[1]) + (v1[2] + v1[3]); if (bj == 0) q0 = sq; else q1 = sq; } }
                if (seg == 1) { float q = q0 + q1; s1 += __shfl_xor(s1, 16); s1 += __shfl_xor(s1, 32); q += __shfl_xor(q, 16); q += __shfl_xor(q, 32);
                    if (fq == 0) { f32x2 o = {s1, q}; *(f32x2*)(gvstat + (size_t)row * 32 + 2 * ((pn - 8) * 4 + wc)) = o; } }
                else if (seg == 3) { q0 += __shfl_xor(q0, 16); q0 += __shfl_xor(q0, 32); q1 += __shfl_xor(q1, 16); q1 += __shfl_xor(q1, 32);
                    if (fq == 0) { if (pn == 16) latstat[row * 16 + wc] = q0 + q1; else if (pn == 17) latstat[row * 16 + 4 + wc] = q0 + q1; else { latstat[row * 16 + 8 + wc] = q0; latstat[row * 16 + 12 + wc] = q1; } } }
            }
    }
};
struct EpiBf16 {
    static constexpr bool PERM = true;
    bf16_t* O; int ldc;
    __device__ __forceinline__ void operator()(const f32x4 (&acc)[2][2][4][2], const pg8::Unit& u, int wr, int wc, int fr, int fq) const {
        const int row0 = u.pm * 256 + wr * 64 + fr, col0 = u.pn * 256 + wc * 32 + 8 * fq;
#pragma unroll
        for (int ai = 0; ai < 2; ++ai)
#pragma unroll
            for (int m = 0; m < 4; ++m) { bf16_t* rowp = O + (size_t)(row0 + ai * 128 + m * 16) * ldc + col0;
#pragma unroll
                for (int bj = 0; bj < 2; ++bj) store8bf(rowp + bj * 128, acc[ai][bj][m][0], acc[ai][bj][m][1]); }
    }
};
constexpr int PART_OFF = 131072 + 1024;
__device__ __forceinline__ float sumsq8(const f32x4 a, const f32x4 b) { return (a[0] * a[0] + a[1] * a[1]) + (a[2] * a[2] + a[3] * a[3]) + (b[0] * b[0] + b[1] * b[1]) + (b[2] * b[2] + b[3] * b[3]); }
struct EpiQ {
    static constexpr bool PERM = true;
    unsigned char* ws; LAS unsigned char* lds; const float* gqn; const float* gqr;
    __device__ __forceinline__ void operator()(const f32x4 (&acc)[2][2][4][2], const pg8::Unit& u, int wr, int wc, int fr, int fq) const {
        LAS float* part = (LAS float*)(lds + PART_OFF);
        const float* latstat = (const float*)(ws + WS_LATSTAT); bf16_t* Q = (bf16_t*)(ws + WS_QRAW);
        const float* cs = (const float*)(ws + WS_COS); const float* sn = (const float*)(ws + WS_SIN);
        const float scale = 0.07216878364870322f;
        const int pn = u.pn; const bool rope = pn >= 4;
        { int t_ = threadIdx.x; asm volatile("" : "+v"(t_)); fr = t_ & 15; fq = (t_ >> 4) & 3; wc = (t_ >> 6) & 3; wr = t_ >> 8; }
        const int trow0 = wr * 64 + fr, row0 = u.pm * 256 + trow0;
        float rq[2][4];
#pragma unroll
        for (int ai = 0; ai < 2; ++ai)
#pragma unroll
            for (int m = 0; m < 4; ++m) { const int row = row0 + ai * 128 + m * 16; const f32x4 a = *(const f32x4*)(latstat + row * 16 + 4), b = *(const f32x4*)(latstat + row * 16 + 8);
                rq[ai][m] = 1.0f / sqrtf((((a[0] + a[1]) + (a[2] + a[3])) + ((b[0] + b[1]) + (b[2] + b[3]))) * (1.0f / QLAT) + NORM_EPS);
#pragma unroll
                for (int bj = 0; bj < 2; ++bj) { float s = sumsq8(acc[ai][bj][m][0], acc[ai][bj][m][1]) * (rq[ai][m] * rq[ai][m]); s += __shfl_xor(s, 16); s += __shfl_xor(s, 32);
                    if (fq == 0) part[((trow0 + ai * 128 + m * 16) * 2 + bj) * 4 + wc] = s; }
                asm volatile("" ::: "memory"); }
        asm volatile("s_waitcnt lgkmcnt(0)" ::: "memory"); __builtin_amdgcn_s_barrier(); asm volatile("" ::: "memory");
        if (!rope) {
            const f32x4 g0 = *(const f32x4*)(gqn + wc * 32 + 8 * fq), g1 = *(const f32x4*)(gqn + wc * 32 + 8 * fq + 4);
#pragma unroll
            for (int ai = 0; ai < 2; ++ai)
#pragma unroll
                for (int m = 0; m < 4; ++m) { const int tr = trow0 + ai * 128 + m * 16; const int row = u.pm * 256 + tr;
#pragma unroll
                    for (int bj = 0; bj < 2; ++bj) { const f32x4 pp = *(const LAS f32x4*)(part + (tr * 2 + bj) * 4); const float tot = (pp[0] + pp[1]) + (pp[2] + pp[3]);
                        const float f = rq[ai][m] * (1.0f / sqrtf(tot * (1.0f / 128) + NORM_EPS)) * scale;
                        store8bf(Q + (size_t)row * QW + (2 * pn + bj) * 192 + wc * 32 + 8 * fq, acc[ai][bj][m][0] * f * g0, acc[ai][bj][m][1] * f * g1); }
                    asm volatile("" ::: "memory"); }
        } else {
            const int g = 4 * (wc & 1) + fq;
            const f32x4 g0 = *(const f32x4*)(gqr + 4 * g), g1 = *(const f32x4*)(gqr + 32 + 4 * g);
#pragma unroll
            for (int ai = 0; ai < 2; ++ai)
#pragma unroll
                for (int m = 0; m < 4; ++m) { const int tr = trow0 + ai * 128 + m * 16; const int row = u.pm * 256 + tr;
                    const f32x4 c = *(const f32x4*)(cs + row * 32 + 4 * g), s = *(const f32x4*)(sn + row * 32 + 4 * g);
#pragma unroll
                    for (int bj = 0; bj < 2; ++bj) { const LAS float* pp = part + (tr * 2 + bj) * 4 + (wc & 2); const float tot = pp[0] + pp[1];
                        const float f = rq[ai][m] * (1.0f / sqrtf(tot * (1.0f / ROPE) + NORM_EPS));
                        const f32x4 y1 = acc[ai][bj][m][0] * f * g0, y2 = acc[ai][bj][m][1] * f * g1;
                        const int hd = (pn - 4) * 4 + 2 * bj + (wc >> 1);
                        store8bf(Q + (size_t)row * QW + hd * 192 + 128 + 8 * g, (y1 * c - y2 * s) * scale, (y2 * c + y1 * s) * scale); }
                    asm volatile("" ::: "memory"); }
        }
    }
};
struct EpiKV {
    static constexpr bool PERM = true;
    unsigned char* ws; LAS unsigned char* lds; const float* gkn;
    __device__ __forceinline__ void operator()(const f32x4 (&acc)[2][2][4][2], const pg8::Unit& u, int wr, int wc, int fr, int fq) const {
        LAS float* part = (LAS float*)(lds + PART_OFF);
        const float* latstat = (const float*)(ws + WS_LATSTAT); bf16_t* KV = (bf16_t*)(ws + WS_KVRAW);
        { int t_ = threadIdx.x; asm volatile("" : "+v"(t_)); fr = t_ & 15; fq = (t_ >> 4) & 3; wc = (t_ >> 6) & 3; wr = t_ >> 8; }
        const int trow0 = wr * 64 + fr, row0 = u.pm * 256 + trow0;
        float rk[2][4];
#pragma unroll
        for (int ai = 0; ai < 2; ++ai)
#pragma unroll
            for (int m = 0; m < 4; ++m) { const int row = row0 + ai * 128 + m * 16; const f32x4 a = *(const f32x4*)(latstat + row * 16);
                rk[ai][m] = 1.0f / sqrtf(((a[0] + a[1]) + (a[2] + a[3])) * (1.0f / KVLAT) + NORM_EPS);
                float s = sumsq8(acc[ai][0][m][0], acc[ai][0][m][1]) * (rk[ai][m] * rk[ai][m]); s += __shfl_xor(s, 16); s += __shfl_xor(s, 32);
                if (fq == 0) part[((trow0 + ai * 128 + m * 16) * 2) * 4 + wc] = s;
                asm volatile("" ::: "memory"); }
        asm volatile("s_waitcnt lgkmcnt(0)" ::: "memory"); __builtin_amdgcn_s_barrier(); asm volatile("" ::: "memory");
        const f32x4 g0 = *(const f32x4*)(gkn + wc * 32 + 8 * fq), g1 = *(const f32x4*)(gkn + wc * 32 + 8 * fq + 4);
#pragma unroll
        for (int ai = 0; ai < 2; ++ai)
#pragma unroll
            for (int m = 0; m < 4; ++m) { const int tr = trow0 + ai * 128 + m * 16; const int row = u.pm * 256 + tr;
                const f32x4 pp = *(const LAS f32x4*)(part + (tr * 2) * 4); const float tot = (pp[0] + pp[1]) + (pp[2] + pp[3]);
                const float f = rk[ai][m] * (1.0f / sqrtf(tot * (1.0f / 128) + NORM_EPS));
                bf16_t* rowp = KV + (size_t)row * KVW + u.pn * 256 + wc * 32 + 8 * fq;
                store8bf(rowp, acc[ai][0][m][0] * f * g0, acc[ai][0][m][1] * f * g1);
                store8bf(rowp + 128, acc[ai][1][m][0] * rk[ai][m], acc[ai][1][m][1] * rk[ai][m]);
                asm volatile("" ::: "memory"); }
    }
};
struct EpiG4 {
    static constexpr bool PERM = false;
    const float* x; bf16_t* x1b;
    __device__ __forceinline__ void operator()(const f32x4 (&acc)[2][2][4][2], const pg8::Unit& u, int wr, int wc, int fr, int fq) const {
        const int row0 = u.pm * 256 + wr * 64 + fr, col0 = u.pn * 256 + wc * 32 + 4 * fq;
#pragma unroll
        for (int ai = 0; ai < 2; ++ai)
#pragma unroll
            for (int m = 0; m < 4; ++m) { const size_t off = (size_t)(row0 + ai * 128 + m * 16) * DM + col0;
#pragma unroll
                for (int bj = 0; bj < 2; ++bj)
#pragma unroll
                    for (int n = 0; n < 2; ++n) { const size_t o = off + bj * 128 + n * 16; const f32x4 v = *(const f32x4*)(x + o) + acc[ai][bj][m][n];
                        u32x2 w; w.x = pk2(v[0], v[1]); w.y = pk2(v[2], v[3]); *(u32x2*)(x1b + o) = w; } }
    }
};
struct EpiG6 {
    static constexpr bool PERM = true;
    bf16_t* O; float* pestat;
    __device__ __forceinline__ void operator()(const f32x4 (&acc)[2][2][4][2], const pg8::Unit& u, int wr, int wc, int fr, int fq) const {
        const int row0 = u.pm * 256 + wr * 64 + fr, col0 = u.pn * 256 + wc * 32 + 8 * fq;
#pragma unroll
        for (int ai = 0; ai < 2; ++ai)
#pragma unroll
            for (int m = 0; m < 4; ++m) { const int row = row0 + ai * 128 + m * 16; bf16_t* rowp = O + (size_t)row * DM + col0; float s = 0.f;
#pragma unroll
                for (int bj = 0; bj < 2; ++bj) { const f32x4 v0 = acc[ai][bj][m][0], v1 = acc[ai][bj][m][1]; store8bf(rowp + bj * 128, v0, v1);
                    s += (v0[0] * v0[0] + v0[1] * v0[1]) + (v0[2] * v0[2] + v0[3] * v0[3]) + (v1[0] * v1[0] + v1[1] * v1[1]) + (v1[2] * v1[2] + v1[3] * v1[3]); }
                s += __shfl_xor(s, 16); s += __shfl_xor(s, 32);
                if (fq == 0) pestat[row * 16 + u.pn * 4 + wc] = s; }
    }
};
struct EpiG5 {
    static constexpr bool PERM = false;
    float* out; const bf16_t* pe; const bf16_t* x2b; const float* rstd3; const float* pestat; const float* gout;
    __device__ __forceinline__ void operator()(const f32x4 (&acc)[2][2][4][2], const pg8::Unit& u, int wr, int wc, int fr, int fq) const {
        const int row0 = u.pm * 256 + wr * 64 + fr, col0 = u.pn * 256 + wc * 32 + 4 * fq;
        f32x4 gv[2][2];
#pragma unroll
        for (int bj = 0; bj < 2; ++bj)
#pragma unroll
            for (int n = 0; n < 2; ++n) gv[bj][n] = *(const f32x4*)(gout + col0 + bj * 128 + n * 16);
#pragma unroll
        for (int ai = 0; ai < 2; ++ai)
#pragma unroll
            for (int m = 0; m < 4; ++m) { const int row = row0 + ai * 128 + m * 16; const size_t off = (size_t)row * DM + col0; const float r3 = rstd3[row];
                const f32x4* ps = (const f32x4*)(pestat + row * 16); const f32x4 p0 = ps[0], p1 = ps[1], p2 = ps[2], p3 = ps[3];
                const float sq = ((p0[0] + p0[1]) + (p0[2] + p0[3])) + ((p1[0] + p1[1]) + (p1[2] + p1[3])) + ((p2[0] + p2[1]) + (p2[2] + p2[3])) + ((p3[0] + p3[1]) + (p3[2] + p3[3]));
                const float rp = 1.0f / sqrtf(sq * (1.0f / DM) + NORM_EPS);
#pragma unroll
                for (int bj = 0; bj < 2; ++bj)
#pragma unroll
                    for (int n = 0; n < 2; ++n) { const size_t o = off + bj * 128 + n * 16; const u32x2 pw = *(const u32x2*)(pe + o); const u32x2 xw = *(const u32x2*)(x2b + o); const f32x4 xv = {bflo(xw.x), bfhi(xw.x), bflo(xw.y), bfhi(xw.y)};
                        const f32x4 a = acc[ai][bj][m][n]; f32x4 r;
                        r[0] = xv[0] + fast_sigmoid(a[0] * r3) * (bflo(pw.x) * rp * gv[bj][n][0]);
                        r[1] = xv[1] + fast_sigmoid(a[1] * r3) * (bfhi(pw.x) * rp * gv[bj][n][1]);
                        r[2] = xv[2] + fast_sigmoid(a[2] * r3) * (bflo(pw.y) * rp * gv[bj][n][2]);
                        r[3] = xv[3] + fast_sigmoid(a[3] * r3) * (bfhi(pw.y) * rp * gv[bj][n][3]);
                        *(f32x4*)(out + o) = r; }
                asm volatile("" ::: "memory"); }
    }
};

struct MoeGuSched {
    unsigned char* ws; const LAS int* tl; int ntiles, G, c;
    __device__ __forceinline__ bool next(int i, pg8::Unit& u) const {
        const int L = i * G + c; if (L >= ntiles * 2) return false;
        const int rt = L >> 1, pn = L & 1, li = __builtin_amdgcn_readfirstlane(tl[rt]);
        u.pm = rt; u.pn = pn | (li == 64 ? 256 : 0); u.A = (const char*)((const u32x4*)(ws + WS_ENT) + rt * 256);
        u.B = (const char*)(li == 64 ? ws + WS_WSHGU : ws + WS_WGU + (size_t)li * 512 * DM * 2) + (size_t)pn * 256 * DM * 2; return true;
    }
};
struct EpiGu {
    static constexpr bool PERM = true;
    unsigned char* ws; int off64;
    __device__ __forceinline__ void operator()(const f32x4 (&acc)[2][2][4][2], const pg8::Unit& u, int wr, int wc, int fr, int fq) const {
        bf16_t* base = (u.pn & 256) ? (bf16_t*)(ws + WS_HSH) - (size_t)off64 * EFF : (bf16_t*)(ws + WS_ACT);
        const u32x4* ent = (const u32x4*)(ws + WS_ENT);
        const int row0 = u.pm * 256 + wr * 64 + fr, col0 = (u.pn & 1) * 128 + wc * 32 + 8 * fq;
#pragma unroll
        for (int ai = 0; ai < 2; ++ai)
#pragma unroll
            for (int m = 0; m < 4; ++m) { const int idx = row0 + ai * 128 + m * 16; const u32x4 en = ent[idx]; const float s = __uint_as_float(en.w), w = __uint_as_float(en.z);
                f32x4 g0 = acc[ai][0][m][0] * s, g1 = acc[ai][0][m][1] * s, u0 = acc[ai][1][m][0] * (s * w), u1 = acc[ai][1][m][1] * (s * w);
#pragma unroll
                for (int j = 0; j < 4; ++j) { g0[j] = silu(g0[j]) * u0[j]; g1[j] = silu(g1[j]) * u1[j]; }
                store8bf(base + (size_t)idx * EFF + col0, g0, g1); }
    }
};
struct MoeDownSched {
    unsigned char* ws; const LAS int* tl; int ntiles, G, c, off64;
    __device__ __forceinline__ bool next(int i, pg8::Unit& u) const {
        const int L = (i >> 1) * G + c; if (L >= ntiles * 2) return false;
        const int rt = L >> 1, pn = (L & 1) * 2 + (i & 1), li = __builtin_amdgcn_readfirstlane(tl[rt]);
        u.pm = rt; u.pn = pn | (li << 8);
        u.A = (const char*)((li == 64) ? ws + WS_HSH + (size_t)(rt * 256 - off64) * EFF * 2 : ws + WS_ACT + (size_t)rt * 256 * EFF * 2);
        u.B = (const char*)(li == 64 ? ws + WS_WSHD : ws + WS_WD + (size_t)li * DM * EFF * 2) + (size_t)pn * 256 * EFF * 2; return true;
    }
};
struct EpiDown {
    static constexpr bool PERM = true;
    unsigned char* ws; const LAS int* lsh;
    __device__ __forceinline__ void operator()(const f32x4 (&acc)[2][2][4][2], const pg8::Unit& u, int wr, int wc, int fr, int fq) const {
        unsigned char* ybuf = ws + WS_YBUF; const int li = u.pn >> 8, pn = u.pn & 255;
        const int shift = lsh[li], lim = lsh[128 + li];
        const int row0 = u.pm * 256 + wr * 64 + fr; const unsigned col0 = (unsigned)(pn * 256 + wc * 32 + 8 * fq);
#pragma unroll
        for (int ai = 0; ai < 2; ++ai)
#pragma unroll
            for (int m = 0; m < 4; ++m) { const int row = row0 + ai * 128 + m * 16;
                if (row < lim) { const unsigned o = (unsigned)(row - shift) * 1024u + col0;
#pragma unroll
                    for (int bj = 0; bj < 2; ++bj) { const f32x4 v0 = acc[ai][bj][m][0], v1 = acc[ai][bj][m][1];
                        int w0 = __builtin_amdgcn_cvt_pk_fp8_f32(v0[0], v0[1], 0, false); w0 = __builtin_amdgcn_cvt_pk_fp8_f32(v0[2], v0[3], w0, true);
                        int w1 = __builtin_amdgcn_cvt_pk_fp8_f32(v1[0], v1[1], 0, false); w1 = __builtin_amdgcn_cvt_pk_fp8_f32(v1[2], v1[3], w1, true);
                        u32x2 w; w.x = (unsigned)w0; w.y = (unsigned)w1; *(u32x2*)(ybuf + o + bj * 128) = w; } } }
    }
};
struct Ctx {
    LAS unsigned char* lds; unsigned char* ws; int tid, lane, wave, vcu, G;
};
#define LDS_WAIT() asm volatile("s_waitcnt lgkmcnt(0)" ::: "memory")

__device__ __forceinline__ void tr_item(const float* W, int ldw, int k0, int src0, bf16_t* WT, int ldt, int dst0, const float* gain, LAS float* scr, int lane, bool ropeperm = false) {
    const int c4 = (lane & 15) * 4, r0 = lane >> 4;
    f32x4 v[16];
#pragma unroll
    for (int i = 0; i < 16; ++i) v[i] = *(const f32x4*)(W + (size_t)(k0 + 4 * i + r0) * ldw + src0 + c4);
    if (gain) {
#pragma unroll
        for (int i = 0; i < 16; ++i) v[i] = v[i] * gain[k0 + 4 * i + r0]; }
    const int c = lane & 7;
#pragma unroll
    for (int half = 0; half < 2; ++half) {
        if (((lane & 15) >> 3) == half) {
#pragma unroll
            for (int i = 0; i < 16; ++i) { LAS float* d = scr + (4 * i + r0) * 33 + (c4 - 32 * half); d[0] = v[i][0]; d[1] = v[i][1]; d[2] = v[i][2]; d[3] = v[i][3]; } }
        LDS_WAIT(); asm volatile("" ::: "memory");
#pragma unroll
        for (int j = 0; j < 4; ++j) { const int n = (lane >> 3) + 8 * j; const LAS float* s = scr + (8 * c) * 33 + n;
            u32x4 o; o.x = pk2(s[0 * 33], s[1 * 33]); o.y = pk2(s[2 * 33], s[3 * 33]); o.z = pk2(s[4 * 33], s[5 * 33]); o.w = pk2(s[6 * 33], s[7 * 33]);
            const int drow = ropeperm ? 8 * (n >> 2) + 4 * half + (n & 3) : 32 * half + n;
            *(u32x4*)(WT + (size_t)(dst0 + drow) * ldt + k0 + 8 * c) = o; }
        LDS_WAIT(); asm volatile("" ::: "memory");
    }
}
struct TrJob { const float* W; int ldw, K, ncols, src0; bf16_t* WT; int dst0; const float* gain; bool ropeperm; };
__device__ __forceinline__ int trjob_items(const TrJob& j) { return (j.K / 64) * (j.ncols / 64); }
__device__ __forceinline__ void trjob_run(const TrJob& j, int item, LAS float* scr, int lane) {
    const int nblk = j.ncols / 64, kb = item / nblk, nb = item % nblk;
    tr_item(j.W, j.ldw, kb * 64, j.src0 + nb * 64, j.WT, j.K, j.dst0 + nb * 64, j.gain, scr, lane, j.ropeperm);
}

struct JobDesc { int in_idx, ldw, K, ncols, src0; unsigned wt_off; int dst0, gain_idx, perm; };
#define QJ(h) {I_WQB, QW, QLAT, 128, (h) * 192, (unsigned)WS_WQB, (h) * 128, I_GQA, 0}
#define RJ(h) {I_WQB, QW, QLAT, 64, (h) * 192 + 128, (unsigned)WS_WQB, 1024 + (h) * 64, I_GQA, 1}
#define UJ(j) {I_WIN, 4800, DM, 128, 128 * (j), (unsigned)WS_WIN, 256 * (j), I_GMIX, 0}, {I_WIN, 4800, DM, 128, 2752 + 128 * (j), (unsigned)WS_WIN, 256 * (j) + 128, I_GMIX, 0}
constexpr int NJOBS = 46, NESS = 21;
__constant__ JobDesc JOBS[NJOBS] = {
    UJ(0), UJ(1), UJ(2), UJ(3), UJ(4), UJ(5), UJ(6), UJ(7),
    {I_WIN, 4800, DM, 1024, 1024, (unsigned)WS_WIN, 2048, I_GMIX, 0},
    {I_WIN, 4800, DM, 1024, 3776, (unsigned)WS_WIN, 3072, I_GMIX, 0},
    {I_WIN, 4800, DM, 256, 2432, (unsigned)WS_WIN, 4096, I_GMIX, 0},
    {I_WIN, 4800, DM, 384, 2048, (unsigned)WS_WIN, 4352, I_GMIX, 0},
    {I_WIN, 4800, DM, 64, 2688, (unsigned)WS_WIN, 4736, I_GMIX, 0},
    {I_WKVB, KVW, KVLAT, KVW, 0, (unsigned)WS_WKVB, 0, I_GKVA, 0},
    {I_WO, DM, DM, DM, 0, (unsigned)WS_WO, 0, -1, 0},
    {I_WSG, EFF, DM, 128, 0, (unsigned)WS_WSHGU, 0, I_GFFN, 0}, {I_WSG, EFF, DM, 128, 128, (unsigned)WS_WSHGU, 256, I_GFFN, 0},
    {I_WSU, EFF, DM, 128, 0, (unsigned)WS_WSHGU, 128, I_GFFN, 0}, {I_WSU, EFF, DM, 128, 128, (unsigned)WS_WSHGU, 384, I_GFFN, 0},
    {I_WSD, DM, EFF, DM, 0, (unsigned)WS_WSHD, 0, -1, 0},
    {I_WPG, DM, DM, DM, 0, (unsigned)WS_WPG, 0, I_GPI, 0},
    {I_WPP, DM, PLE, DM, 0, (unsigned)WS_WPP, 0, -1, 0},
    QJ(0), QJ(1), QJ(2), QJ(3), QJ(4), QJ(5), QJ(6), QJ(7), RJ(0), RJ(1), RJ(2), RJ(3), RJ(4), RJ(5), RJ(6), RJ(7)};
#undef QJ
#undef RJ
#undef UJ

__device__ __forceinline__ void phase_prep0(const Params& P, const Ctx& C) {
    LAS float* scr = (LAS float*)(C.lds + C.wave * 16384);
    unsigned char* ws = C.ws;
    const int gw = C.vcu * NWAVES + C.wave, NGW = C.G * NWAVES, lane = C.lane;
    int total = 0;
#pragma unroll
    for (int j = 0; j < NESS; ++j) total += (JOBS[j].K / 64) * (JOBS[j].ncols / 64);
    for (int it = gw; it < total; it += NGW) {
        int r = it, jj = 0;
        for (int j = 0; j < NESS; ++j) { const int n = (JOBS[j].K / 64) * (JOBS[j].ncols / 64); if (r >= n) { r -= n; jj = j + 1; } else break; }
        const JobDesc d = JOBS[jj];
        TrJob j{P.in[d.in_idx], d.ldw, d.K, d.ncols, d.src0, (bf16_t*)(ws + d.wt_off), d.dst0, d.gain_idx >= 0 ? P.in[d.gain_idx] : nullptr, d.perm != 0};
        trjob_run(j, r, scr, lane);
    }
    bf16_t* WinT = (bf16_t*)(ws + WS_WIN);
    { const int gt = C.vcu * NTHREADS + C.tid, NT = C.G * NTHREADS; u32x4 z = {0u, 0u, 0u, 0u};
      for (int i = gt; i < 64 * DM / 8; i += NT) *(u32x4*)(WinT + (size_t)4800 * DM + (size_t)i * 8) = z; }
    bf16_t* xb = (bf16_t*)(ws + WS_XB); float* rstd0 = (float*)(ws + WS_RSTD0);
#pragma unroll 2
    for (int m = gw; m < T_; m += NGW) {
        const f32x4* xr = (const f32x4*)(P.in[I_X] + (size_t)m * DM) + lane;
        f32x4 v[4]; float s = 0.f;
#pragma unroll
        for (int j = 0; j < 4; ++j) { v[j] = xr[64 * j]; s += (v[j][0] * v[j][0] + v[j][1] * v[j][1]) + (v[j][2] * v[j][2] + v[j][3] * v[j][3]); }
        s = wave_sum(s);
        if (lane == 0) rstd0[m] = 1.0f / sqrtf(s * (1.0f / DM) + NORM_EPS);
        u32x2* o8 = (u32x2*)(xb + (size_t)m * DM) + lane;
#pragma unroll
        for (int j = 0; j < 4; ++j) { u32x2 w; w.x = pk2(v[j][0], v[j][1]); w.y = pk2(v[j][2], v[j][3]); o8[64 * j] = w; }
    }
}
__device__ __forceinline__ void prep_rest(const Params& P, const Ctx& C, int widx, int nw) {
    LAS float* scr = (LAS float*)(C.lds + C.wave * 16384);
    unsigned char* ws = C.ws;
    const int gw = widx * NWAVES + C.wave, NGW = nw * NWAVES, lane = C.lane;
    int total = 0;
#pragma unroll
    for (int j = NESS; j < NJOBS; ++j) total += (JOBS[j].K / 64) * (JOBS[j].ncols / 64);
    for (int it = gw; it < total; it += NGW) {
        int r = it, jj = NESS;
        for (int j = NESS; j < NJOBS; ++j) { const int n = (JOBS[j].K / 64) * (JOBS[j].ncols / 64); if (r >= n) { r -= n; jj = j + 1; } else break; }
        const JobDesc d = JOBS[jj];
        TrJob j{P.in[d.in_idx], d.ldw, d.K, d.ncols, d.src0, (bf16_t*)(ws + d.wt_off), d.dst0, d.gain_idx >= 0 ? P.in[d.gain_idx] : nullptr, d.perm != 0};
        trjob_run(j, r, scr, lane);
    }
    { const int gt = widx * NTHREADS + C.tid, NT = nw * NTHREADS;
      bf16_t* sw = (bf16_t*)(ws + WS_SGUW); const float* w = P.in[I_SGUW];
      for (int i = gt; i < 8 * 128 * 128; i += NT) { const int r = (i >> 7) & 127, c = i & 127; sw[i] = (bf16_t)f2bf(c <= r ? w[i] : 0.f); }
      bf16_t* wrh = (bf16_t*)(ws + WS_WRH); bf16_t* wrl = (bf16_t*)(ws + WS_WRL); const float* wrr = P.in[I_WR]; const float* gff = P.in[I_GFFN];
      for (int i = gt; i < NEXP * DM; i += NT) { const int e = i & 63, k = i >> 6; const float wv = wrr[i] * gff[k]; const unsigned h = f2bf(wv); wrh[e * DM + k] = (bf16_t)h; wrl[e * DM + k] = (bf16_t)f2bf(wv - bf2f(h)); }
      float* cs = (float*)(ws + WS_COS); float* sn = (float*)(ws + WS_SIN); const int* pos = (const int*)P.in[I_POS];
      for (int i = gt; i < T_ * 32; i += NT) { const int m = i >> 5, l = i & 31; const float inv_freq = exp2f((float)l * (-13.287712379549449f / 32.0f)); const float ang = (float)pos[m] * inv_freq;
          float sv, cv; sincosf(ang, &sv, &cv); cs[i] = cv; sn[i] = sv; }
    }
}
__device__ __forceinline__ void prep_pb(const Params& P, const Ctx& C) {
    const int gt = C.vcu * NTHREADS + C.tid, NT = C.G * NTHREADS;
    bf16_t* pb = (bf16_t*)(C.ws + WS_PB); const float* p = P.in[I_P];
    for (int i = gt; i < T_ * PLE / 8; i += NT) { const f32x4 a = *(const f32x4*)(p + (size_t)i * 8), b = *(const f32x4*)(p + (size_t)i * 8 + 4); store8bf(pb + (size_t)i * 8, a, b); }
}
__device__ __forceinline__ void phase_prep_wgu(const Params& P, const Ctx& C) {
    LAS float* scr = (LAS float*)(C.lds + C.wave * 16384);
    const int gw = C.vcu * NWAVES + C.wave, NGW = C.G * NWAVES;
    constexpr int ITEMS = (DM / 64) * (128 / 64);
    const int total = NEXP * 4 * ITEMS;
    for (int it = gw; it < total; it += NGW) {
        const int e = it / (4 * ITEMS), r = it % (4 * ITEMS), q = r / ITEMS, item = r % ITEMS;
        const float* W = ((q & 1) ? P.in[I_WEU] : P.in[I_WEG]) + (size_t)e * DM * EFF;
        TrJob j{W, EFF, DM, 128, (q >> 1) * 128, (bf16_t*)(C.ws + WS_WGU) + (size_t)e * 512 * DM, q * 128, P.in[I_GFFN], false};
        trjob_run(j, item, scr, C.lane);
    }
    constexpr int ED_ITEMS = (EFF / 64) * (DM / 64);
    for (int it = gw; it < NEXP * ED_ITEMS; it += NGW) { const int e = it / ED_ITEMS, item = it % ED_ITEMS;
        TrJob j{P.in[I_WED] + (size_t)e * EFF * DM, DM, EFF, DM, 0, (bf16_t*)(C.ws + WS_WD) + (size_t)e * DM * EFF, 0, nullptr, false}; trjob_run(j, item, scr, C.lane); }
}

__device__ __forceinline__ void kpe_rows(const Params& P, const Ctx& C) {
    unsigned char* ws = C.ws; const int gw = C.vcu * NWAVES + C.wave, NGW = C.G * NWAVES, lane = C.lane;
    const bf16_t* lat = (const bf16_t*)(ws + WS_LAT); bf16_t* kpe = (bf16_t*)(ws + WS_KPE);
    const float* cs = (const float*)(ws + WS_COS); const float* sn = (const float*)(ws + WS_SIN);
    const float gkr = P.in[I_GKR][lane];
    const int e = lane & 31, pos = 8 * (e >> 2) + (lane >> 5) * 4 + (e & 3);
    for (int m = gw; m < T_; m += NGW) {
        const float kr = bf2f(lat[(size_t)m * LATW + 640 + lane]);
        const float s3 = wave_sum(kr * kr); const float kn = kr * (1.0f / sqrtf(s3 * (1.0f / ROPE) + NORM_EPS)) * gkr;
        const float other = __shfl_xor(kn, 32);
        const float c = cs[m * 32 + e], sv = sn[m * 32 + e];
        const float ro = lane < 32 ? kn * c - other * sv : kn * c + other * sv;
        kpe[(size_t)m * ROPE + pos] = (bf16_t)f2bf(ro);
    }
}
__device__ __forceinline__ void phase_sgu(const Params& P, const Ctx& C) {
    unsigned char* ws = C.ws; const int tid = C.tid, lane = C.lane, wid = C.wave;
    const bf16_t* gs = (const bf16_t*)(ws + WS_GU); const bf16_t* gv = (const bf16_t*)(ws + WS_GV);
    bf16_t* yag = (bf16_t*)(ws + WS_YAG); const bf16_t* sw = (const bf16_t*)(ws + WS_SGUW);
    const float* gvstat = (const float*)(ws + WS_GVSTAT);
    const float* lng = P.in[I_LNG]; const float* lnb = P.in[I_LNB]; const float* sgub = P.in[I_SGUB];
    constexpr int VTS = 136;
    LAS bf16_t* VT = (LAS bf16_t*)C.lds;
    LAS float* murs = (LAS float*)(C.lds + 128 * VTS * 2);
    constexpr int OTS = 132;
    LAS float* OT = (LAS float*)(C.lds + 128 * VTS * 2 + 1024);
    const int wi = wid >> 1, wcn = wid & 1, r32 = lane & 31, hi = lane >> 5;
    for (int unit = C.vcu; unit < NB * 16 * 8; unit += C.G) {
        const int g = unit & 7, n = (unit >> 3) & 15, b = unit >> 7;
        const size_t t0 = (size_t)b * SEQ + n * 128;
        if (tid < 128) { const f32x4* st = (const f32x4*)(gvstat + (t0 + tid) * 32); float sm = 0.f, sq = 0.f;
#pragma unroll
            for (int k = 0; k < 8; ++k) { const f32x4 v = st[k]; sm += v[0] + v[2]; sq += v[1] + v[3]; }
            const float mu = sm * (1.0f / DM); const float var = fmaxf(sq * (1.0f / DM) - mu * mu, 0.f);
            murs[2 * tid] = mu; murs[2 * tid + 1] = 1.0f / sqrtf(var + LN_EPS); }
        __syncthreads();
#pragma unroll
        for (int q = 0; q < 4; ++q) { const int chunk = tid + 512 * q, j = chunk >> 4, c0 = (chunk & 15) * 8;
            const u32x4 w = *(const u32x4*)(gv + (t0 + j) * DM + g * 128 + c0); const float mu = murs[2 * j], rs = murs[2 * j + 1];
            const f32x4 ga = *(const f32x4*)(lng + g * 128 + c0), gb = *(const f32x4*)(lng + g * 128 + c0 + 4), ba = *(const f32x4*)(lnb + g * 128 + c0), bb = *(const f32x4*)(lnb + g * 128 + c0 + 4);
            float f[8] = {bflo(w.x), bfhi(w.x), bflo(w.y), bfhi(w.y), bflo(w.z), bfhi(w.z), bflo(w.w), bfhi(w.w)};
#pragma unroll
            for (int e = 0; e < 8; ++e) { const float gg = e < 4 ? ga[e] : gb[e - 4], bv = e < 4 ? ba[e] : bb[e - 4]; VT[(c0 + e) * VTS + (j ^ c0)] = (bf16_t)f2bf((f[e] - mu) * rs * gg + bv); } }
        __syncthreads();
        f32x16 acc0 = {}, acc1 = {};
        const bf16_t* wrow = sw + (size_t)g * 128 * 128 + (size_t)(wi * 32 + r32) * 128 + hi * 8;
        const int c0r = wcn * 64 + r32, c1r = c0r + 32; const LAS bf16_t* v0p = VT + c0r * VTS; const LAS bf16_t* v1p = VT + c1r * VTS; const int k0s = c0r & 120, k1s = c1r & 120;
        for (int ks = 0; ks < 2 * wi + 2; ++ks) {
            const bf16x8 a = *(const bf16x8*)(wrow + ks * 16);
            const bf16x8 b0 = *(const LAS bf16x8*)(v0p + ((ks * 16 + hi * 8) ^ k0s)), b1 = *(const LAS bf16x8*)(v1p + ((ks * 16 + hi * 8) ^ k1s));
            acc0 = __builtin_amdgcn_mfma_f32_32x32x16_bf16(a, b0, acc0, 0, 0, 0);
            acc1 = __builtin_amdgcn_mfma_f32_32x32x16_bf16(a, b1, acc1, 0, 0, 0);
        }
#pragma unroll
        for (int r = 0; r < 16; ++r) { const int i = wi * 32 + (r & 3) + 8 * (r >> 2) + 4 * hi; const float bias = sgub[g * 128 + i];
            OT[i * OTS + wcn * 64 + r32] = acc0[r] + bias; OT[i * OTS + wcn * 64 + 32 + r32] = acc1[r] + bias; }
        __syncthreads();
#pragma unroll
        for (int q = 0; q < 4; ++q) { const int chunk = tid + 512 * q, i = chunk >> 4, c0 = (chunk & 15) * 8;
            const size_t o = (t0 + i) * DM + g * 128 + c0;
            const u32x4 gw4 = *(const u32x4*)(gs + o);
            const f32x4 m0 = *(const LAS f32x4*)(OT + i * OTS + c0), m1 = *(const LAS f32x4*)(OT + i * OTS + c0 + 4);
            f32x4 r0, r1;
            r0[0] = bflo(gw4.x) * m0[0]; r0[1] = bfhi(gw4.x) * m0[1]; r0[2] = bflo(gw4.y) * m0[2]; r0[3] = bfhi(gw4.y) * m0[3];
            r1[0] = bflo(gw4.z) * m1[0]; r1[1] = bfhi(gw4.z) * m1[1]; r1[2] = bflo(gw4.w) * m1[2]; r1[3] = bfhi(gw4.w) * m1[3];
            store8bf(yag + o, r0, r1); }
        __syncthreads();
    }
}

namespace att {
constexpr int QBLK = 32, KVBLK = 64, QB = 256;
constexpr int SHM_V = KVBLK * 128 * 2, SHM_KN = KVBLK * 128 * 2, SHM_KR = KVBLK * 64 * 2;
constexpr int LDS_V = 0, LDS_KN = 2 * SHM_V, LDS_KR = LDS_KN + 2 * SHM_KN, LDS_WS = LDS_KR + 2 * SHM_KR, LDS_BYTES = LDS_WS + NWAVES * 64 * 4;
#define KSWZ(row, colB) ((row) * 256 + ((colB) ^ (((row) & 7) << 4)))
#define KRSWZ(row, chunk) ((row) * 128 + ((((chunk) ^ ((row) >> 1)) & 7) << 4))
#define SBAR() __builtin_amdgcn_sched_barrier(0)
__device__ __forceinline__ int v_st(int k, int c) { const int kk = (k & ~0xC) | ((k & 4) << 1) | ((k & 8) >> 1); return ((kk >> 3) * 4 + (c >> 5)) * 512 + ((kk & 7) * 32 + (c & 31)) * 2; }
__device__ __forceinline__ int v_rd_base(int lane) { return ((lane & 3) << 3) | (((lane >> 2) & 3) << 6) | (((lane >> 4) & 1) << 5) | (((lane >> 5) & 1) << 8); }
constexpr int v_rd_off(int d0, int ks, int half) { return d0 * 512 + ks * 4096 + half * 2048; }
__device__ __forceinline__ int crow(int r, int hi) { return (r & 3) + 8 * (r >> 2) + 4 * hi; }

__device__ __forceinline__ void attn_block(int b, int h, int qb, const bf16_t* Q, const bf16_t* KV, const bf16_t* KPE, const bf16_t* SBG, bf16_t* MRG, LAS char* lds, bool dry) {
    const int tid = threadIdx.x, wid = __builtin_amdgcn_readfirstlane(tid >> 6), lane = tid & 63, r32 = lane & 31, hi = lane >> 5;
    LAS char* V_lds = lds + LDS_V; LAS char* KN_lds = lds + LDS_KN; LAS char* KR_lds = lds + LDS_KR;
    LAS float* wsf = (LAS float*)(lds + LDS_WS) + wid * 64; LAS float* li_l = wsf; LAS float* al_l = wsf + 32;
    const int P0 = qb * QB, NT = (P0 + QB) / KVBLK;
    const unsigned tb = (unsigned)b * SEQ;
    const int qlo = P0 + wid * QBLK;
    bf16x8 qr[12];
    { const bf16_t* qp = Q + (unsigned)((tb + qlo + r32) * QW + h * 192 + hi * 8);
#pragma unroll
      for (int d0 = 0; d0 < 12; ++d0) qr[d0] = *(const bf16x8*)(qp + d0 * 16); }
    bf16x8 st_k0, st_k1, st_v0, st_v1, st_r;
#define SLOAD(k0) do { int t3_ = tid; asm volatile("" : "+v"(t3_)); const unsigned kvo = (tb + (t3_ >> 4)) * KVW + h * 256 + (t3_ & 15) * 8, kro = (tb + (t3_ >> 3)) * ROPE + (t3_ & 7) * 8; \
        const bf16_t* p_ = KV + (unsigned)(kvo + (unsigned)(k0) * KVW); st_k0 = *(const bf16x8*)p_; st_k1 = *(const bf16x8*)(p_ + 32 * KVW); \
        st_v0 = *(const bf16x8*)(p_ + 128); st_v1 = *(const bf16x8*)(p_ + 32 * KVW + 128); st_r = *(const bf16x8*)(KPE + (unsigned)(kro + (unsigned)(k0) * ROPE)); } while (0)
#define SWRITE(bf) do { int t2_ = tid; asm volatile("" : "+v"(t2_)); const int sr_ = t2_ >> 4, sc_ = (t2_ & 15) * 8, rr_ = t2_ >> 3, rc_ = t2_ & 7; \
        const int kws = KSWZ(sr_, sc_ * 2), vst0 = v_st(sr_, sc_), vst1 = v_st(32 + sr_, sc_), krs = KRSWZ(rr_, rc_); \
        *(LAS bf16x8*)(KN_lds + (bf) * SHM_KN + kws) = st_k0; *(LAS bf16x8*)(KN_lds + (bf) * SHM_KN + kws + 32 * 256) = st_k1; \
        *(LAS bf16x8*)(V_lds + (bf) * SHM_V + vst0) = st_v0; *(LAS bf16x8*)(V_lds + (bf) * SHM_V + vst1) = st_v1; *(LAS bf16x8*)(KR_lds + (bf) * SHM_KR + krs) = st_r; } while (0)
    SLOAD(0); SWRITE(0);
    __syncthreads();
    float m_reg = -1e30f, l_reg = 0.f; f32x16 o[4] = {};
    const int vb0 = (int)(unsigned)(uintptr_t)V_lds + v_rd_base(lane);
    constexpr float C2 = 1.4426950408889634f;
    for (int t = 0; t < NT; ++t) {
        const int bf = t & 1, kb = t * KVBLK;
        if (t + 1 < NT) SLOAD(kb + KVBLK);
        if (kb <= qlo + QBLK - 1) {
            f32x16 p0 = {}, p1 = {};
            int l2_ = lane; asm volatile("" : "+v"(l2_)); const int r32 = l2_ & 31, hi = l2_ >> 5;
            { LAS const char* kn = KN_lds + bf * SHM_KN;
              LAS const char* kbp[4];
#pragma unroll
              for (int dd = 0; dd < 4; ++dd) kbp[dd] = kn + KSWZ(r32, (dd * 16 + hi * 8) * 2);
#pragma unroll
              for (int d0 = 0; d0 < 8; ++d0) { LAS const char* a = kbp[d0 & 3] + (d0 >> 2) * 128;
                  const bf16x8 b0 = *(LAS const bf16x8*)a, b1 = *(LAS const bf16x8*)(a + 32 * 256);
                  p0 = __builtin_amdgcn_mfma_f32_32x32x16_bf16(b0, qr[d0], p0, 0, 0, 0);
                  p1 = __builtin_amdgcn_mfma_f32_32x32x16_bf16(b1, qr[d0], p1, 0, 0, 0); }
              LAS const char* kr = KR_lds + bf * SHM_KR;
#pragma unroll
              for (int d0 = 0; d0 < 4; ++d0) { LAS const char* a = kr + KRSWZ(r32, 2 * d0 + hi);
                  const bf16x8 b0 = *(LAS const bf16x8*)a, b1 = *(LAS const bf16x8*)(a + 32 * 128);
                  p0 = __builtin_amdgcn_mfma_f32_32x32x16_bf16(b0, qr[8 + d0], p0, 0, 0, 0);
                  p1 = __builtin_amdgcn_mfma_f32_32x32x16_bf16(b1, qr[8 + d0], p1, 0, 0, 0); } }
            if (kb + KVBLK - 1 > qlo) {
                const int dq = qlo + r32 - 4 * hi - kb; const float NEG = -__builtin_inff();
#pragma unroll
                for (int r = 0; r < 16; ++r) { const int c = (r & 3) + 8 * (r >> 2); if (dq - c < 0) p0[r] = NEG; if (dq - c - 32 < 0) p1[r] = NEG; } }
            float pmax = p0[0];
#pragma unroll
            for (int r = 1; r < 16; ++r) pmax = fmaxf(pmax, p0[r]);
#pragma unroll
            for (int r = 0; r < 16; ++r) pmax = fmaxf(pmax, p1[r]);
            { auto sw = __builtin_amdgcn_permlane32_swap(__float_as_uint(pmax), __float_as_uint(pmax), false, false); pmax = fmaxf(__uint_as_float(sw[0]), __uint_as_float(sw[1])); }
            float alpha = 1.f; const bool grow = __any((pmax - m_reg) * C2 > 6.0f);
            if (grow) { const float mn_ = fmaxf(m_reg, pmax); alpha = __builtin_amdgcn_exp2f((m_reg - mn_) * C2); m_reg = mn_; }
            const float mnL = -m_reg * C2; float ps = 0.f;
#pragma unroll
            for (int r = 0; r < 16; ++r) { p0[r] = __builtin_amdgcn_exp2f(fmaf(p0[r], C2, mnL)); p1[r] = __builtin_amdgcn_exp2f(fmaf(p1[r], C2, mnL)); ps += p0[r] + p1[r]; }
            { auto sw = __builtin_amdgcn_permlane32_swap(__float_as_uint(ps), __float_as_uint(ps), false, false); ps = __uint_as_float(sw[0]) + __uint_as_float(sw[1]); }
            l_reg = l_reg * alpha + ps;
            bf16x8 pa0, pa1, pa2, pa3;
#define PK4(Pv, B_, OUT) do { unsigned a0 = pk2(Pv[B_ + 0], Pv[B_ + 1]), a1 = pk2(Pv[B_ + 2], Pv[B_ + 3]); unsigned b0 = pk2(Pv[B_ + 4], Pv[B_ + 5]), b1 = pk2(Pv[B_ + 6], Pv[B_ + 7]); \
        auto r0 = __builtin_amdgcn_permlane32_swap(a0, b0, false, false); auto r1 = __builtin_amdgcn_permlane32_swap(a1, b1, false, false); \
        u32x4 w = {r0[0], r1[0], r0[1], r1[1]}; OUT = *reinterpret_cast<bf16x8*>(&w); } while (0)
            PK4(p0, 0, pa0); PK4(p0, 8, pa1); PK4(p1, 0, pa2); PK4(p1, 8, pa3);
#undef PK4
            if (grow) { if (hi == 0) al_l[r32] = alpha; asm volatile("s_waitcnt lgkmcnt(0)" ::: "memory");
#pragma unroll
                for (int d_ = 0; d_ < 4; ++d_)
#pragma unroll
                    for (int r = 0; r < 16; ++r) o[d_][r] *= al_l[crow(r, hi)]; }
#define TRRD(dst, off) asm volatile("ds_read_b64_tr_b16 %0, %1 offset:%2" : "=&v"(dst) : "v"(vb0), "i"(off) : "memory")
#define PV_D0(VB, d0) do { s16x4 l0, l1, l2, l3, h0, h1, h2, h3; constexpr int b_ = VB * SHM_V + v_rd_off(d0, 0, 0); \
        TRRD(l0, b_); TRRD(h0, b_ + 2048); TRRD(l1, b_ + 4096); TRRD(h1, b_ + 6144); TRRD(l2, b_ + 8192); TRRD(h2, b_ + 10240); TRRD(l3, b_ + 12288); TRRD(h3, b_ + 14336); \
        asm volatile("s_waitcnt lgkmcnt(0)" ::: "memory"); SBAR(); \
        o[d0] = __builtin_amdgcn_mfma_f32_32x32x16_bf16(pa0, (bf16x8){l0[0], l0[1], l0[2], l0[3], h0[0], h0[1], h0[2], h0[3]}, o[d0], 0, 0, 0); \
        o[d0] = __builtin_amdgcn_mfma_f32_32x32x16_bf16(pa1, (bf16x8){l1[0], l1[1], l1[2], l1[3], h1[0], h1[1], h1[2], h1[3]}, o[d0], 0, 0, 0); \
        o[d0] = __builtin_amdgcn_mfma_f32_32x32x16_bf16(pa2, (bf16x8){l2[0], l2[1], l2[2], l2[3], h2[0], h2[1], h2[2], h2[3]}, o[d0], 0, 0, 0); \
        o[d0] = __builtin_amdgcn_mfma_f32_32x32x16_bf16(pa3, (bf16x8){l3[0], l3[1], l3[2], l3[3], h3[0], h3[1], h3[2], h3[3]}, o[d0], 0, 0, 0); } while (0)
            if (bf == 0) { PV_D0(0, 0); PV_D0(0, 1); PV_D0(0, 2); PV_D0(0, 3); } else { PV_D0(1, 0); PV_D0(1, 1); PV_D0(1, 2); PV_D0(1, 3); }
#undef PV_D0
#undef TRRD
        }
        if (t + 1 < NT) SWRITE(bf ^ 1);
        __syncthreads();
    }
#undef SLOAD
#undef SWRITE
    if (hi == 0) li_l[r32] = l_reg; asm volatile("s_waitcnt lgkmcnt(0)" ::: "memory");
    int hi2 = hi; asm volatile("" : "+v"(hi2));
    LAS bf16_t* OT = (LAS bf16_t*)(lds + wid * 8704);
#pragma unroll
    for (int r = 0; r < 16; ++r) { const int orow = crow(r, hi2); const float rl = __builtin_amdgcn_rcpf(li_l[orow]);
#pragma unroll
        for (int d0 = 0; d0 < 4; ++d0) OT[orow * 136 + d0 * 32 + r32] = (bf16_t)f2bf(o[d0][r] * rl); }
    asm volatile("s_waitcnt lgkmcnt(0)" ::: "memory");
    int l3_ = lane; asm volatile("" : "+v"(l3_));
#pragma unroll
    for (int i = 0; i < 8; ++i) { const int id = l3_ + 64 * i, row = id >> 4, ch = id & 15;
        const u32x4 ov = *(const LAS u32x4*)(OT + row * 136 + ch * 8);
        const unsigned a = (tb + qlo + row) * DM + h * 128 + ch * 8;
        const u32x4 yv = *(const u32x4*)(MRG + a), sv = *(const u32x4*)(SBG + a);
        f32x4 r0, r1;
        r0[0] = bflo(yv.x) + bflo(sv.x) * bflo(ov.x); r0[1] = bfhi(yv.x) + bfhi(sv.x) * bfhi(ov.x); r0[2] = bflo(yv.y) + bflo(sv.y) * bflo(ov.y); r0[3] = bfhi(yv.y) + bfhi(sv.y) * bfhi(ov.y);
        r1[0] = bflo(yv.z) + bflo(sv.z) * bflo(ov.z); r1[1] = bfhi(yv.z) + bfhi(sv.z) * bfhi(ov.z); r1[2] = bflo(yv.w) + bflo(sv.w) * bflo(ov.w); r1[3] = bfhi(yv.w) + bfhi(sv.w) * bfhi(ov.w);
        if (!dry) store8bf(MRG + a, r0, r1); }
    __syncthreads();
}
#undef KSWZ
#undef KRSWZ
#undef SBAR
}

__device__ __forceinline__ void phase_attn(const Params& P, const Ctx& C, bool dry) {
    unsigned char* ws = C.ws;
    const bf16_t* Q = (const bf16_t*)(ws + WS_QRAW); const bf16_t* KV = (const bf16_t*)(ws + WS_KVRAW); const bf16_t* KPE = (const bf16_t*)(ws + WS_KPE);
    const bf16_t* SBG = (const bf16_t*)(ws + WS_SB); bf16_t* MRG = (bf16_t*)(ws + WS_YAG);
    for (int item = C.vcu; item < NB * NH * 4; item += C.G) {
        const int bh = item >> 2, x = item & 3, b = bh >> 3, h = bh & 7;
#pragma unroll 1
        for (int pass = 0; pass < 2; ++pass) att::attn_block(b, h, pass ? 7 - x : x, Q, KV, KPE, SBG, MRG, (LAS char*)C.lds, dry);
    }
}
__device__ __forceinline__ void phase_router(const Params& P, const Ctx& C, bool dry) {
    unsigned char* ws = C.ws; const int lane = C.lane, w = C.wave;
    const bf16_t* x1 = (const bf16_t*)P.out; const bf16_t* wrh = (const bf16_t*)(ws + WS_WRH); const bf16_t* wrl = (const bf16_t*)(ws + WS_WRL);
    float* rstd2 = (float*)(ws + WS_RSTD2); int* tok_e = (int*)(ws + WS_TOKE); float* tok_w = (float*)(ws + WS_TOKW);
    unsigned* cnt = (unsigned*)(ws + WS_CTL) + CW_CNT;
    const float br = P.in[I_BR][lane];
    LAS float* Lp = (LAS float*)C.lds;
    LAS float* Sq = Lp + 2 * 4 * 16 * 64;
    LAS unsigned* lcnt = (LAS unsigned*)(Sq + 128);
    LAS unsigned* lbase = lcnt + 64;
    LAS int* lte = (LAS int*)(lbase + 64);
    const int task = w & 3, kh = w >> 2, r16 = lane & 15, q = lane >> 4;
    for (int base = C.vcu * 4; base < T_ / 16; base += C.G * 4) {
        const int t0 = (base + task) * 16;
        if (C.tid < 64) lcnt[C.tid] = 0u;
        f32x4 acc[4];
#pragma unroll
        for (int nt = 0; nt < 4; ++nt) acc[nt] = (f32x4){0.f, 0.f, 0.f, 0.f};
        float ssq = 0.f;
        const bf16_t* xp = x1 + (size_t)(t0 + r16) * DM + kh * 512 + q * 8;
        unsigned wo = (unsigned)(r16 * DM + kh * 512 + q * 8); asm volatile("" : "+v"(wo));
        u32x4 av[16];
#pragma unroll
        for (int ks = 0; ks < 16; ++ks) av[ks] = *(const u32x4*)(xp + ks * 32);
        asm volatile("" ::: "memory");
#pragma unroll
        for (int ks = 0; ks < 16; ++ks) {
            const u32x4 hw = av[ks];
            { const float f0 = bflo(hw.x), f1 = bfhi(hw.x), f2 = bflo(hw.y), f3 = bfhi(hw.y), f4 = bflo(hw.z), f5 = bfhi(hw.z), f6 = bflo(hw.w), f7 = bfhi(hw.w);
              ssq += (f0 * f0 + f1 * f1) + (f2 * f2 + f3 * f3) + (f4 * f4 + f5 * f5) + (f6 * f6 + f7 * f7); }
            const bf16x8 ah = __builtin_bit_cast(bf16x8, hw);
#pragma unroll
            for (int nt = 0; nt < 4; ++nt) { const bf16x8 bh = *(const bf16x8*)(wrh + wo + nt * 16 * DM + ks * 32), bl = *(const bf16x8*)(wrl + wo + nt * 16 * DM + ks * 32);
                acc[nt] = __builtin_amdgcn_mfma_f32_16x16x32_bf16(ah, bh, acc[nt], 0, 0, 0);
                acc[nt] = __builtin_amdgcn_mfma_f32_16x16x32_bf16(ah, bl, acc[nt], 0, 0, 0); }
            if ((ks & 3) == 3) asm volatile("" ::: "memory");
        }
        ssq += __shfl_xor(ssq, 16); ssq += __shfl_xor(ssq, 32);
        LAS float* lp = Lp + (kh * 4 + task) * 16 * 64;
#pragma unroll
        for (int nt = 0; nt < 4; ++nt)
#pragma unroll
            for (int r = 0; r < 4; ++r) lp[(4 * q + r) * 64 + nt * 16 + r16] = acc[nt][r];
        if (q == 0) Sq[(kh * 4 + task) * 16 + r16] = ssq;
        __syncthreads();
#pragma unroll 1
        for (int tt = 0; tt < 8; ++tt) {
            const int tok = kh * 8 + tt, m = t0 + tok;
            const float s = Sq[task * 16 + tok] + Sq[(4 + task) * 16 + tok]; const float rs = 1.0f / sqrtf(s * (1.0f / DM) + NORM_EPS);
            const float logit = (Lp[(task * 16 + tok) * 64 + lane] + Lp[((4 + task) * 16 + tok) * 64 + lane]) * rs;
            const float score = 1.0f / (1.0f + expf(-logit)); const float sel = score + br;
            float m1 = sel, m2 = -__builtin_inff();
#pragma unroll
            for (int o = 1; o < 8; o <<= 1) { const float p1 = __shfl_xor(m1, o), p2 = __shfl_xor(m2, o); const float hi1 = fmaxf(m1, p1), lo1 = fminf(m1, p1); m2 = fmaxf(lo1, fmaxf(m2, p2)); m1 = hi1; }
            const float gs = m1 + m2;
            int grank = 0; const int mygrp = lane >> 3;
#pragma unroll
            for (int g = 0; g < 8; ++g) { const float og = __builtin_bit_cast(float, __builtin_amdgcn_readlane(__builtin_bit_cast(int, gs), g * 8)); grank += (og > gs || (og == gs && g < mygrp)) ? 1 : 0; }
            const float msel = grank < 4 ? sel : -__builtin_inff();
            int rank = 0;
#pragma unroll
            for (int j = 0; j < 64; ++j) { const float oj = __builtin_bit_cast(float, __builtin_amdgcn_readlane(__builtin_bit_cast(int, msel), j)); rank += (oj > msel || (oj == msel && j < lane)) ? 1 : 0; }
            const bool chosen = rank < 8;
            const float wsum = wave_sum(chosen ? score : 0.f);
            if (lane == 0 && !dry) rstd2[m] = rs;
            unsigned lpos = 0u; if (chosen) lpos = __hip_atomic_fetch_add(lcnt + lane, 1u, __ATOMIC_RELAXED, __HIP_MEMORY_SCOPE_WORKGROUP);
            if (chosen) lte[(task * 16 + tok) * 8 + rank] = lane | ((int)lpos << 8);
            if (chosen && !dry) tok_w[m * 8 + rank] = score / wsum * 2.5f;
        }
        __syncthreads();
        if (C.tid < 64 && !dry) { const unsigned c = lcnt[C.tid]; lbase[C.tid] = c ? __hip_atomic_fetch_add(cnt + 32 * C.tid, c, __ATOMIC_RELAXED, __HIP_MEMORY_SCOPE_AGENT) : 0u; }
        __syncthreads();
        if (!dry) { const int tb0 = base * 16;
            const int v = lte[C.tid]; const int e = v & 255; tok_e[tb0 * 8 + C.tid] = e | ((int)(lbase[e] + (unsigned)(v >> 8)) << 8); }
        __syncthreads();
    }
}
__device__ __forceinline__ void phase_lists(const Params& P, const Ctx& C) {
    unsigned char* ws = C.ws; const int tid = C.tid;
    LAS int* offs = (LAS int*)C.lds;
    LAS int* coff = offs + 80;
    unsigned* ctl = (unsigned*)(ws + WS_CTL); const unsigned* cnt = ctl + CW_CNT;
    u32x4* ent = (u32x4*)(ws + WS_ENT); int* tile_list = (int*)(ws + WS_TILEL); int* inv = (int*)(ws + WS_INV);
    const int* tok_e = (const int*)(ws + WS_TOKE); const float* tok_w = (const float*)(ws + WS_TOKW); const float* rstd2 = (const float*)(ws + WS_RSTD2);
    if (tid < 64) { const int c = (int)__hip_atomic_load(cnt + 32 * tid, __ATOMIC_RELAXED, __HIP_MEMORY_SCOPE_AGENT); const int pc = (c + 255) & ~255;
        int po = pc, co = c;
#pragma unroll
        for (int d = 1; d < 64; d <<= 1) { const int a = __shfl_up(po, d), b = __shfl_up(co, d); if (tid >= d) { po += a; co += b; } }
        offs[tid] = po - pc; coff[tid] = co - c;
        if (C.vcu == 0) { ctl[CW_LSH + tid] = (unsigned)((po - pc) - (co - c)); ctl[CW_LSH + 128 + tid] = (unsigned)(po - pc + c); }
        if (tid == 63) { offs[64] = po; coff[64] = co; offs[65] = po + T_; coff[65] = co + T_;
            if (C.vcu == 0) { ctl[CW_LSH + 64] = (unsigned)(po - co); ctl[CW_LSH + 128 + 64] = (unsigned)(po + T_); } } }
    __syncthreads();
    const int gt = C.vcu * NTHREADS + tid, NT = C.G * NTHREADS;
    for (int i = gt; i < T_ * 8; i += NT) { const int m = i >> 3, k = i & 7, v = tok_e[i], e = v & 255;
        const int pos = v >> 8, idx = offs[e] + pos;
        u32x4 en; en.x = (unsigned)m; en.y = 0u; en.z = __float_as_uint(tok_w[i]); en.w = __float_as_uint(rstd2[m]); ent[idx] = en; inv[m * 9 + k] = coff[e] + pos; }
    for (int m = gt; m < T_; m += NT) { u32x4 en; en.x = (unsigned)m; en.y = 0u; en.z = __float_as_uint(1.0f); en.w = __float_as_uint(rstd2[m]); ent[offs[64] + m] = en; inv[m * 9 + 8] = coff[64] + m; }
    for (int e = C.vcu; e < NEXP; e += C.G) { const int c = (int)__hip_atomic_load(cnt + 32 * e, __ATOMIC_RELAXED, __HIP_MEMORY_SCOPE_AGENT);
        for (int i = offs[e] + c + tid; i < offs[e + 1]; i += NTHREADS) { u32x4 en; en.x = 0u; en.y = 0xffffffffu; en.z = 0u; en.w = 0u; ent[i] = en; } }
    const int ntiles = offs[NLIST] >> 8;
    for (int rt = gt; rt < ntiles; rt += NT) { int li = 0;
        for (int e = 0; e < NLIST; ++e) if (rt * 256 >= offs[e]) li = e;
        tile_list[rt] = li; }
    if (gt == 0) { ctl[CW_FILL + 80] = (unsigned)ntiles; ctl[CW_FILL + 81] = (unsigned)offs[64]; }
    __syncthreads();
}
__device__ __forceinline__ void phase_combine(const Params& P, const Ctx& C) {
    const int gw = C.vcu * NWAVES + C.wave, NGW = C.G * NWAVES, lane = C.lane;
    const unsigned char* ybuf = (const unsigned char*)(C.ws + WS_YBUF); float* out = P.out;
    bf16_t* x2b = (bf16_t*)(C.ws + WS_X2B); float* rstd3 = (float*)(C.ws + WS_RSTD3); const int* inv = (const int*)(C.ws + WS_INV);
#pragma unroll 2
    for (int m = gw; m < T_; m += NGW) {
        const u32x4* xp = (const u32x4*)((const bf16_t*)out + (size_t)m * DM + lane * 16); const u32x4 x0 = xp[0], x1v = xp[1];
        f32x4 a[4];
        a[0] = (f32x4){bflo(x0.x), bfhi(x0.x), bflo(x0.y), bfhi(x0.y)}; a[1] = (f32x4){bflo(x0.z), bfhi(x0.z), bflo(x0.w), bfhi(x0.w)};
        a[2] = (f32x4){bflo(x1v.x), bfhi(x1v.x), bflo(x1v.y), bfhi(x1v.y)}; a[3] = (f32x4){bflo(x1v.z), bfhi(x1v.z), bflo(x1v.w), bfhi(x1v.w)};
        const int iv = inv[m * 9 + (lane < 9 ? lane : 0)];
#pragma unroll
        for (int k = 0; k < 9; ++k) { const unsigned yr = (unsigned)__builtin_amdgcn_readlane(iv, k); const u32x4 w = *(const u32x4*)(ybuf + (size_t)yr * DM + lane * 16);
#pragma unroll
            for (int j = 0; j < 4; ++j) { const f32x2 lo = __builtin_amdgcn_cvt_pk_f32_fp8((int)w[j], false), hi = __builtin_amdgcn_cvt_pk_f32_fp8((int)w[j], true);
                a[j][0] += lo.x; a[j][1] += lo.y; a[j][2] += hi.x; a[j][3] += hi.y; } }
        float s = 0.f;
#pragma unroll
        for (int j = 0; j < 4; ++j) s += (a[j][0] * a[j][0] + a[j][1] * a[j][1]) + (a[j][2] * a[j][2] + a[j][3] * a[j][3]);
        s = wave_sum(s);
        store8bf(x2b + (size_t)m * DM + lane * 16, a[0], a[1]); store8bf(x2b + (size_t)m * DM + lane * 16 + 8, a[2], a[3]);
        if (lane == 0) rstd3[m] = 1.0f / sqrtf(s * (1.0f / DM) + NORM_EPS);
    }
}
#define XB_TMO      128
#define XB_XCNT(j)  (256  + 64 * (j))
#define XB_XSUB(j)  (1280 + 64 * (j))
#define XB_XGEN(j)  (2304 + 64 * (j))
#define XB_TOP      3328
#define XB_TOPGEN   3392
#define XCD_BAR_WORDS 3456
#define XB_SPIN_CAP (1u << 20)
__device__ __forceinline__ unsigned xb_ld(unsigned* p)              { return __hip_atomic_load(p, __ATOMIC_RELAXED, __HIP_MEMORY_SCOPE_AGENT); }
__device__ __forceinline__ unsigned xb_add(unsigned* p, unsigned v) { return __hip_atomic_fetch_add(p, v, __ATOMIC_RELAXED, __HIP_MEMORY_SCOPE_AGENT); }
__device__ __forceinline__ unsigned xb_xcc_id() { return (unsigned)__builtin_amdgcn_s_getreg((3 << 11) | 20) & 0xFu; }
#define XB_SPIN(cond, bar) do { unsigned _sp = 0; while (cond) { __builtin_amdgcn_s_sleep(1); \
    if ((++_sp & 255u) == 0u) { if (xb_ld(&(bar)[XB_TMO])) break; if (_sp > XB_SPIN_CAP) { atomicAdd(&(bar)[XB_TMO], 1u); break; } } } } while (0)
struct XcdBarrier { unsigned* bar; unsigned x; volatile LAS unsigned* st; };
__device__ __forceinline__ XcdBarrier xcd_barrier_post(unsigned* bar, volatile LAS unsigned* st) {
    XcdBarrier b; b.bar = bar; b.x = xb_xcc_id(); b.st = st;
    if (threadIdx.x == 0) (void)xb_add(&bar[XB_XCNT(b.x)], 1u);
    return b;
}
__device__ __forceinline__ void xcd_barrier_complete(unsigned* bar, unsigned x, unsigned& nloc, unsigned& nx) {
    const unsigned G = gridDim.x * gridDim.y * gridDim.z;
    unsigned sum, cnt, mine, sp = 0u;
    for (;;) {
        sum = 0u; cnt = 0u; mine = 0u;
#pragma unroll
        for (unsigned j = 0; j < 16; ++j) { const unsigned c = xb_ld(&bar[XB_XCNT(j)]); sum += c; cnt += (c > 0u) ? 1u : 0u; mine = (j == x) ? c : mine; }
        if (sum == G) break;
        __builtin_amdgcn_s_sleep(1);
        if ((++sp & 255u) == 0u) { if (xb_ld(&bar[XB_TMO])) break; if (sp > XB_SPIN_CAP) { atomicAdd(&bar[XB_TMO], 1u); break; } }
    }
    nloc = mine > 0u ? mine : 1u; nx = cnt > 0u ? cnt : 1u;
}
__device__ __forceinline__ void xcd_barrier(const XcdBarrier& b) {
    asm volatile("s_waitcnt vmcnt(0)" ::: "memory");
    __syncthreads();
    if (threadIdx.x == 0) {
        unsigned* bar = b.bar;
        __builtin_amdgcn_s_waitcnt(0);
        unsigned nloc = b.st[0], nx = b.st[1];
        if (nloc == 0u) { xcd_barrier_complete(bar, b.x, nloc, nx); b.st[0] = nloc; b.st[1] = nx; }
        const unsigned old = xb_add(&bar[XB_XSUB(b.x)], 1u);
        const unsigned gen = old / nloc;
        if (old + 1u == (gen + 1u) * nloc) {
            __builtin_amdgcn_fence(__ATOMIC_RELEASE, "agent");
            asm volatile("s_waitcnt vmcnt(0)" ::: "memory");
            const unsigned og = xb_add(&bar[XB_TOP], 1u);
            const unsigned tg = og / nx;
            if (og + 1u == (tg + 1u) * nx) xb_add(&bar[XB_TOPGEN], 1u);
            else XB_SPIN(xb_ld(&bar[XB_TOPGEN]) == tg, bar);
            __builtin_amdgcn_fence(__ATOMIC_ACQUIRE, "agent");
            xb_add(&bar[XB_XGEN(b.x)], 1u);
            asm volatile("s_waitcnt vmcnt(0)" ::: "memory");
        } else {
            XB_SPIN(xb_ld(&bar[XB_XGEN(b.x)]) == gen, bar);
            __builtin_amdgcn_fence(__ATOMIC_ACQUIRE, "agent");
            asm volatile("s_waitcnt vmcnt(0)" ::: "memory");
        }
    }
    __syncthreads();
}

constexpr int RING_BYTES = 131072, MISC_OFF = RING_BYTES + 320, LDS_BYTES = 147456;
constexpr int N_PHASES = 11;
#ifndef MK_N_LAUNCHES
#define MK_N_LAUNCHES 1
#endif
struct Args { Params P; int ph_lo, ph_hi; };

__global__ void __launch_bounds__(NTHREADS, 2) fwd_kernel(Args args) {
    extern __shared__ __attribute__((aligned(16))) unsigned char lds_raw[];
    Ctx C; C.lds = (LAS unsigned char*)lds_raw; C.ws = args.P.ws; C.tid = threadIdx.x; C.lane = C.tid & 63; C.wave = __builtin_amdgcn_readfirstlane(C.tid >> 6);
    C.G = gridDim.x; C.vcu = vcu_of(blockIdx.x, C.G);
    const Params& P = args.P;
    unsigned char* ws = C.ws;
    volatile LAS unsigned* MISC = (volatile LAS unsigned*)(C.lds + MISC_OFF);
    for (int u = C.tid; u < (LDS_BYTES - RING_BYTES) / 4; u += NTHREADS) ((LAS unsigned*)(C.lds + RING_BYTES))[u] = 0u;
    __syncthreads();
    const int lo = args.ph_lo, hi = args.ph_hi;
    XcdBarrier bar; bar.bar = (unsigned*)(ws + WS_CTL) + CW_BAR; bar.x = 0; bar.st = nullptr;
    if (hi - lo > 1) bar = xcd_barrier_post((unsigned*)(ws + WS_CTL) + CW_BAR, MISC + 8);
#ifdef ONLY_PHASE
#define IN(k) ((k) == ONLY_PHASE && lo <= (k) && (k) < hi)
#else
#define IN(k) (lo <= (k) && (k) < hi)
#endif
#ifdef REPEAT_PHASE
#define NREP(k) ((k) == REPEAT_PHASE ? 2 : 1)
#else
#define NREP(k) 1
#endif
#ifdef DILATE_PHASE
    unsigned long long dl_t0 = 0, dl_t1 = 0;
#define DL_MARK(k) do { if ((k) == DILATE_PHASE || (DILATE_PHASE == 99 && (k) == 0)) dl_t0 = __builtin_amdgcn_s_memrealtime(); if ((k) == DILATE_PHASE + 1 || (DILATE_PHASE == 99 && (k) == 11)) dl_t1 = __builtin_amdgcn_s_memrealtime(); } while (0)
#else
#define DL_MARK(k) do {} while (0)
#endif
#define SEAM(k) do { if (IN(k) && IN((k) + 1)) xcd_barrier(bar); DL_MARK((k) + 1); } while (0)
    DL_MARK(0);
    if (IN(0)) { phase_prep0(P, C); } SEAM(0);
    if (IN(1)) {
        DenseSched S{(const char*)(ws + WS_XB), (const char*)(ws + WS_WIN), T_ / 256, NZ / 256, C.G, C.vcu, DM * 2, DM * 2};
        EpiG1 E{ws};
        pg8::gemm_phase<EpiG1, DenseSched, false>(C.lds, pg8::Shape{DM * 2, DM * 2, DM / 64, nullptr}, S, E);
        { const int rem = ((T_ / 256) * (NZ / 256)) % C.G; if (rem == 0) prep_rest(P, C, C.vcu, C.G); else if (C.vcu >= rem) prep_rest(P, C, C.vcu - rem, C.G - rem); }
    } SEAM(1);
    if (IN(2)) { kpe_rows(P, C); phase_sgu(P, C); } SEAM(2);
    if (IN(3)) {
        { DenseSched S{(const char*)(ws + WS_LAT) + 256 * 2, (const char*)(ws + WS_WQB), T_ / 256, QW / 256, C.G, C.vcu, LATW * 2, QLAT * 2};
          EpiQ E{ws, C.lds, P.in[I_GQN], P.in[I_GQR]};
          pg8::gemm_phase<EpiQ, DenseSched, false>(C.lds, pg8::Shape{LATW * 2, QLAT * 2, QLAT / 64, nullptr}, S, E); }
        { DenseSched S{(const char*)(ws + WS_LAT), (const char*)(ws + WS_WKVB), T_ / 256, KVW / 256, C.G, C.vcu, LATW * 2, KVLAT * 2};
          EpiKV E{ws, C.lds, P.in[I_GKN]};
          pg8::gemm_phase<EpiKV, DenseSched, false>(C.lds, pg8::Shape{LATW * 2, KVLAT * 2, KVLAT / 64, nullptr}, S, E); }
    } SEAM(3);
    if (IN(4)) { phase_attn(P, C, false); } SEAM(4);
    if (IN(5)) {
        DenseSched S{(const char*)(ws + WS_YAG), (const char*)(ws + WS_WO), T_ / 256, DM / 256, C.G, C.vcu, DM * 2, DM * 2};
        EpiG4 E{P.in[I_X], (bf16_t*)P.out};
        pg8::gemm_phase<EpiG4, DenseSched, false>(C.lds, pg8::Shape{DM * 2, DM * 2, DM / 64, nullptr}, S, E);
    } SEAM(5);
    if (IN(6)) {
        unsigned* sig = (unsigned*)(ws + WS_CTL) + 1024;
        phase_router(P, C, false);
        asm volatile("s_waitcnt vmcnt(0)" ::: "memory"); __syncthreads();
        if (C.tid == 0) { __builtin_amdgcn_fence(__ATOMIC_RELEASE, "agent"); asm volatile("s_waitcnt vmcnt(0)" ::: "memory"); __hip_atomic_fetch_add(sig, 1u, __ATOMIC_RELAXED, __HIP_MEMORY_SCOPE_AGENT); }
        phase_prep_wgu(P, C);
        if (C.tid == 0) { unsigned sp = 0; while (__hip_atomic_load(sig, __ATOMIC_RELAXED, __HIP_MEMORY_SCOPE_AGENT) < (unsigned)C.G) { __builtin_amdgcn_s_sleep(2); if (++sp > (1u << 22)) break; }
            __builtin_amdgcn_fence(__ATOMIC_ACQUIRE, "agent"); asm volatile("s_waitcnt vmcnt(0)" ::: "memory"); }
        __syncthreads();
        phase_lists(P, C);
    } SEAM(6);
    const unsigned* ctl = (const unsigned*)(ws + WS_CTL);
    if (IN(7)) {
        const int ntiles = (int)__hip_atomic_load(ctl + CW_FILL + 80, __ATOMIC_RELAXED, __HIP_MEMORY_SCOPE_AGENT), off64 = (int)__hip_atomic_load(ctl + CW_FILL + 81, __ATOMIC_RELAXED, __HIP_MEMORY_SCOPE_AGENT);
        LAS int* tl = (LAS int*)(C.lds + PART_OFF); for (int i = C.tid; i < ntiles; i += NTHREADS) tl[i] = ((const int*)(ws + WS_TILEL))[i]; __syncthreads();
        MoeGuSched S{ws, tl, ntiles, C.G, C.vcu};
        EpiGu E{ws, off64};
        pg8::gemm_phase<EpiGu, MoeGuSched, true>(C.lds, pg8::Shape{DM * 2, DM * 2, DM / 64, (const char*)P.out}, S, E);
    } SEAM(7);
    if (IN(8)) {
        const int ntiles = (int)__hip_atomic_load(ctl + CW_FILL + 80, __ATOMIC_RELAXED, __HIP_MEMORY_SCOPE_AGENT), off64 = (int)__hip_atomic_load(ctl + CW_FILL + 81, __ATOMIC_RELAXED, __HIP_MEMORY_SCOPE_AGENT);
        LAS int* tl = (LAS int*)(C.lds + PART_OFF); for (int i = C.tid; i < ntiles; i += NTHREADS) tl[i] = ((const int*)(ws + WS_TILEL))[i]; __syncthreads();
        LAS int* lsh = tl + 1024; if (C.tid < 65) { lsh[C.tid] = (int)ctl[CW_LSH + C.tid]; lsh[128 + C.tid] = (int)ctl[CW_LSH + 128 + C.tid]; } __syncthreads();
        MoeDownSched S{ws, tl, ntiles, C.G, C.vcu, off64};
        EpiDown E{ws, lsh};
        pg8::gemm_phase<EpiDown, MoeDownSched, false>(C.lds, pg8::Shape{EFF * 2, EFF * 2, EFF / 64, nullptr}, S, E);
        prep_pb(P, C);
    } SEAM(8);
    if (IN(9)) {
        phase_combine(P, C);
        DenseSched S{(const char*)(ws + WS_PB), (const char*)(ws + WS_WPP), T_ / 256, DM / 256, C.G, C.vcu, PLE * 2, PLE * 2};
        EpiG6 E{(bf16_t*)(ws + WS_PERAW), (float*)(ws + WS_PESTAT)};
        pg8::gemm_phase<EpiG6, DenseSched, false>(C.lds, pg8::Shape{PLE * 2, PLE * 2, PLE / 64, nullptr}, S, E);
    } SEAM(9);
    if (IN(10)) {
        DenseSched S{(const char*)(ws + WS_X2B), (const char*)(ws + WS_WPG), T_ / 256, DM / 256, C.G, C.vcu, DM * 2, DM * 2};
        EpiG5 E{P.out, (const bf16_t*)(ws + WS_PERAW), (const bf16_t*)(ws + WS_X2B), (const float*)(ws + WS_RSTD3), (const float*)(ws + WS_PESTAT), P.in[I_GPO]};
        pg8::gemm_phase<EpiG5, DenseSched, false>(C.lds, pg8::Shape{DM * 2, DM * 2, DM / 64, nullptr}, S, E);
    }
#ifdef SPIN_US
    { const unsigned long long s0 = __builtin_amdgcn_s_memrealtime(); while (__builtin_amdgcn_s_memrealtime() - s0 < (unsigned long long)(SPIN_US) * 100ull) __builtin_amdgcn_s_sleep(8); }
#endif
#ifdef DILATE_PHASE
    DL_MARK(11);
    { const unsigned long long d = dl_t1 - dl_t0, s0 = __builtin_amdgcn_s_memrealtime(); while (__builtin_amdgcn_s_memrealtime() - s0 < d) __builtin_amdgcn_s_sleep(8); }
#endif
#undef IN
#undef SEAM
}

extern "C" void kernel_launch(void* const* d_in, const int* in_sizes, int n_in, void* d_out, int out_size, void* d_ws, size_t ws_size, hipStream_t stream) {
    static int grid = 0;
    if (grid == 0) {
        if (n_in != 31 || in_sizes[0] != T_ * DM || out_size != T_ * DM || ws_size < WS_END) { fprintf(stderr, "kernel_launch: unexpected shapes (n_in %d, in0 %d, out %d, ws %zu, need %zu)\n", n_in, n_in > 0 ? in_sizes[0] : -1, out_size, ws_size, (size_t)WS_END); grid = -1; return; }
        int dev = 0, cus = 0;
        if (hipGetDevice(&dev) != hipSuccess || hipDeviceGetAttribute(&cus, hipDeviceAttributeMultiprocessorCount, dev) != hipSuccess) { grid = -1; return; }
        if (hipFuncSetAttribute((const void*)fwd_kernel, hipFuncAttributeMaxDynamicSharedMemorySize, LDS_BYTES) != hipSuccess) { fprintf(stderr, "kernel_launch: hipFuncSetAttribute failed\n"); grid = -1; return; }
        grid = cus;
    }
    if (grid < 0) return;
    (void)hipMemsetAsync((char*)d_ws + WS_CTL, 0, CTL_BYTES, stream);
    Args a{};
    for (int i = 0; i < 31; ++i) a.P.in[i] = (const float*)d_in[i];
    a.P.out = (float*)d_out; a.P.ws = (unsigned char*)d_ws;
    constexpr int NL = MK_N_LAUNCHES;
    for (int li = 0; li < NL; ++li) {
        a.ph_lo = (NL == N_PHASES) ? li : (li * N_PHASES) / NL; a.ph_hi = (NL == N_PHASES) ? li + 1 : ((li + 1) * N_PHASES) / NL;
        hipLaunchKernelGGL(fwd_kernel, dim3(grid), dim3(NTHREADS), LDS_BYTES, stream, a);
    }
}
```

```cpp
#include <hip/hip_runtime.h>
#include <hip/hip_bf16.h>
#include <cstdio>
#include <cstdint>

#define LAS __attribute__((address_space(3)))
#define GAS __attribute__((address_space(1)))
typedef unsigned short bf16_t;
typedef short bf16x8 __attribute__((ext_vector_type(8)));
typedef short s16x4 __attribute__((ext_vector_type(4)));
typedef float f32x4 __attribute__((ext_vector_type(4)));
typedef float f32x2 __attribute__((ext_vector_type(2)));
typedef float f32x16 __attribute__((ext_vector_type(16)));
typedef unsigned u32x4 __attribute__((ext_vector_type(4)));
typedef unsigned u32x2 __attribute__((ext_vector_type(2)));

constexpr int T_ = 16384, DM = 1024, NB = 8, SEQ = 2048, NH = 8;
constexpr int NZ = 4864;
constexpr int QLAT = 384, KVLAT = 256, ROPE = 64, LATW = 768;
constexpr int QW = 1536, KVW = 2048;
constexpr int NEXP = 64, EFF = 256, NLIST = 65;
constexpr int PLE = 256;
constexpr float NORM_EPS = 1e-6f, LN_EPS = 1e-5f;
constexpr int NTHREADS = 512, NWAVES = 8;

constexpr size_t MiB = 1u << 20, KiB = 1u << 10;
constexpr size_t WS_CTL = 0, CTL_BYTES = 64 * KiB;
constexpr size_t WS_RSTD0 = 1 * MiB, WS_LNMU = WS_RSTD0 + 64 * KiB, WS_LNRS = WS_LNMU + 64 * KiB, WS_RSTD2 = WS_LNRS + 64 * KiB,
                 WS_RSTD3 = WS_RSTD2 + 64 * KiB, WS_RSTDPE = WS_RSTD3 + 64 * KiB;
constexpr size_t WS_PESTAT = 1 * MiB + 512 * KiB;
constexpr size_t WS_COS = 2 * MiB + 512 * KiB, WS_SIN = 4 * MiB + 512 * KiB;
static_assert(WS_RSTDPE + 64 * KiB <= WS_PESTAT && WS_PESTAT + (size_t)T_ * 64 <= WS_COS && WS_SIN + 2 * MiB <= 6 * MiB + 512 * KiB, "small map");
constexpr size_t WS_WIN = 6 * MiB + 512 * KiB;
constexpr size_t WS_WQB = WS_WIN + (size_t)NZ * DM * 2;
constexpr size_t WS_WKVB = WS_WQB + (size_t)QW * QLAT * 2;
constexpr size_t WS_WO = WS_WKVB + (size_t)KVW * KVLAT * 2;
constexpr size_t WS_SGUW = WS_WO + (size_t)DM * DM * 2;
constexpr size_t WS_WSHGU = WS_SGUW + (size_t)8 * 128 * 128 * 2;
constexpr size_t WS_WSHD = WS_WSHGU + (size_t)512 * DM * 2;
constexpr size_t WS_WPG = WS_WSHD + (size_t)DM * EFF * 2;
constexpr size_t WS_WPP = WS_WPG + (size_t)DM * DM * 2;
constexpr size_t WS_WSMALL_END = WS_WPP + (size_t)DM * PLE * 2;
static_assert(WS_WSMALL_END <= 25 * MiB, "small weights");
constexpr size_t WS_WRH = 25 * MiB, WS_WRL = 25 * MiB + 128 * KiB;
constexpr size_t WS_TOKE = 26 * MiB, WS_TOKW = WS_TOKE + 512 * KiB;
constexpr int LIST_CAP = 164096;
constexpr size_t WS_ENT = 27 * MiB, WS_INV = 30 * MiB, WS_TILEL = 31 * MiB;
constexpr size_t S0 = 32 * MiB, S1 = 64 * MiB, S2 = 96 * MiB, S3 = 128 * MiB, S4 = 160 * MiB, S5 = 192 * MiB, S6 = 224 * MiB, S7 = 256 * MiB;
constexpr size_t WS_XB = S0, WS_YAG = S0, WS_HSH = S0;
constexpr size_t WS_GU = S1, WS_GV = S2, WS_SA = S3, WS_LAT = S5, WS_SB = S7;
constexpr size_t WS_GVSTAT = S6, WS_LATSTAT = S6 + 2 * MiB, WS_KPE = S6 + 20 * MiB;
constexpr size_t WS_QRAW = S1, WS_KVRAW = S1 + 48 * MiB;
constexpr size_t WS_X1F8 = S1;
constexpr size_t WS_WGU = S3;
constexpr size_t WS_WD = S5;
constexpr size_t WS_ACT = S6;
constexpr size_t WS_YBUF = 47 * MiB;
constexpr size_t WS_X2B = S6, WS_PERAW = S7;
constexpr size_t WS_PB = 296 * MiB;
constexpr size_t WS_END = 304 * MiB;
static_assert(WS_KVRAW + (size_t)T_ * KVW * 2 <= S5 && WS_YBUF + (size_t)(T_ * 9) * 1024 <= S5 && WS_HSH + (size_t)T_ * EFF * 2 <= WS_YBUF && WS_ACT + (size_t)147456 * 512 <= WS_PB, "map");
constexpr int CW_CNT = 8192;
constexpr int CW_FILL = 192;
constexpr int CW_LSH = 512;
constexpr int CW_BAR = 4096;

__device__ __forceinline__ unsigned f2bf(float f) { unsigned u = __builtin_bit_cast(unsigned, f); return (u + 0x7fffu + ((u >> 16) & 1u)) >> 16; }
__device__ __forceinline__ float bf2f(unsigned h) { return __builtin_bit_cast(float, h << 16); }
__device__ __forceinline__ unsigned pk2(float lo, float hi) { unsigned r; asm volatile("v_cvt_pk_bf16_f32 %0, %1, %2" : "=v"(r) : "v"(lo), "v"(hi)); return r; }
__device__ __forceinline__ float bflo(unsigned w) { return __builtin_bit_cast(float, w << 16); }
__device__ __forceinline__ float bfhi(unsigned w) { return __builtin_bit_cast(float, w & 0xffff0000u); }
__device__ __forceinline__ float wave_sum(float v) {
#pragma unroll
    for (int o = 1; o < 64; o <<= 1) v += __shfl_xor(v, o);
    return v;
}
__device__ __forceinline__ float fast_sigmoid(float x) { return __builtin_amdgcn_rcpf(1.0f + __builtin_amdgcn_exp2f(-1.4426950408889634f * x)); }
__device__ __forceinline__ float gelu_tanh(float x) {
    const float u = 1.5957691216057308f * (x + 0.044715f * x * x * x);
    return x * fast_sigmoid(u);
}
__device__ __forceinline__ float silu(float x) { return x * fast_sigmoid(x); }
constexpr int F8K_WGU = 9, F8K_WD = 4;
__device__ __forceinline__ float clamp8(float v) { return __builtin_amdgcn_fmed3f(v, -448.0f, 448.0f); }
__device__ __forceinline__ unsigned pk4f8(float a, float b, float c, float d) {
    int w = __builtin_amdgcn_cvt_pk_fp8_f32(clamp8(a), clamp8(b), 0, false); w = __builtin_amdgcn_cvt_pk_fp8_f32(clamp8(c), clamp8(d), w, true); return (unsigned)w; }
__device__ __forceinline__ void store8f8(unsigned char* p, f32x4 a, f32x4 b) { u32x2 w; w.x = pk4f8(a[0], a[1], a[2], a[3]); w.y = pk4f8(b[0], b[1], b[2], b[3]); *(u32x2*)p = w; }

struct Params {
    const float* in[31];
    float* out;
    unsigned char* ws;
};
enum { I_X = 0, I_P, I_POS, I_GMIX, I_WIN, I_LNG, I_LNB, I_SGUW, I_SGUB, I_GQA, I_WQB, I_GKVA, I_WKVB, I_GQN, I_GKN, I_GQR, I_GKR, I_WO, I_GFFN, I_WR, I_BR,
       I_WEG, I_WEU, I_WED, I_WSG, I_WSU, I_WSD, I_GPI, I_WPG, I_WPP, I_GPO };
namespace pg8 {
constexpr int BM = 256, BK = 64, HALF = 128, HTB = HALF * BK * 2  , STAGE_BYTES = 8 * HTB;

__device__ __forceinline__ int lds_byte(int r, int c) { const int st = (r >> 4) * 2 + (c >> 5), rr = r & 15, cc = c & 31, ob = rr * 64 + cc * 2; return st * 1024 + (ob ^ (((ob >> 9) & 1) << 5)); }
__device__ __forceinline__ void stage_rc(int b, int& R, int& C) { const int st = b / 1024, sb = b % 1024, swz = sb ^ (((sb >> 9) & 1) << 5); R = (st >> 1) * 16 + swz / 64; C = (st & 1) * 32 + (swz % 64) / 2; }
__device__ __forceinline__ int perm32(int rho) { const int n = rho >> 4, i = rho & 15; return 8 * (i >> 2) + 4 * n + (i & 3); }

struct Unit { const char* A; const char* B; int pm, pn; };
struct Shape { int ldaB, ldbB, nt; const char* Abase; };

typedef int i32x4 __attribute__((ext_vector_type(4)));
typedef int i32x8 __attribute__((ext_vector_type(8)));
__device__ __forceinline__ void mma_f8(f32x4& c, const bf16x8 b0, const bf16x8 b1, const bf16x8 a0, const bf16x8 a1) {
    const i32x4 p0 = __builtin_bit_cast(i32x4, b0), p1 = __builtin_bit_cast(i32x4, b1), q0 = __builtin_bit_cast(i32x4, a0), q1 = __builtin_bit_cast(i32x4, a1);
    const i32x8 bb = __builtin_shufflevector(p0, p1, 0, 1, 2, 3, 4, 5, 6, 7), aa = __builtin_shufflevector(q0, q1, 0, 1, 2, 3, 4, 5, 6, 7);
    asm volatile("v_mfma_f32_16x16x128_f8f6f4 %0, %1, %2, %0" : "+v"(c) : "v"(bb), "v"(aa));
}
template <class Epi, class Sched, bool GATHER, bool F8 = false>
__device__ __forceinline__ void gemm_phase(LAS unsigned char* lds, const Shape sh, const Sched& S, const Epi& E) {
    const int tid = threadIdx.x, wid = __builtin_amdgcn_readfirstlane(tid >> 6), lane = tid & 63, wr = wid >> 2, wc = wid & 3, fr = lane & 15, fq = lane >> 4;
    const int nt = sh.nt;
    int Rr[2], Cc[2];
    unsigned voffB[2], voffA[2];
#pragma unroll
    for (int i = 0; i < 2; ++i) { stage_rc(tid * 16 + i * 8192, Rr[i], Cc[i]); const int Rb = Epi::PERM ? ((Rr[i] & ~31) + perm32(Rr[i] & 31)) : Rr[i];
        voffB[i] = (unsigned)(Rb * sh.ldbB + Cc[i] * 2); voffA[i] = (unsigned)(Rr[i] * sh.ldaB + Cc[i] * 2); }
    const size_t kstep = (size_t)(BK * 2);
    const size_t hstepB = (size_t)HALF * sh.ldbB, hstepA = (size_t)HALF * sh.ldaB;
    const unsigned ldsw = (unsigned)wid * 1024u;
    const int aoff = lds_byte(wr * 64 + fr, fq * 8), boff = lds_byte(wc * 32 + fr, fq * 8);
#define PG8_SA(b, h) (((b) * 2 + (h)) * HTB)
#define PG8_SB(b, h) ((4 + (b) * 2 + (h)) * HTB)
#define PG8_STAGE(bufoff, gbase, voff) do { _Pragma("unroll") for (int _i = 0; _i < 2; ++_i) \
        __builtin_amdgcn_global_load_lds((const unsigned*)((const char*)(gbase) + (voff)[_i]), (LAS unsigned*)(lds + (bufoff) + ldsw + _i * 8192), 16, 0, 0); } while (0)
#define PG8_STAGE_A(bufoff, gbase, h, oarr) do { if (GATHER) { PG8_STAGE(bufoff, gbase, (oarr)[h]); } else { PG8_STAGE(bufoff, (gbase) + (h) * hstepA, voffA); } } while (0)
#define PG8_LDA(dst, b, h) do { _Pragma("unroll") for (int m = 0; m < 4; ++m) _Pragma("unroll") for (int k = 0; k < 2; ++k) dst[m][k] = *(const LAS bf16x8*)(lds + PG8_SA(b, h) + aoff + m * 2048 + k * 1024); } while (0)
#define PG8_LDB(dst, b, h) do { _Pragma("unroll") for (int n = 0; n < 2; ++n) _Pragma("unroll") for (int k = 0; k < 2; ++k) dst[n][k] = *(const LAS bf16x8*)(lds + PG8_SB(b, h) + boff + n * 2048 + k * 1024); } while (0)
#define PG8_MMA(ai, bj, At, Bt) do { __builtin_amdgcn_s_setprio(1); _Pragma("unroll") for (int m = 0; m < 4; ++m) _Pragma("unroll") for (int n = 0; n < 2; ++n) { \
        if constexpr (F8) mma_f8(acc[ai][bj][m][n], Bt[n][0], Bt[n][1], At[m][0], At[m][1]); \
        else { _Pragma("unroll") for (int k = 0; k < 2; ++k) acc[ai][bj][m][n] = __builtin_amdgcn_mfma_f32_16x16x32_bf16(Bt[n][k], At[m][k], acc[ai][bj][m][n], 0, 0, 0); } } __builtin_amdgcn_s_setprio(0); } while (0)
#define PG8_WAIT_V(n) asm volatile("s_waitcnt vmcnt(" #n ")" ::: "memory")
#define PG8_WAIT_L(n) asm volatile("s_waitcnt lgkmcnt(" #n ")" ::: "memory")
#define PG8_BAR __builtin_amdgcn_s_barrier()
#define PG8_SCHED __builtin_amdgcn_sched_barrier(0)
#define PG8_AOFF(o, u) do { _Pragma("unroll") for (int _h = 0; _h < 2; ++_h) _Pragma("unroll") for (int _i = 0; _i < 2; ++_i) { \
        if (GATHER) o[_h][_i] = (unsigned)(((const int*)(u).A)[(_h * HALF + Rr[_i]) * 4]) * (unsigned)sh.ldaB + (unsigned)(Cc[_i] * 2); \
        else o[_h][_i] = 0u; } } while (0)
    Unit cur, nxt; int ui = 0;
    if (!S.next(0, cur)) return;
    f32x4 acc[2][2][4][2];
#pragma unroll
    for (int a = 0; a < 2; ++a)
#pragma unroll
        for (int b = 0; b < 2; ++b)
#pragma unroll
            for (int m = 0; m < 4; ++m)
#pragma unroll
                for (int n = 0; n < 2; ++n) acc[a][b][m][n] = (f32x4){0.f, 0.f, 0.f, 0.f};
    bf16x8 At[4][2], B0[2][2], B1[2][2];
    unsigned oC[2][2], oN[2][2];
    PG8_AOFF(oC, cur);
    const char* cA = GATHER ? sh.Abase : cur.A; const char* cB = cur.B;
    PG8_STAGE(PG8_SB(0, 0), cB, voffB); PG8_STAGE(PG8_SB(0, 1), cB + hstepB, voffB); PG8_STAGE_A(PG8_SA(0, 0), cA, 0, oC); PG8_STAGE_A(PG8_SA(0, 1), cA, 1, oC);
    if (wr == 1) PG8_BAR;
    PG8_WAIT_V(2); PG8_BAR;
    PG8_STAGE(PG8_SB(1, 0), cB + kstep, voffB); PG8_STAGE_A(PG8_SA(1, 0), cA + kstep, 0, oC); PG8_STAGE(PG8_SB(1, 1), cB + hstepB + kstep, voffB);
    PG8_WAIT_V(6); PG8_BAR;
    for (;;) {
        const bool has_next = S.next(ui + 1, nxt);
        const char* nA = GATHER ? cA : (has_next ? nxt.A : cA); const char* nB = has_next ? nxt.B : cB;
        if (GATHER) { if (has_next) { PG8_AOFF(oN, nxt); } else {
#pragma unroll
            for (int h = 0; h < 2; ++h)
#pragma unroll
                for (int i = 0; i < 2; ++i) oN[h][i] = oC[h][i]; } }
#pragma unroll 1
        for (int t = 0; t < nt; t += 2) {
            const bool last = (t == nt - 2);
            const char* a1 = cA + (size_t)(t + 1) * kstep;
            const char* a2 = last ? nA : cA + (size_t)(t + 2) * kstep; const char* b2 = last ? nB : cB + (size_t)(t + 2) * kstep;
            const char* a3 = a2 + kstep; const char* b3 = b2 + kstep;
            unsigned o2[2][2];
#pragma unroll
            for (int h = 0; h < 2; ++h)
#pragma unroll
                for (int i = 0; i < 2; ++i) o2[h][i] = (GATHER && last) ? oN[h][i] : oC[h][i];
            PG8_LDB(B0, 0, 0); PG8_LDB(B1, 0, 1); PG8_SCHED; PG8_LDA(At, 0, 0); PG8_STAGE_A(PG8_SA(1, 1), a1, 1, oC);
            PG8_WAIT_V(8); PG8_WAIT_L(0); PG8_BAR; PG8_MMA(0, 0, At, B0); PG8_MMA(0, 1, At, B1); PG8_BAR; PG8_SCHED;
            PG8_LDA(At, 0, 1); PG8_STAGE(PG8_SB(0, 0), b2, voffB); PG8_STAGE(PG8_SB(0, 1), b2 + hstepB, voffB); PG8_STAGE_A(PG8_SA(0, 0), a2, 0, o2);
            PG8_WAIT_V(8); PG8_WAIT_L(0); PG8_BAR; PG8_MMA(1, 0, At, B0); PG8_MMA(1, 1, At, B1); PG8_BAR; PG8_SCHED;
            PG8_LDB(B0, 1, 0); PG8_LDB(B1, 1, 1); PG8_SCHED; PG8_LDA(At, 1, 0); PG8_STAGE_A(PG8_SA(0, 1), a2, 1, o2);
            PG8_WAIT_V(8); PG8_WAIT_L(0); PG8_BAR; PG8_MMA(0, 0, At, B0); PG8_MMA(0, 1, At, B1); PG8_BAR; PG8_SCHED;
            PG8_LDA(At, 1, 1); PG8_STAGE(PG8_SB(1, 0), b3, voffB); PG8_STAGE(PG8_SB(1, 1), b3 + hstepB, voffB); PG8_STAGE_A(PG8_SA(1, 0), a3, 0, o2);
            PG8_WAIT_V(8); PG8_WAIT_L(0); PG8_BAR; PG8_MMA(1, 0, At, B0); PG8_MMA(1, 1, At, B1); PG8_BAR; PG8_SCHED;
        }
        if (wr == 0) PG8_BAR;
        if constexpr (F8) asm volatile("s_nop 15\n\ts_nop 7" ::: "memory");
        E(acc, cur, wr, wc, fr, fq);
        if (!has_next) break;
#pragma unroll
        for (int a = 0; a < 2; ++a)
#pragma unroll
            for (int b = 0; b < 2; ++b)
#pragma unroll
                for (int m = 0; m < 4; ++m)
#pragma unroll
                    for (int n = 0; n < 2; ++n) acc[a][b][m][n] = (f32x4){0.f, 0.f, 0.f, 0.f};
        cur = nxt; cA = nA; cB = nB; ++ui;
        if (GATHER) {
#pragma unroll
            for (int h = 0; h < 2; ++h)
#pragma unroll
                for (int i = 0; i < 2; ++i) oC[h][i] = oN[h][i]; }
        if (wr == 1) PG8_BAR;
    }
    PG8_WAIT_V(0);
    PG8_BAR;
#undef PG8_SA
#undef PG8_SB
#undef PG8_STAGE
#undef PG8_STAGE_A
#undef PG8_LDA
#undef PG8_LDB
#undef PG8_MMA
#undef PG8_WAIT_V
#undef PG8_WAIT_L
#undef PG8_BAR
#undef PG8_SCHED
#undef PG8_AOFF
}
}
__device__ __forceinline__ int vcu_of(int bx, int G) { return (G % 8 == 0) ? (bx % 8) * (G / 8) + bx / 8 : bx; }

struct DenseSched {
    const char* A; const char* B; int nM, nN, G, c, ldaB, ldbB;
    __device__ __forceinline__ bool next(int i, pg8::Unit& u) const {
        const int L = i * G + c; if (L >= nM * nN) return false;
        const int nig = 8 * nN, gid = L / nig, fm = gid * 8, gsz = (nM - fm) < 8 ? (nM - fm) : 8;
        u.pm = fm + ((L % nig) % gsz); u.pn = (L % nig) / gsz;
        u.A = A + (size_t)u.pm * 256 * ldaB; u.B = B + (size_t)u.pn * 256 * ldbB; return true;
    }
};

__device__ __forceinline__ void store8bf(bf16_t* p, f32x4 a, f32x4 b) { u32x4 w; w.x = pk2(a[0], a[1]); w.y = pk2(a[2], a[3]); w.z = pk2(b[0], b[1]); w.w = pk2(b[2], b[3]); *(u32x4*)p = w; }

struct EpiG1 {
    static constexpr bool PERM = true;
    unsigned char* ws;
    __device__ __forceinline__ void operator()(const f32x4 (&acc)[2][2][4][2], const pg8::Unit& u, int wr, int wc, int fr, int fq) const {
        const float* rstd = (const float*)(ws + WS_RSTD0);
        const int pn = u.pn; const int seg = pn < 8 ? 0 : (pn >> 2) - 1;
        const int row0 = u.pm * 256 + wr * 64 + fr;
        if (seg == 0) {
            bf16_t* gs = (bf16_t*)(ws + WS_GU); const int col0 = pn * 128 + wc * 32 + 8 * fq;
#pragma unroll
            for (int ai = 0; ai < 2; ++ai)
#pragma unroll
                for (int m = 0; m < 4; ++m) { const int row = row0 + ai * 128 + m * 16; const float rs = rstd[row];
                    f32x4 a0 = acc[ai][0][m][0] * rs, a1 = acc[ai][0][m][1] * rs, g0 = acc[ai][1][m][0] * rs, g1 = acc[ai][1][m][1] * rs;
#pragma unroll
                    for (int j = 0; j < 4; ++j) { a0[j] = gelu_tanh(a0[j]) * fast_sigmoid(g0[j]); a1[j] = gelu_tanh(a1[j]) * fast_sigmoid(g1[j]); }
                    store8bf(gs + (size_t)row * DM + col0, a0, a1); }
            return; }
        bf16_t* base; int ldc, colt;
        if (seg == 1) { base = (bf16_t*)(ws + WS_GV); ldc = DM; colt = (pn - 8) * 256; }
        else if (seg == 2) { base = (bf16_t*)(ws + WS_SB); ldc = DM; colt = (pn - 12) * 256; }
        else { base = (bf16_t*)(ws + WS_LAT); ldc = LATW; colt = (pn - 16) * 256; }
        const int act = seg == 1 ? 1 : (seg == 2 ? 2 : 0);
        const int col0 = colt + wc * 32 + 8 * fq;
        float* gvstat = (float*)(ws + WS_GVSTAT); float* latstat = (float*)(ws + WS_LATSTAT);
#pragma unroll
        for (int ai = 0; ai < 2; ++ai)
#pragma unroll
            for (int m = 0; m < 4; ++m) { const int row = row0 + ai * 128 + m * 16; const float rs = rstd[row]; bf16_t* rowp = base + (size_t)row * ldc + col0;
                float s1 = 0.f, q0 = 0.f, q1 = 0.f;
#pragma unroll
                for (int bj = 0; bj < 2; ++bj) { f32x4 v0 = acc[ai][bj][m][0] * rs, v1 = acc[ai][bj][m][1] * rs;
                    if (act == 1) {
#pragma unroll
                        for (int j = 0; j < 4; ++j) { v0[j] = gelu_tanh(v0[j]); v1[j] = gelu_tanh(v1[j]); } }
                    else if (act == 2) {
#pragma unroll
                        for (int j = 0; j < 4; ++j) { v0[j] = fast_sigmoid(v0[j]); v1[j] = fast_sigmoid(v1[j]); } }
                    store8bf(rowp + bj * 128, v0, v1);
                    if (seg == 1 || seg == 3) { const float sq = (v0[0] * v0[0] + v0[1] * v0[1]) + (v0[2] * v0[2] + v0[3] * v0[3]) + (v1[0] * v1[0] + v1[1] * v1[1]) + (v1[2] * v1[2] + v1[3] * v1[3]);
                        s1 += (v0[0] + v0[1]) + (v0[2] + v0[3]) + (v1[0] + v1[1]) + (v1[2] + v1[3]); if (bj == 0) q0 = sq; else q1 = sq; } }
                if (seg == 1) { float q = q0 + q1; s1 += __shfl_xor(s1, 16); s1 += __shfl_xor(s1, 32); q += __shfl_xor(q, 16); q += __shfl_xor(q, 32);
                    if (fq == 0) { f32x2 o = {s1, q}; *(f32x2*)(gvstat + (size_t)row * 32 + 2 * ((pn - 8) * 4 + wc)) = o; } }
                else if (seg == 3) { q0 += __shfl_xor(q0, 16); q0 += __shfl_xor(q0, 32); q1 += __shfl_xor(q1, 16); q1 += __shfl_xor(q1, 32);
                    if (fq == 0) { if (pn == 16) latstat[row * 16 + wc] = q0 + q1; else if (pn == 17) latstat[row * 16 + 4 + wc] = q0 + q1; else { latstat[row * 16 + 8 + wc] = q0; latstat[row * 16 + 12 + wc] = q1; } } }
            }
    }
};
struct EpiBf16 {
    static constexpr bool PERM = true;
    bf16_t* O; int ldc;
    __device__ __forceinline__ void operator()(const f32x4 (&acc)[2][2][4][2], const pg8::Unit& u, int wr, int wc, int fr, int fq) const {
        const int row0 = u.pm * 256 + wr * 64 + fr, col0 = u.pn * 256 + wc * 32 + 8 * fq;
#pragma unroll
        for (int ai = 0; ai < 2; ++ai)
#pragma unroll
            for (int m = 0; m < 4; ++m) { bf16_t* rowp = O + (size_t)(row0 + ai * 128 + m * 16) * ldc + col0;
#pragma unroll
                for (int bj = 0; bj < 2; ++bj) store8bf(rowp + bj * 128, acc[ai][bj][m][0], acc[ai][bj][m][1]); }
    }
};
constexpr int PART_OFF = 131072 + 1024;
__device__ __forceinline__ float sumsq8(const f32x4 a, const f32x4 b) { return (a[0] * a[0] + a[1] * a[1]) + (a[2] * a[2] + a[3] * a[3]) + (b[0] * b[0] + b[1] * b[1]) + (b[2] * b[2] + b[3] * b[3]); }
struct EpiQ {
    static constexpr bool PERM = true;
    unsigned char* ws; LAS unsigned char* lds; const float* gqn; const float* gqr;
    __device__ __forceinline__ void operator()(const f32x4 (&acc)[2][2][4][2], const pg8::Unit& u, int wr, int wc, int fr, int fq) const {
        LAS float* part = (LAS float*)(lds + PART_OFF);
        const float* latstat = (const float*)(ws + WS_LATSTAT); bf16_t* Q = (bf16_t*)(ws + WS_QRAW);
        const float* cs = (const float*)(ws + WS_COS); const float* sn = (const float*)(ws + WS_SIN);
        const float scale = 0.07216878364870322f;
        const int pn = u.pn; const bool rope = pn >= 4;
        { int t_ = threadIdx.x; asm volatile("" : "+v"(t_)); fr = t_ & 15; fq = (t_ >> 4) & 3; wc = (t_ >> 6) & 3; wr = t_ >> 8; }
        const int trow0 = wr * 64 + fr, row0 = u.pm * 256 + trow0;
        float rq[2][4];
#pragma unroll
        for (int ai = 0; ai < 2; ++ai)
#pragma unroll
            for (int m = 0; m < 4; ++m) { const int row = row0 + ai * 128 + m * 16; const f32x4 a = *(const f32x4*)(latstat + row * 16 + 4), b = *(const f32x4*)(latstat + row * 16 + 8);
                rq[ai][m] = 1.0f / sqrtf((((a[0] + a[1]) + (a[2] + a[3])) + ((b[0] + b[1]) + (b[2] + b[3]))) * (1.0f / QLAT) + NORM_EPS);
#pragma unroll
                for (int bj = 0; bj < 2; ++bj) { float s = sumsq8(acc[ai][bj][m][0], acc[ai][bj][m][1]) * (rq[ai][m] * rq[ai][m]); s += __shfl_xor(s, 16); s += __shfl_xor(s, 32);
                    if (fq == 0) part[((trow0 + ai * 128 + m * 16) * 2 + bj) * 4 + wc] = s; }
                asm volatile("" ::: "memory"); }
        asm volatile("s_waitcnt lgkmcnt(0)" ::: "memory"); __builtin_amdgcn_s_barrier(); asm volatile("" ::: "memory");
        if (!rope) {
            const f32x4 g0 = *(const f32x4*)(gqn + wc * 32 + 8 * fq), g1 = *(const f32x4*)(gqn + wc * 32 + 8 * fq + 4);
#pragma unroll
            for (int ai = 0; ai < 2; ++ai)
#pragma unroll
                for (int m = 0; m < 4; ++m) { const int tr = trow0 + ai * 128 + m * 16; const int row = u.pm * 256 + tr;
#pragma unroll
                    for (int bj = 0; bj < 2; ++bj) { const f32x4 pp = *(const LAS f32x4*)(part + (tr * 2 + bj) * 4); const float tot = (pp[0] + pp[1]) + (pp[2] + pp[3]);
                        const float f = rq[ai][m] * (1.0f / sqrtf(tot * (1.0f / 128) + NORM_EPS)) * scale;
                        store8bf(Q + (size_t)row * QW + (2 * pn + bj) * 192 + wc * 32 + 8 * fq, acc[ai][bj][m][0] * f * g0, acc[ai][bj][m][1] * f * g1); }
                    asm volatile("" ::: "memory"); }
        } else {
            const int g = 4 * (wc & 1) + fq;
            const f32x4 g0 = *(const f32x4*)(gqr + 4 * g), g1 = *(const f32x4*)(gqr + 32 + 4 * g);
#pragma unroll
            for (int ai = 0; ai < 2; ++ai)
#pragma unroll
                for (int m = 0; m < 4; ++m) { const int tr = trow0 + ai * 128 + m * 16; const int row = u.pm * 256 + tr;
                    const f32x4 c = *(const f32x4*)(cs + row * 32 + 4 * g), s = *(const f32x4*)(sn + row * 32 + 4 * g);
#pragma unroll
                    for (int bj = 0; bj < 2; ++bj) { const LAS float* pp = part + (tr * 2 + bj) * 4 + (wc & 2); const float tot = pp[0] + pp[1];
                        const float f = rq[ai][m] * (1.0f / sqrtf(tot * (1.0f / ROPE) + NORM_EPS));
                        const f32x4 y1 = acc[ai][bj][m][0] * f * g0, y2 = acc[ai][bj][m][1] * f * g1;
                        const int hd = (pn - 4) * 4 + 2 * bj + (wc >> 1);
                        store8bf(Q + (size_t)row * QW + hd * 192 + 128 + 8 * g, (y1 * c - y2 * s) * scale, (y2 * c + y1 * s) * scale); }
                    asm volatile("" ::: "memory"); }
        }
    }
};
struct EpiKV {
    static constexpr bool PERM = true;
    unsigned char* ws; LAS unsigned char* lds; const float* gkn;
    __device__ __forceinline__ void operator()(const f32x4 (&acc)[2][2][4][2], const pg8::Unit& u, int wr, int wc, int fr, int fq) const {
        LAS float* part = (LAS float*)(lds + PART_OFF);
        const float* latstat = (const float*)(ws + WS_LATSTAT); bf16_t* KV = (bf16_t*)(ws + WS_KVRAW);
        { int t_ = threadIdx.x; asm volatile("" : "+v"(t_)); fr = t_ & 15; fq = (t_ >> 4) & 3; wc = (t_ >> 6) & 3; wr = t_ >> 8; }
        const int trow0 = wr * 64 + fr, row0 = u.pm * 256 + trow0;
        float rk[2][4];
#pragma unroll
        for (int ai = 0; ai < 2; ++ai)
#pragma unroll
            for (int m = 0; m < 4; ++m) { const int row = row0 + ai * 128 + m * 16; const f32x4 a = *(const f32x4*)(latstat + row * 16);
                rk[ai][m] = 1.0f / sqrtf(((a[0] + a[1]) + (a[2] + a[3])) * (1.0f / KVLAT) + NORM_EPS);
                float s = sumsq8(acc[ai][0][m][0], acc[ai][0][m][1]) * (rk[ai][m] * rk[ai][m]); s += __shfl_xor(s, 16); s += __shfl_xor(s, 32);
                if (fq == 0) part[((trow0 + ai * 128 + m * 16) * 2) * 4 + wc] = s;
                asm volatile("" ::: "memory"); }
        asm volatile("s_waitcnt lgkmcnt(0)" ::: "memory"); __builtin_amdgcn_s_barrier(); asm volatile("" ::: "memory");
        const f32x4 g0 = *(const f32x4*)(gkn + wc * 32 + 8 * fq), g1 = *(const f32x4*)(gkn + wc * 32 + 8 * fq + 4);
#pragma unroll
        for (int ai = 0; ai < 2; ++ai)
#pragma unroll
            for (int m = 0; m < 4; ++m) { const int tr = trow0 + ai * 128 + m * 16; const int row = u.pm * 256 + tr;
                const f32x4 pp = *(const LAS f32x4*)(part + (tr * 2) * 4); const float tot = (pp[0] + pp[1]) + (pp[2] + pp[3]);
                const float f = rk[ai][m] * (1.0f / sqrtf(tot * (1.0f / 128) + NORM_EPS));
                bf16_t* rowp = KV + (size_t)row * KVW + u.pn * 256 + wc * 32 + 8 * fq;
                store8bf(rowp, acc[ai][0][m][0] * f * g0, acc[ai][0][m][1] * f * g1);
                store8bf(rowp + 128, acc[ai][1][m][0] * rk[ai][m], acc[ai][1][m][1] * rk[ai][m]);
                asm volatile("" ::: "memory"); }
    }
};
struct EpiG4 {
    static constexpr bool PERM = true;
    const float* x; bf16_t* x1b; unsigned char* x1q;
    __device__ __forceinline__ void operator()(const f32x4 (&acc)[2][2][4][2], const pg8::Unit& u, int wr, int wc, int fr, int fq) const {
        const int row0 = u.pm * 256 + wr * 64 + fr, col0 = u.pn * 256 + wc * 32 + 8 * fq;
#pragma unroll
        for (int ai = 0; ai < 2; ++ai)
#pragma unroll
            for (int m = 0; m < 4; ++m) { const size_t off = (size_t)(row0 + ai * 128 + m * 16) * DM + col0;
#pragma unroll
                for (int bj = 0; bj < 2; ++bj) { const size_t o = off + bj * 128;
                    const f32x4 v0 = *(const f32x4*)(x + o) + acc[ai][bj][m][0], v1 = *(const f32x4*)(x + o + 4) + acc[ai][bj][m][1];
                    store8bf(x1b + o, v0, v1); store8f8(x1q + o, v0, v1); } }
    }
};
struct EpiG6 {
    static constexpr bool PERM = true;
    bf16_t* O; float* pestat;
    __device__ __forceinline__ void operator()(const f32x4 (&acc)[2][2][4][2], const pg8::Unit& u, int wr, int wc, int fr, int fq) const {
        const int row0 = u.pm * 256 + wr * 64 + fr, col0 = u.pn * 256 + wc * 32 + 8 * fq;
#pragma unroll
        for (int ai = 0; ai < 2; ++ai)
#pragma unroll
            for (int m = 0; m < 4; ++m) { const int row = row0 + ai * 128 + m * 16; bf16_t* rowp = O + (size_t)row * DM + col0; float s = 0.f;
#pragma unroll
                for (int bj = 0; bj < 2; ++bj) { const f32x4 v0 = acc[ai][bj][m][0], v1 = acc[ai][bj][m][1]; store8bf(rowp + bj * 128, v0, v1);
                    s += (v0[0] * v0[0] + v0[1] * v0[1]) + (v0[2] * v0[2] + v0[3] * v0[3]) + (v1[0] * v1[0] + v1[1] * v1[1]) + (v1[2] * v1[2] + v1[3] * v1[3]); }
                s += __shfl_xor(s, 16); s += __shfl_xor(s, 32);
                if (fq == 0) pestat[row * 16 + u.pn * 4 + wc] = s; }
    }
};
struct EpiG5 {
    static constexpr bool PERM = false;
    float* out; const bf16_t* pe; const bf16_t* x2b; const float* rstd3; const float* pestat; const float* gout;
    __device__ __forceinline__ void operator()(const f32x4 (&acc)[2][2][4][2], const pg8::Unit& u, int wr, int wc, int fr, int fq) const {
        const int row0 = u.pm * 256 + wr * 64 + fr, col0 = u.pn * 256 + wc * 32 + 4 * fq;
        f32x4 gv[2][2];
#pragma unroll
        for (int bj = 0; bj < 2; ++bj)
#pragma unroll
            for (int n = 0; n < 2; ++n) gv[bj][n] = *(const f32x4*)(gout + col0 + bj * 128 + n * 16);
#pragma unroll
        for (int ai = 0; ai < 2; ++ai)
#pragma unroll
            for (int m = 0; m < 4; ++m) { const int row = row0 + ai * 128 + m * 16; const size_t off = (size_t)row * DM + col0; const float r3 = rstd3[row];
                const f32x4* ps = (const f32x4*)(pestat + row * 16); const f32x4 p0 = ps[0], p1 = ps[1], p2 = ps[2], p3 = ps[3];
                const float sq = ((p0[0] + p0[1]) + (p0[2] + p0[3])) + ((p1[0] + p1[1]) + (p1[2] + p1[3])) + ((p2[0] + p2[1]) + (p2[2] + p2[3])) + ((p3[0] + p3[1]) + (p3[2] + p3[3]));
                const float rp = 1.0f / sqrtf(sq * (1.0f / DM) + NORM_EPS);
#pragma unroll
                for (int bj = 0; bj < 2; ++bj)
#pragma unroll
                    for (int n = 0; n < 2; ++n) { const size_t o = off + bj * 128 + n * 16; const u32x2 pw = *(const u32x2*)(pe + o); const u32x2 xw = *(const u32x2*)(x2b + o); const f32x4 xv = {bflo(xw.x), bfhi(xw.x), bflo(xw.y), bfhi(xw.y)};
                        const f32x4 a = acc[ai][bj][m][n]; f32x4 r;
                        r[0] = xv[0] + fast_sigmoid(a[0] * r3) * (bflo(pw.x) * rp * gv[bj][n][0]);
                        r[1] = xv[1] + fast_sigmoid(a[1] * r3) * (bfhi(pw.x) * rp * gv[bj][n][1]);
                        r[2] = xv[2] + fast_sigmoid(a[2] * r3) * (bflo(pw.y) * rp * gv[bj][n][2]);
                        r[3] = xv[3] + fast_sigmoid(a[3] * r3) * (bfhi(pw.y) * rp * gv[bj][n][3]);
                        *(f32x4*)(out + o) = r; }
                asm volatile("" ::: "memory"); }
    }
};

struct MoeGuSched {
    unsigned char* ws; const LAS int* tl; int ntiles, G, c;
    __device__ __forceinline__ bool next(int i, pg8::Unit& u) const {
        const int L = i * G + c; if (L >= ntiles * 2) return false;
        const int rt = L >> 1, pn = L & 1, li = __builtin_amdgcn_readfirstlane(tl[rt]);
        u.pm = rt; u.pn = pn | (li == 64 ? 256 : 0); u.A = (const char*)((const u32x4*)(ws + WS_ENT) + rt * 256);
        u.B = (const char*)(li == 64 ? ws + WS_WSHGU : ws + WS_WGU + (size_t)li * 512 * DM) + (size_t)pn * 256 * DM; return true;
    }
};
struct EpiGu {
    static constexpr bool PERM = true;
    unsigned char* ws; int off64;
    __device__ __forceinline__ void operator()(const f32x4 (&acc)[2][2][4][2], const pg8::Unit& u, int wr, int wc, int fr, int fq) const {
        unsigned char* base = (u.pn & 256) ? ws + WS_HSH - (size_t)off64 * EFF : ws + WS_ACT;
        const u32x4* ent = (const u32x4*)(ws + WS_ENT);
        const int row0 = u.pm * 256 + wr * 64 + fr, col0 = (u.pn & 1) * 128 + wc * 32 + 8 * fq;
#pragma unroll
        for (int ai = 0; ai < 2; ++ai)
#pragma unroll
            for (int m = 0; m < 4; ++m) { const int idx = row0 + ai * 128 + m * 16; const u32x4 en = ent[idx]; const float s = __uint_as_float(en.w) * (1.0f / (float)(1 << F8K_WGU)), w = __uint_as_float(en.z);
                f32x4 g0 = acc[ai][0][m][0] * s, g1 = acc[ai][0][m][1] * s, u0 = acc[ai][1][m][0] * (s * w), u1 = acc[ai][1][m][1] * (s * w);
#pragma unroll
                for (int j = 0; j < 4; ++j) { g0[j] = silu(g0[j]) * u0[j]; g1[j] = silu(g1[j]) * u1[j]; }
                store8f8(base + (size_t)idx * EFF + col0, g0, g1); }
    }
};
struct MoeDownSched {
    unsigned char* ws; const LAS int* tl; int ntiles, G, c, off64;
    __device__ __forceinline__ bool next(int i, pg8::Unit& u) const {
        const int L = (i >> 1) * G + c; if (L >= ntiles * 2) return false;
        const int rt = L >> 1, pn = (L & 1) * 2 + (i & 1), li = __builtin_amdgcn_readfirstlane(tl[rt]);
        u.pm = rt; u.pn = pn | (li << 8);
        u.A = (const char*)((li == 64) ? ws + WS_HSH + (size_t)(rt * 256 - off64) * EFF : ws + WS_ACT + (size_t)rt * 256 * EFF);
        u.B = (const char*)(li == 64 ? ws + WS_WSHD : ws + WS_WD + (size_t)li * DM * EFF) + (size_t)pn * 256 * EFF; return true;
    }
};
struct EpiDown {
    static constexpr bool PERM = true;
    unsigned char* ws; const LAS int* lsh;
    __device__ __forceinline__ void operator()(const f32x4 (&acc)[2][2][4][2], const pg8::Unit& u, int wr, int wc, int fr, int fq) const {
        unsigned char* ybuf = ws + WS_YBUF; const int li = u.pn >> 8, pn = u.pn & 255;
        const int shift = lsh[li], lim = lsh[128 + li];
        const int row0 = u.pm * 256 + wr * 64 + fr; const unsigned col0 = (unsigned)(pn * 256 + wc * 32 + 8 * fq);
#pragma unroll
        for (int ai = 0; ai < 2; ++ai)
#pragma unroll
            for (int m = 0; m < 4; ++m) { const int row = row0 + ai * 128 + m * 16;
                if (row < lim) { const unsigned o = (unsigned)(row - shift) * 1024u + col0;
#pragma unroll
                    for (int bj = 0; bj < 2; ++bj) { const f32x4 v0 = acc[ai][bj][m][0], v1 = acc[ai][bj][m][1];
                        u32x2 w; w.x = pk4f8(v0[0], v0[1], v0[2], v0[3]); w.y = pk4f8(v1[0], v1[1], v1[2], v1[3]); *(u32x2*)(ybuf + o + bj * 128) = w; } } }
    }
};
struct Ctx {
    LAS unsigned char* lds; unsigned char* ws; int tid, lane, wave, vcu, G;
};
#define LDS_WAIT() asm volatile("s_waitcnt lgkmcnt(0)" ::: "memory")

template <bool F8>
__device__ __forceinline__ void tr_item(const float* W, int ldw, int k0, int src0, bf16_t* WT, int ldt, int dst0, const float* gain, LAS float* scr, int lane, bool ropeperm, float qs) {
    const int c4 = (lane & 15) * 4, r0 = lane >> 4;
    f32x4 v[16];
#pragma unroll
    for (int i = 0; i < 16; ++i) v[i] = *(const f32x4*)(W + (size_t)(k0 + 4 * i + r0) * ldw + src0 + c4);
    if (gain) {
#pragma unroll
        for (int i = 0; i < 16; ++i) v[i] = v[i] * gain[k0 + 4 * i + r0]; }
    const int c = lane & 7;
#pragma unroll
    for (int half = 0; half < 2; ++half) {
        if (((lane & 15) >> 3) == half) {
#pragma unroll
            for (int i = 0; i < 16; ++i) { LAS float* d = scr + (4 * i + r0) * 33 + (c4 - 32 * half); d[0] = v[i][0]; d[1] = v[i][1]; d[2] = v[i][2]; d[3] = v[i][3]; } }
        LDS_WAIT(); asm volatile("" ::: "memory");
#pragma unroll
        for (int j = 0; j < 4; ++j) { const int n = (lane >> 3) + 8 * j; const LAS float* s = scr + (8 * c) * 33 + n;
            const int drow = ropeperm ? 8 * (n >> 2) + 4 * half + (n & 3) : 32 * half + n;
            if constexpr (F8) { u32x2 o; o.x = pk4f8(s[0 * 33] * qs, s[1 * 33] * qs, s[2 * 33] * qs, s[3 * 33] * qs); o.y = pk4f8(s[4 * 33] * qs, s[5 * 33] * qs, s[6 * 33] * qs, s[7 * 33] * qs);
                *(u32x2*)((unsigned char*)WT + (size_t)(dst0 + drow) * ldt + k0 + 8 * c) = o; }
            else { u32x4 o; o.x = pk2(s[0 * 33], s[1 * 33]); o.y = pk2(s[2 * 33], s[3 * 33]); o.z = pk2(s[4 * 33], s[5 * 33]); o.w = pk2(s[6 * 33], s[7 * 33]);
                *(u32x4*)(WT + (size_t)(dst0 + drow) * ldt + k0 + 8 * c) = o; } }
        LDS_WAIT(); asm volatile("" ::: "memory");
    }
}
struct TrJob { const float* W; int ldw, K, ncols, src0; bf16_t* WT; int dst0; const float* gain; bool ropeperm; int f8k; };
__device__ __forceinline__ int trjob_items(const TrJob& j) { return (j.K / 64) * (j.ncols / 64); }
template <int MODE>
__device__ __forceinline__ void trjob_run(const TrJob& j, int item, LAS float* scr, int lane) {
    const int nblk = j.ncols / 64, kb = item / nblk, nb = item % nblk;
    if (MODE == 1 || (MODE == 2 && j.f8k > 0)) tr_item<true>(j.W, j.ldw, kb * 64, j.src0 + nb * 64, j.WT, j.K, j.dst0 + nb * 64, j.gain, scr, lane, false, (float)(1 << j.f8k));
    else tr_item<false>(j.W, j.ldw, kb * 64, j.src0 + nb * 64, j.WT, j.K, j.dst0 + nb * 64, j.gain, scr, lane, j.ropeperm, 1.0f);
}

struct JobDesc { int in_idx, ldw, K, ncols, src0; unsigned wt_off; int dst0, gain_idx, perm, f8k; };
#define QJ(h) {I_WQB, QW, QLAT, 128, (h) * 192, (unsigned)WS_WQB, (h) * 128, I_GQA, 0, 0}
#define RJ(h) {I_WQB, QW, QLAT, 64, (h) * 192 + 128, (unsigned)WS_WQB, 1024 + (h) * 64, I_GQA, 1, 0}
#define UJ(j) {I_WIN, 4800, DM, 128, 128 * (j), (unsigned)WS_WIN, 256 * (j), I_GMIX, 0, 0}, {I_WIN, 4800, DM, 128, 2752 + 128 * (j), (unsigned)WS_WIN, 256 * (j) + 128, I_GMIX, 0, 0}
constexpr int NJOBS = 46, NESS = 21;
__constant__ JobDesc JOBS[NJOBS] = {
    UJ(0), UJ(1), UJ(2), UJ(3), UJ(4), UJ(5), UJ(6), UJ(7),
    {I_WIN, 4800, DM, 1024, 1024, (unsigned)WS_WIN, 2048, I_GMIX, 0, 0},
    {I_WIN, 4800, DM, 1024, 3776, (unsigned)WS_WIN, 3072, I_GMIX, 0, 0},
    {I_WIN, 4800, DM, 256, 2432, (unsigned)WS_WIN, 4096, I_GMIX, 0, 0},
    {I_WIN, 4800, DM, 384, 2048, (unsigned)WS_WIN, 4352, I_GMIX, 0, 0},
    {I_WIN, 4800, DM, 64, 2688, (unsigned)WS_WIN, 4736, I_GMIX, 0, 0},
    {I_WKVB, KVW, KVLAT, KVW, 0, (unsigned)WS_WKVB, 0, I_GKVA, 0, 0},
    {I_WO, DM, DM, DM, 0, (unsigned)WS_WO, 0, -1, 0, 0},
    {I_WSG, EFF, DM, 128, 0, (unsigned)WS_WSHGU, 0, I_GFFN, 0, F8K_WGU}, {I_WSG, EFF, DM, 128, 128, (unsigned)WS_WSHGU, 256, I_GFFN, 0, F8K_WGU},
    {I_WSU, EFF, DM, 128, 0, (unsigned)WS_WSHGU, 128, I_GFFN, 0, F8K_WGU}, {I_WSU, EFF, DM, 128, 128, (unsigned)WS_WSHGU, 384, I_GFFN, 0, F8K_WGU},
    {I_WSD, DM, EFF, DM, 0, (unsigned)WS_WSHD, 0, -1, 0, F8K_WD},
    {I_WPG, DM, DM, DM, 0, (unsigned)WS_WPG, 0, I_GPI, 0, 0},
    {I_WPP, DM, PLE, DM, 0, (unsigned)WS_WPP, 0, -1, 0, 0},
    QJ(0), QJ(1), QJ(2), QJ(3), QJ(4), QJ(5), QJ(6), QJ(7), RJ(0), RJ(1), RJ(2), RJ(3), RJ(4), RJ(5), RJ(6), RJ(7)};
#undef QJ
#undef RJ
#undef UJ

__device__ __forceinline__ void phase_prep0(const Params& P, const Ctx& C) {
    LAS float* scr = (LAS float*)(C.lds + C.wave * 16384);
    unsigned char* ws = C.ws;
    const int gw = C.vcu * NWAVES + C.wave, NGW = C.G * NWAVES, lane = C.lane;
    int total = 0;
#pragma unroll
    for (int j = 0; j < NESS; ++j) total += (JOBS[j].K / 64) * (JOBS[j].ncols / 64);
    for (int it = gw; it < total; it += NGW) {
        int r = it, jj = 0;
        for (int j = 0; j < NESS; ++j) { const int n = (JOBS[j].K / 64) * (JOBS[j].ncols / 64); if (r >= n) { r -= n; jj = j + 1; } else break; }
        const JobDesc d = JOBS[jj];
        TrJob j{P.in[d.in_idx], d.ldw, d.K, d.ncols, d.src0, (bf16_t*)(ws + d.wt_off), d.dst0, d.gain_idx >= 0 ? P.in[d.gain_idx] : nullptr, d.perm != 0, 0};
        trjob_run<0>(j, r, scr, lane);
    }
    bf16_t* WinT = (bf16_t*)(ws + WS_WIN);
    { const int gt = C.vcu * NTHREADS + C.tid, NT = C.G * NTHREADS; u32x4 z = {0u, 0u, 0u, 0u};
      for (int i = gt; i < 64 * DM / 8; i += NT) *(u32x4*)(WinT + (size_t)4800 * DM + (size_t)i * 8) = z; }
    bf16_t* xb = (bf16_t*)(ws + WS_XB); float* rstd0 = (float*)(ws + WS_RSTD0);
#pragma unroll 2
    for (int m = gw; m < T_; m += NGW) {
        const f32x4* xr = (const f32x4*)(P.in[I_X] + (size_t)m * DM) + lane;
        f32x4 v[4]; float s = 0.f;
#pragma unroll
        for (int j = 0; j < 4; ++j) { v[j] = xr[64 * j]; s += (v[j][0] * v[j][0] + v[j][1] * v[j][1]) + (v[j][2] * v[j][2] + v[j][3] * v[j][3]); }
        s = wave_sum(s);
        if (lane == 0) rstd0[m] = 1.0f / sqrtf(s * (1.0f / DM) + NORM_EPS);
        u32x2* o8 = (u32x2*)(xb + (size_t)m * DM) + lane;
#pragma unroll
        for (int j = 0; j < 4; ++j) { u32x2 w; w.x = pk2(v[j][0], v[j][1]); w.y = pk2(v[j][2], v[j][3]); o8[64 * j] = w; }
    }
}
__device__ __forceinline__ void prep_rest(const Params& P, const Ctx& C, int widx, int nw) {
    LAS float* scr = (LAS float*)(C.lds + C.wave * 16384);
    unsigned char* ws = C.ws;
    const int gw = widx * NWAVES + C.wave, NGW = nw * NWAVES, lane = C.lane;
    int total = 0;
#pragma unroll
    for (int j = NESS; j < NJOBS; ++j) total += (JOBS[j].K / 64) * (JOBS[j].ncols / 64);
    for (int it = gw; it < total; it += NGW) {
        int r = it, jj = NESS;
        for (int j = NESS; j < NJOBS; ++j) { const int n = (JOBS[j].K / 64) * (JOBS[j].ncols / 64); if (r >= n) { r -= n; jj = j + 1; } else break; }
        const JobDesc d = JOBS[jj];
        TrJob j{P.in[d.in_idx], d.ldw, d.K, d.ncols, d.src0, (bf16_t*)(ws + d.wt_off), d.dst0, d.gain_idx >= 0 ? P.in[d.gain_idx] : nullptr, d.perm != 0, d.f8k};
        trjob_run<2>(j, r, scr, lane);
    }
    { const int gt = widx * NTHREADS + C.tid, NT = nw * NTHREADS;
      bf16_t* sw = (bf16_t*)(ws + WS_SGUW); const float* w = P.in[I_SGUW];
      for (int i = gt; i < 8 * 128 * 128; i += NT) { const int r = (i >> 7) & 127, c = i & 127; sw[i] = (bf16_t)f2bf(c <= r ? w[i] : 0.f); }
      bf16_t* wrh = (bf16_t*)(ws + WS_WRH); bf16_t* wrl = (bf16_t*)(ws + WS_WRL); const float* wrr = P.in[I_WR]; const float* gff = P.in[I_GFFN];
      for (int i = gt; i < NEXP * DM; i += NT) { const int e = i & 63, k = i >> 6; const float wv = wrr[i] * gff[k]; const unsigned h = f2bf(wv); wrh[e * DM + k] = (bf16_t)h; wrl[e * DM + k] = (bf16_t)f2bf(wv - bf2f(h)); }
      float* cs = (float*)(ws + WS_COS); float* sn = (float*)(ws + WS_SIN); const int* pos = (const int*)P.in[I_POS];
      for (int i = gt; i < T_ * 32; i += NT) { const int m = i >> 5, l = i & 31; const float inv_freq = exp2f((float)l * (-13.287712379549449f / 32.0f)); const float ang = (float)pos[m] * inv_freq;
          float sv, cv; sincosf(ang, &sv, &cv); cs[i] = cv; sn[i] = sv; }
    }
}
__device__ __forceinline__ void prep_pb(const Params& P, const Ctx& C) {
    const int gt = C.vcu * NTHREADS + C.tid, NT = C.G * NTHREADS;
    bf16_t* pb = (bf16_t*)(C.ws + WS_PB); const float* p = P.in[I_P];
    for (int i = gt; i < T_ * PLE / 8; i += NT) { const f32x4 a = *(const f32x4*)(p + (size_t)i * 8), b = *(const f32x4*)(p + (size_t)i * 8 + 4); store8bf(pb + (size_t)i * 8, a, b); }
}
__device__ __forceinline__ void phase_prep_wgu(const Params& P, const Ctx& C) {
    LAS float* scr = (LAS float*)(C.lds + C.wave * 16384);
    const int gw = C.vcu * NWAVES + C.wave, NGW = C.G * NWAVES;
    constexpr int ITEMS = (DM / 64) * (128 / 64);
    const int total = NEXP * 4 * ITEMS;
    for (int it = gw; it < total; it += NGW) {
        const int e = it / (4 * ITEMS), r = it % (4 * ITEMS), q = r / ITEMS, item = r % ITEMS;
        const float* W = ((q & 1) ? P.in[I_WEU] : P.in[I_WEG]) + (size_t)e * DM * EFF;
        TrJob j{W, EFF, DM, 128, (q >> 1) * 128, (bf16_t*)(C.ws + WS_WGU + (size_t)e * 512 * DM), q * 128, P.in[I_GFFN], false, F8K_WGU};
        trjob_run<1>(j, item, scr, C.lane);
    }
    constexpr int ED_ITEMS = (EFF / 64) * (DM / 64);
    for (int it = gw; it < NEXP * ED_ITEMS; it += NGW) { const int e = it / ED_ITEMS, item = it % ED_ITEMS;
        TrJob j{P.in[I_WED] + (size_t)e * EFF * DM, DM, EFF, DM, 0, (bf16_t*)(C.ws + WS_WD + (size_t)e * DM * EFF), 0, nullptr, false, F8K_WD}; trjob_run<1>(j, item, scr, C.lane); }
}

__device__ __forceinline__ void kpe_rows(const Params& P, const Ctx& C) {
    unsigned char* ws = C.ws; const int gw = C.vcu * NWAVES + C.wave, NGW = C.G * NWAVES, lane = C.lane;
    const bf16_t* lat = (const bf16_t*)(ws + WS_LAT); bf16_t* kpe = (bf16_t*)(ws + WS_KPE);
    const float* cs = (const float*)(ws + WS_COS); const float* sn = (const float*)(ws + WS_SIN);
    const float gkr = P.in[I_GKR][lane];
    const int e = lane & 31, pos = 8 * (e >> 2) + (lane >> 5) * 4 + (e & 3);
    for (int m = gw; m < T_; m += NGW) {
        const float kr = bf2f(lat[(size_t)m * LATW + 640 + lane]);
        const float s3 = wave_sum(kr * kr); const float kn = kr * (1.0f / sqrtf(s3 * (1.0f / ROPE) + NORM_EPS)) * gkr;
        const float other = __shfl_xor(kn, 32);
        const float c = cs[m * 32 + e], sv = sn[m * 32 + e];
        const float ro = lane < 32 ? kn * c - other * sv : kn * c + other * sv;
        kpe[(size_t)m * ROPE + pos] = (bf16_t)f2bf(ro);
    }
}
__device__ __forceinline__ void phase_sgu(const Params& P, const Ctx& C) {
    unsigned char* ws = C.ws; const int tid = C.tid, lane = C.lane, wid = C.wave;
    const bf16_t* gs = (const bf16_t*)(ws + WS_GU); const bf16_t* gv = (const bf16_t*)(ws + WS_GV);
    bf16_t* yag = (bf16_t*)(ws + WS_YAG); const bf16_t* sw = (const bf16_t*)(ws + WS_SGUW);
    const float* gvstat = (const float*)(ws + WS_GVSTAT);
    const float* lng = P.in[I_LNG]; const float* lnb = P.in[I_LNB]; const float* sgub = P.in[I_SGUB];
    constexpr int VTS = 136;
    LAS bf16_t* VT = (LAS bf16_t*)C.lds;
    LAS float* murs = (LAS float*)(C.lds + 128 * VTS * 2);
    constexpr int OTS = 132;
    LAS float* OT = (LAS float*)(C.lds + 128 * VTS * 2 + 1024);
    const int wi = wid >> 1, wcn = wid & 1, r32 = lane & 31, hi = lane >> 5;
    for (int unit = C.vcu; unit < NB * 16 * 8; unit += C.G) {
        const int g = unit & 7, n = (unit >> 3) & 15, b = unit >> 7;
        const size_t t0 = (size_t)b * SEQ + n * 128;
        if (tid < 128) { const f32x4* st = (const f32x4*)(gvstat + (t0 + tid) * 32); float sm = 0.f, sq = 0.f;
#pragma unroll
            for (int k = 0; k < 8; ++k) { const f32x4 v = st[k]; sm += v[0] + v[2]; sq += v[1] + v[3]; }
            const float mu = sm * (1.0f / DM); const float var = fmaxf(sq * (1.0f / DM) - mu * mu, 0.f);
            murs[2 * tid] = mu; murs[2 * tid + 1] = 1.0f / sqrtf(var + LN_EPS); }
        __syncthreads();
#pragma unroll
        for (int q = 0; q < 4; ++q) { const int chunk = tid + 512 * q, j = chunk >> 4, c0 = (chunk & 15) * 8;
            const u32x4 w = *(const u32x4*)(gv + (t0 + j) * DM + g * 128 + c0); const float mu = murs[2 * j], rs = murs[2 * j + 1];
            const f32x4 ga = *(const f32x4*)(lng + g * 128 + c0), gb = *(const f32x4*)(lng + g * 128 + c0 + 4), ba = *(const f32x4*)(lnb + g * 128 + c0), bb = *(const f32x4*)(lnb + g * 128 + c0 + 4);
            float f[8] = {bflo(w.x), bfhi(w.x), bflo(w.y), bfhi(w.y), bflo(w.z), bfhi(w.z), bflo(w.w), bfhi(w.w)};
#pragma unroll
            for (int e = 0; e < 8; ++e) { const float gg = e < 4 ? ga[e] : gb[e - 4], bv = e < 4 ? ba[e] : bb[e - 4]; VT[(c0 + e) * VTS + (j ^ c0)] = (bf16_t)f2bf((f[e] - mu) * rs * gg + bv); } }
        __syncthreads();
        f32x16 acc0 = {}, acc1 = {};
        const bf16_t* wrow = sw + (size_t)g * 128 * 128 + (size_t)(wi * 32 + r32) * 128 + hi * 8;
        const int c0r = wcn * 64 + r32, c1r = c0r + 32; const LAS bf16_t* v0p = VT + c0r * VTS; const LAS bf16_t* v1p = VT + c1r * VTS; const int k0s = c0r & 120, k1s = c1r & 120;
        for (int ks = 0; ks < 2 * wi + 2; ++ks) {
            const bf16x8 a = *(const bf16x8*)(wrow + ks * 16);
            const bf16x8 b0 = *(const LAS bf16x8*)(v0p + ((ks * 16 + hi * 8) ^ k0s)), b1 = *(const LAS bf16x8*)(v1p + ((ks * 16 + hi * 8) ^ k1s));
            acc0 = __builtin_amdgcn_mfma_f32_32x32x16_bf16(a, b0, acc0, 0, 0, 0);
            acc1 = __builtin_amdgcn_mfma_f32_32x32x16_bf16(a, b1, acc1, 0, 0, 0);
        }
#pragma unroll
        for (int r = 0; r < 16; ++r) { const int i = wi * 32 + (r & 3) + 8 * (r >> 2) + 4 * hi; const float bias = sgub[g * 128 + i];
            OT[i * OTS + wcn * 64 + r32] = acc0[r] + bias; OT[i * OTS + wcn * 64 + 32 + r32] = acc1[r] + bias; }
        __syncthreads();
#pragma unroll
        for (int q = 0; q < 4; ++q) { const int chunk = tid + 512 * q, i = chunk >> 4, c0 = (chunk & 15) * 8;
            const size_t o = (t0 + i) * DM + g * 128 + c0;
            const u32x4 gw4 = *(const u32x4*)(gs + o);
            const f32x4 m0 = *(const LAS f32x4*)(OT + i * OTS + c0), m1 = *(const LAS f32x4*)(OT + i * OTS + c0 + 4);
            f32x4 r0, r1;
            r0[0] = bflo(gw4.x) * m0[0]; r0[1] = bfhi(gw4.x) * m0[1]; r0[2] = bflo(gw4.y) * m0[2]; r0[3] = bfhi(gw4.y) * m0[3];
            r1[0] = bflo(gw4.z) * m1[0]; r1[1] = bfhi(gw4.z) * m1[1]; r1[2] = bflo(gw4.w) * m1[2]; r1[3] = bfhi(gw4.w) * m1[3];
            store8bf(yag + o, r0, r1); }
        __syncthreads();
    }
}

namespace att {
constexpr int QBLK = 32, KVBLK = 64, QB = 256;
constexpr int SHM_V = KVBLK * 128 * 2, SHM_KN = KVBLK * 128 * 2, SHM_KR = KVBLK * 64 * 2;
constexpr int LDS_V = 0, LDS_KN = 2 * SHM_V, LDS_KR = LDS_KN + 2 * SHM_KN, LDS_WS = LDS_KR + 2 * SHM_KR, LDS_BYTES = LDS_WS + NWAVES * 64 * 4;
#define KSWZ(row, colB) ((row) * 256 + ((colB) ^ (((row) & 7) << 4)))
#define KRSWZ(row, chunk) ((row) * 128 + ((((chunk) ^ ((row) >> 1)) & 7) << 4))
#define SBAR() __builtin_amdgcn_sched_barrier(0)
__device__ __forceinline__ int v_st(int k, int c) { const int kk = (k & ~0xC) | ((k & 4) << 1) | ((k & 8) >> 1); return ((kk >> 3) * 4 + (c >> 5)) * 512 + ((kk & 7) * 32 + (c & 31)) * 2; }
__device__ __forceinline__ int v_rd_base(int lane) { return ((lane & 3) << 3) | (((lane >> 2) & 3) << 6) | (((lane >> 4) & 1) << 5) | (((lane >> 5) & 1) << 8); }
constexpr int v_rd_off(int d0, int ks, int half) { return d0 * 512 + ks * 4096 + half * 2048; }
__device__ __forceinline__ int crow(int r, int hi) { return (r & 3) + 8 * (r >> 2) + 4 * hi; }

__device__ __forceinline__ void attn_block(int b, int h, int qb, const bf16_t* Q, const bf16_t* KV, const bf16_t* KPE, const bf16_t* SBG, bf16_t* MRG, LAS char* lds, bool dry) {
    const int tid = threadIdx.x, wid = __builtin_amdgcn_readfirstlane(tid >> 6), lane = tid & 63, r32 = lane & 31, hi = lane >> 5;
    LAS char* V_lds = lds + LDS_V; LAS char* KN_lds = lds + LDS_KN; LAS char* KR_lds = lds + LDS_KR;
    LAS float* wsf = (LAS float*)(lds + LDS_WS) + wid * 64; LAS float* li_l = wsf; LAS float* al_l = wsf + 32;
    const int P0 = qb * QB, NT = (P0 + QB) / KVBLK;
    const unsigned tb = (unsigned)b * SEQ;
    const int qlo = P0 + wid * QBLK;
    bf16x8 qr[12];
    { const bf16_t* qp = Q + (unsigned)((tb + qlo + r32) * QW + h * 192 + hi * 8);
#pragma unroll
      for (int d0 = 0; d0 < 12; ++d0) qr[d0] = *(const bf16x8*)(qp + d0 * 16); }
    bf16x8 st_k0, st_k1, st_v0, st_v1, st_r;
#define SLOAD(k0) do { int t3_ = tid; asm volatile("" : "+v"(t3_)); const unsigned kvo = (tb + (t3_ >> 4)) * KVW + h * 256 + (t3_ & 15) * 8, kro = (tb + (t3_ >> 3)) * ROPE + (t3_ & 7) * 8; \
        const bf16_t* p_ = KV + (unsigned)(kvo + (unsigned)(k0) * KVW); st_k0 = *(const bf16x8*)p_; st_k1 = *(const bf16x8*)(p_ + 32 * KVW); \
        st_v0 = *(const bf16x8*)(p_ + 128); st_v1 = *(const bf16x8*)(p_ + 32 * KVW + 128); st_r = *(const bf16x8*)(KPE + (unsigned)(kro + (unsigned)(k0) * ROPE)); } while (0)
#define SWRITE(bf) do { int t2_ = tid; asm volatile("" : "+v"(t2_)); const int sr_ = t2_ >> 4, sc_ = (t2_ & 15) * 8, rr_ = t2_ >> 3, rc_ = t2_ & 7; \
        const int kws = KSWZ(sr_, sc_ * 2), vst0 = v_st(sr_, sc_), vst1 = v_st(32 + sr_, sc_), krs = KRSWZ(rr_, rc_); \
        *(LAS bf16x8*)(KN_lds + (bf) * SHM_KN + kws) = st_k0; *(LAS bf16x8*)(KN_lds + (bf) * SHM_KN + kws + 32 * 256) = st_k1; \
        *(LAS bf16x8*)(V_lds + (bf) * SHM_V + vst0) = st_v0; *(LAS bf16x8*)(V_lds + (bf) * SHM_V + vst1) = st_v1; *(LAS bf16x8*)(KR_lds + (bf) * SHM_KR + krs) = st_r; } while (0)
    SLOAD(0); SWRITE(0);
    __syncthreads();
    float m_reg = -1e30f, l_reg = 0.f; f32x16 o[4] = {};
    const int vb0 = (int)(unsigned)(uintptr_t)V_lds + v_rd_base(lane);
    constexpr float C2 = 1.4426950408889634f;
    for (int t = 0; t < NT; ++t) {
        const int bf = t & 1, kb = t * KVBLK;
        if (t + 1 < NT) SLOAD(kb + KVBLK);
        if (kb <= qlo + QBLK - 1) {
            f32x16 p0 = {}, p1 = {};
            int l2_ = lane; asm volatile("" : "+v"(l2_)); const int r32 = l2_ & 31, hi = l2_ >> 5;
            { LAS const char* kn = KN_lds + bf * SHM_KN;
              LAS const char* kbp[4];
#pragma unroll
              for (int dd = 0; dd < 4; ++dd) kbp[dd] = kn + KSWZ(r32, (dd * 16 + hi * 8) * 2);
#pragma unroll
              for (int d0 = 0; d0 < 8; ++d0) { LAS const char* a = kbp[d0 & 3] + (d0 >> 2) * 128;
                  const bf16x8 b0 = *(LAS const bf16x8*)a, b1 = *(LAS const bf16x8*)(a + 32 * 256);
                  p0 = __builtin_amdgcn_mfma_f32_32x32x16_bf16(b0, qr[d0], p0, 0, 0, 0);
                  p1 = __builtin_amdgcn_mfma_f32_32x32x16_bf16(b1, qr[d0], p1, 0, 0, 0); }
              LAS const char* kr = KR_lds + bf * SHM_KR;
#pragma unroll
              for (int d0 = 0; d0 < 4; ++d0) { LAS const char* a = kr + KRSWZ(r32, 2 * d0 + hi);
                  const bf16x8 b0 = *(LAS const bf16x8*)a, b1 = *(LAS const bf16x8*)(a + 32 * 128);
                  p0 = __builtin_amdgcn_mfma_f32_32x32x16_bf16(b0, qr[8 + d0], p0, 0, 0, 0);
                  p1 = __builtin_amdgcn_mfma_f32_32x32x16_bf16(b1, qr[8 + d0], p1, 0, 0, 0); } }
            if (kb + KVBLK - 1 > qlo) {
                const int dq = qlo + r32 - 4 * hi - kb; const float NEG = -__builtin_inff();
#pragma unroll
                for (int r = 0; r < 16; ++r) { const int c = (r & 3) + 8 * (r >> 2); if (dq - c < 0) p0[r] = NEG; if (dq - c - 32 < 0) p1[r] = NEG; } }
            float pmax = p0[0];
#pragma unroll
            for (int r = 1; r < 16; ++r) pmax = fmaxf(pmax, p0[r]);
#pragma unroll
            for (int r = 0; r < 16; ++r) pmax = fmaxf(pmax, p1[r]);
            { auto sw = __builtin_amdgcn_permlane32_swap(__float_as_uint(pmax), __float_as_uint(pmax), false, false); pmax = fmaxf(__uint_as_float(sw[0]), __uint_as_float(sw[1])); }
            float alpha = 1.f; const bool grow = __any((pmax - m_reg) * C2 > 6.0f);
            if (grow) { const float mn_ = fmaxf(m_reg, pmax); alpha = __builtin_amdgcn_exp2f((m_reg - mn_) * C2); m_reg = mn_; }
            const float mnL = -m_reg * C2; float ps = 0.f;
#pragma unroll
            for (int r = 0; r < 16; ++r) { p0[r] = __builtin_amdgcn_exp2f(fmaf(p0[r], C2, mnL)); p1[r] = __builtin_amdgcn_exp2f(fmaf(p1[r], C2, mnL)); ps += p0[r] + p1[r]; }
            { auto sw = __builtin_amdgcn_permlane32_swap(__float_as_uint(ps), __float_as_uint(ps), false, false); ps = __uint_as_float(sw[0]) + __uint_as_float(sw[1]); }
            l_reg = l_reg * alpha + ps;
            bf16x8 pa0, pa1, pa2, pa3;
#define PK4(Pv, B_, OUT) do { unsigned a0 = pk2(Pv[B_ + 0], Pv[B_ + 1]), a1 = pk2(Pv[B_ + 2], Pv[B_ + 3]); unsigned b0 = pk2(Pv[B_ + 4], Pv[B_ + 5]), b1 = pk2(Pv[B_ + 6], Pv[B_ + 7]); \
        auto r0 = __builtin_amdgcn_permlane32_swap(a0, b0, false, false); auto r1 = __builtin_amdgcn_permlane32_swap(a1, b1, false, false); \
        u32x4 w = {r0[0], r1[0], r0[1], r1[1]}; OUT = *reinterpret_cast<bf16x8*>(&w); } while (0)
            PK4(p0, 0, pa0); PK4(p0, 8, pa1); PK4(p1, 0, pa2); PK4(p1, 8, pa3);
#undef PK4
            if (grow) { if (hi == 0) al_l[r32] = alpha; asm volatile("s_waitcnt lgkmcnt(0)" ::: "memory");
#pragma unroll
                for (int d_ = 0; d_ < 4; ++d_)
#pragma unroll
                    for (int r = 0; r < 16; ++r) o[d_][r] *= al_l[crow(r, hi)]; }
#define TRRD(dst, off) asm volatile("ds_read_b64_tr_b16 %0, %1 offset:%2" : "=&v"(dst) : "v"(vb0), "i"(off) : "memory")
#define PV_D0(VB, d0) do { s16x4 l0, l1, l2, l3, h0, h1, h2, h3; constexpr int b_ = VB * SHM_V + v_rd_off(d0, 0, 0); \
        TRRD(l0, b_); TRRD(h0, b_ + 2048); TRRD(l1, b_ + 4096); TRRD(h1, b_ + 6144); TRRD(l2, b_ + 8192); TRRD(h2, b_ + 10240); TRRD(l3, b_ + 12288); TRRD(h3, b_ + 14336); \
        asm volatile("s_waitcnt lgkmcnt(0)" ::: "memory"); SBAR(); \
        o[d0] = __builtin_amdgcn_mfma_f32_32x32x16_bf16(pa0, (bf16x8){l0[0], l0[1], l0[2], l0[3], h0[0], h0[1], h0[2], h0[3]}, o[d0], 0, 0, 0); \
        o[d0] = __builtin_amdgcn_mfma_f32_32x32x16_bf16(pa1, (bf16x8){l1[0], l1[1], l1[2], l1[3], h1[0], h1[1], h1[2], h1[3]}, o[d0], 0, 0, 0); \
        o[d0] = __builtin_amdgcn_mfma_f32_32x32x16_bf16(pa2, (bf16x8){l2[0], l2[1], l2[2], l2[3], h2[0], h2[1], h2[2], h2[3]}, o[d0], 0, 0, 0); \
        o[d0] = __builtin_amdgcn_mfma_f32_32x32x16_bf16(pa3, (bf16x8){l3[0], l3[1], l3[2], l3[3], h3[0], h3[1], h3[2], h3[3]}, o[d0], 0, 0, 0); } while (0)
            if (bf == 0) { PV_D0(0, 0); PV_D0(0, 1); PV_D0(0, 2); PV_D0(0, 3); } else { PV_D0(1, 0); PV_D0(1, 1); PV_D0(1, 2); PV_D0(1, 3); }
#undef PV_D0
#undef TRRD
        }
        if (t + 1 < NT) SWRITE(bf ^ 1);
        __syncthreads();
    }
#undef SLOAD
#undef SWRITE
    if (hi == 0) li_l[r32] = l_reg; asm volatile("s_waitcnt lgkmcnt(0)" ::: "memory");
    int hi2 = hi; asm volatile("" : "+v"(hi2));
    LAS bf16_t* OT = (LAS bf16_t*)(lds + wid * 8704);
#pragma unroll
    for (int r = 0; r < 16; ++r) { const int orow = crow(r, hi2); const float rl = __builtin_amdgcn_rcpf(li_l[orow]);
#pragma unroll
        for (int d0 = 0; d0 < 4; ++d0) OT[orow * 136 + d0 * 32 + r32] = (bf16_t)f2bf(o[d0][r] * rl); }
    asm volatile("s_waitcnt lgkmcnt(0)" ::: "memory");
    int l3_ = lane; asm volatile("" : "+v"(l3_));
#pragma unroll
    for (int i = 0; i < 8; ++i) { const int id = l3_ + 64 * i, row = id >> 4, ch = id & 15;
        const u32x4 ov = *(const LAS u32x4*)(OT + row * 136 + ch * 8);
        const unsigned a = (tb + qlo + row) * DM + h * 128 + ch * 8;
        const u32x4 yv = *(const u32x4*)(MRG + a), sv = *(const u32x4*)(SBG + a);
        f32x4 r0, r1;
        r0[0] = bflo(yv.x) + bflo(sv.x) * bflo(ov.x); r0[1] = bfhi(yv.x) + bfhi(sv.x) * bfhi(ov.x); r0[2] = bflo(yv.y) + bflo(sv.y) * bflo(ov.y); r0[3] = bfhi(yv.y) + bfhi(sv.y) * bfhi(ov.y);
        r1[0] = bflo(yv.z) + bflo(sv.z) * bflo(ov.z); r1[1] = bfhi(yv.z) + bfhi(sv.z) * bfhi(ov.z); r1[2] = bflo(yv.w) + bflo(sv.w) * bflo(ov.w); r1[3] = bfhi(yv.w) + bfhi(sv.w) * bfhi(ov.w);
        if (!dry) store8bf(MRG + a, r0, r1); }
    __syncthreads();
}
#undef KSWZ
#undef KRSWZ
#undef SBAR
}

__device__ __forceinline__ void phase_attn(const Params& P, const Ctx& C, bool dry) {
    unsigned char* ws = C.ws;
    const bf16_t* Q = (const bf16_t*)(ws + WS_QRAW); const bf16_t* KV = (const bf16_t*)(ws + WS_KVRAW); const bf16_t* KPE = (const bf16_t*)(ws + WS_KPE);
    const bf16_t* SBG = (const bf16_t*)(ws + WS_SB); bf16_t* MRG = (bf16_t*)(ws + WS_YAG);
    for (int item = C.vcu; item < NB * NH * 4; item += C.G) {
        const int bh = item >> 2, x = item & 3, b = bh >> 3, h = bh & 7;
#pragma unroll 1
        for (int pass = 0; pass < 2; ++pass) att::attn_block(b, h, pass ? 7 - x : x, Q, KV, KPE, SBG, MRG, (LAS char*)C.lds, dry);
    }
}
__device__ __forceinline__ void phase_router(const Params& P, const Ctx& C, bool dry) {
    unsigned char* ws = C.ws; const int lane = C.lane, w = C.wave;
    const bf16_t* x1 = (const bf16_t*)P.out; const bf16_t* wrh = (const bf16_t*)(ws + WS_WRH); const bf16_t* wrl = (const bf16_t*)(ws + WS_WRL);
    float* rstd2 = (float*)(ws + WS_RSTD2); int* tok_e = (int*)(ws + WS_TOKE); float* tok_w = (float*)(ws + WS_TOKW);
    unsigned* cnt = (unsigned*)(ws + WS_CTL) + CW_CNT;
    const float br = P.in[I_BR][lane];
    LAS float* Lp = (LAS float*)C.lds;
    LAS float* Sq = Lp + 2 * 4 * 16 * 64;
    LAS unsigned* lcnt = (LAS unsigned*)(Sq + 128);
    LAS unsigned* lbase = lcnt + 64;
    LAS int* lte = (LAS int*)(lbase + 64);
    const int task = w & 3, kh = w >> 2, r16 = lane & 15, q = lane >> 4;
    for (int base = C.vcu * 4; base < T_ / 16; base += C.G * 4) {
        const int t0 = (base + task) * 16;
        if (C.tid < 64) lcnt[C.tid] = 0u;
        f32x4 acc[4];
#pragma unroll
        for (int nt = 0; nt < 4; ++nt) acc[nt] = (f32x4){0.f, 0.f, 0.f, 0.f};
        float ssq = 0.f;
        const bf16_t* xp = x1 + (size_t)(t0 + r16) * DM + kh * 512 + q * 8;
        unsigned wo = (unsigned)(r16 * DM + kh * 512 + q * 8); asm volatile("" : "+v"(wo));
        u32x4 av[16];
#pragma unroll
        for (int ks = 0; ks < 16; ++ks) av[ks] = *(const u32x4*)(xp + ks * 32);
        asm volatile("" ::: "memory");
#pragma unroll
        for (int ks = 0; ks < 16; ++ks) {
            const u32x4 hw = av[ks];
            { const float f0 = bflo(hw.x), f1 = bfhi(hw.x), f2 = bflo(hw.y), f3 = bfhi(hw.y), f4 = bflo(hw.z), f5 = bfhi(hw.z), f6 = bflo(hw.w), f7 = bfhi(hw.w);
              ssq += (f0 * f0 + f1 * f1) + (f2 * f2 + f3 * f3) + (f4 * f4 + f5 * f5) + (f6 * f6 + f7 * f7); }
            const bf16x8 ah = __builtin_bit_cast(bf16x8, hw);
#pragma unroll
            for (int nt = 0; nt < 4; ++nt) { const bf16x8 bh = *(const bf16x8*)(wrh + wo + nt * 16 * DM + ks * 32), bl = *(const bf16x8*)(wrl + wo + nt * 16 * DM + ks * 32);
                acc[nt] = __builtin_amdgcn_mfma_f32_16x16x32_bf16(ah, bh, acc[nt], 0, 0, 0);
                acc[nt] = __builtin_amdgcn_mfma_f32_16x16x32_bf16(ah, bl, acc[nt], 0, 0, 0); }
            if ((ks & 3) == 3) asm volatile("" ::: "memory");
        }
        ssq += __shfl_xor(ssq, 16); ssq += __shfl_xor(ssq, 32);
        LAS float* lp = Lp + (kh * 4 + task) * 16 * 64;
#pragma unroll
        for (int nt = 0; nt < 4; ++nt)
#pragma unroll
            for (int r = 0; r < 4; ++r) lp[(4 * q + r) * 64 + nt * 16 + r16] = acc[nt][r];
        if (q == 0) Sq[(kh * 4 + task) * 16 + r16] = ssq;
        __syncthreads();
#pragma unroll 1
        for (int tt = 0; tt < 8; ++tt) {
            const int tok = kh * 8 + tt, m = t0 + tok;
            const float s = Sq[task * 16 + tok] + Sq[(4 + task) * 16 + tok]; const float rs = 1.0f / sqrtf(s * (1.0f / DM) + NORM_EPS);
            const float logit = (Lp[(task * 16 + tok) * 64 + lane] + Lp[((4 + task) * 16 + tok) * 64 + lane]) * rs;
            const float score = 1.0f / (1.0f + expf(-logit)); const float sel = score + br;
            float m1 = sel, m2 = -__builtin_inff();
#pragma unroll
            for (int o = 1; o < 8; o <<= 1) { const float p1 = __shfl_xor(m1, o), p2 = __shfl_xor(m2, o); const float hi1 = fmaxf(m1, p1), lo1 = fminf(m1, p1); m2 = fmaxf(lo1, fmaxf(m2, p2)); m1 = hi1; }
            const float gs = m1 + m2;
            int grank = 0; const int mygrp = lane >> 3;
#pragma unroll
            for (int g = 0; g < 8; ++g) { const float og = __builtin_bit_cast(float, __builtin_amdgcn_readlane(__builtin_bit_cast(int, gs), g * 8)); grank += (og > gs || (og == gs && g < mygrp)) ? 1 : 0; }
            const float msel = grank < 4 ? sel : -__builtin_inff();
            int rank = 0;
#pragma unroll
            for (int j = 0; j < 64; ++j) { const float oj = __builtin_bit_cast(float, __builtin_amdgcn_readlane(__builtin_bit_cast(int, msel), j)); rank += (oj > msel || (oj == msel && j < lane)) ? 1 : 0; }
            const bool chosen = rank < 8;
            const float wsum = wave_sum(chosen ? score : 0.f);
            if (lane == 0 && !dry) rstd2[m] = rs;
            unsigned lpos = 0u; if (chosen) lpos = __hip_atomic_fetch_add(lcnt + lane, 1u, __ATOMIC_RELAXED, __HIP_MEMORY_SCOPE_WORKGROUP);
            if (chosen) lte[(task * 16 + tok) * 8 + rank] = lane | ((int)lpos << 8);
            if (chosen && !dry) tok_w[m * 8 + rank] = score / wsum * 2.5f;
        }
        __syncthreads();
        if (C.tid < 64 && !dry) { const unsigned c = lcnt[C.tid]; lbase[C.tid] = c ? __hip_atomic_fetch_add(cnt + 32 * C.tid, c, __ATOMIC_RELAXED, __HIP_MEMORY_SCOPE_AGENT) : 0u; }
        __syncthreads();
        if (!dry) { const int tb0 = base * 16;
            const int v = lte[C.tid]; const int e = v & 255; tok_e[tb0 * 8 + C.tid] = e | ((int)(lbase[e] + (unsigned)(v >> 8)) << 8); }
        __syncthreads();
    }
}
__device__ __forceinline__ void phase_lists(const Params& P, const Ctx& C) {
    unsigned char* ws = C.ws; const int tid = C.tid;
    LAS int* offs = (LAS int*)C.lds;
    LAS int* coff = offs + 80;
    unsigned* ctl = (unsigned*)(ws + WS_CTL); const unsigned* cnt = ctl + CW_CNT;
    u32x4* ent = (u32x4*)(ws + WS_ENT); int* tile_list = (int*)(ws + WS_TILEL); int* inv = (int*)(ws + WS_INV);
    const int* tok_e = (const int*)(ws + WS_TOKE); const float* tok_w = (const float*)(ws + WS_TOKW); const float* rstd2 = (const float*)(ws + WS_RSTD2);
    if (tid < 64) { const int c = (int)__hip_atomic_load(cnt + 32 * tid, __ATOMIC_RELAXED, __HIP_MEMORY_SCOPE_AGENT); const int pc = (c + 255) & ~255;
        int po = pc, co = c;
#pragma unroll
        for (int d = 1; d < 64; d <<= 1) { const int a = __shfl_up(po, d), b = __shfl_up(co, d); if (tid >= d) { po += a; co += b; } }
        offs[tid] = po - pc; coff[tid] = co - c;
        if (C.vcu == 0) { ctl[CW_LSH + tid] = (unsigned)((po - pc) - (co - c)); ctl[CW_LSH + 128 + tid] = (unsigned)(po - pc + c); }
        if (tid == 63) { offs[64] = po; coff[64] = co; offs[65] = po + T_; coff[65] = co + T_;
            if (C.vcu == 0) { ctl[CW_LSH + 64] = (unsigned)(po - co); ctl[CW_LSH + 128 + 64] = (unsigned)(po + T_); } } }
    __syncthreads();
    const int gt = C.vcu * NTHREADS + tid, NT = C.G * NTHREADS;
    for (int i = gt; i < T_ * 8; i += NT) { const int m = i >> 3, k = i & 7, v = tok_e[i], e = v & 255;
        const int pos = v >> 8, idx = offs[e] + pos;
        u32x4 en; en.x = (unsigned)m; en.y = 0u; en.z = __float_as_uint(tok_w[i]); en.w = __float_as_uint(rstd2[m]); ent[idx] = en; inv[m * 9 + k] = coff[e] + pos; }
    for (int m = gt; m < T_; m += NT) { u32x4 en; en.x = (unsigned)m; en.y = 0u; en.z = __float_as_uint(1.0f); en.w = __float_as_uint(rstd2[m]); ent[offs[64] + m] = en; inv[m * 9 + 8] = coff[64] + m; }
    for (int e = C.vcu; e < NEXP; e += C.G) { const int c = (int)__hip_atomic_load(cnt + 32 * e, __ATOMIC_RELAXED, __HIP_MEMORY_SCOPE_AGENT);
        for (int i = offs[e] + c + tid; i < offs[e + 1]; i += NTHREADS) { u32x4 en; en.x = 0u; en.y = 0xffffffffu; en.z = 0u; en.w = 0u; ent[i] = en; } }
    const int ntiles = offs[NLIST] >> 8;
    for (int rt = gt; rt < ntiles; rt += NT) { int li = 0;
        for (int e = 0; e < NLIST; ++e) if (rt * 256 >= offs[e]) li = e;
        tile_list[rt] = li; }
    if (gt == 0) { ctl[CW_FILL + 80] = (unsigned)ntiles; ctl[CW_FILL + 81] = (unsigned)offs[64]; }
    __syncthreads();
}
__device__ __forceinline__ void phase_combine(const Params& P, const Ctx& C) {
    const int gw = C.vcu * NWAVES + C.wave, NGW = C.G * NWAVES, lane = C.lane;
    const unsigned char* ybuf = (const unsigned char*)(C.ws + WS_YBUF); float* out = P.out;
    bf16_t* x2b = (bf16_t*)(C.ws + WS_X2B); float* rstd3 = (float*)(C.ws + WS_RSTD3); const int* inv = (const int*)(C.ws + WS_INV);
#pragma unroll 2
    for (int m = gw; m < T_; m += NGW) {
        const u32x4* xp = (const u32x4*)((const bf16_t*)out + (size_t)m * DM + lane * 16); const u32x4 x0 = xp[0], x1v = xp[1];
        f32x4 a[4];
        a[0] = (f32x4){bflo(x0.x), bfhi(x0.x), bflo(x0.y), bfhi(x0.y)}; a[1] = (f32x4){bflo(x0.z), bfhi(x0.z), bflo(x0.w), bfhi(x0.w)};
        a[2] = (f32x4){bflo(x1v.x), bfhi(x1v.x), bflo(x1v.y), bfhi(x1v.y)}; a[3] = (f32x4){bflo(x1v.z), bfhi(x1v.z), bflo(x1v.w), bfhi(x1v.w)};
#pragma unroll
        for (int j = 0; j < 4; ++j) a[j] = a[j] * (float)(1 << F8K_WD);
        const int iv = inv[m * 9 + (lane < 9 ? lane : 0)];
#pragma unroll
        for (int k = 0; k < 9; ++k) { const unsigned yr = (unsigned)__builtin_amdgcn_readlane(iv, k); const u32x4 w = *(const u32x4*)(ybuf + (size_t)yr * DM + lane * 16);
#pragma unroll
            for (int j = 0; j < 4; ++j) { const f32x2 lo = __builtin_amdgcn_cvt_pk_f32_fp8((int)w[j], false), hi = __builtin_amdgcn_cvt_pk_f32_fp8((int)w[j], true);
                a[j][0] += lo.x; a[j][1] += lo.y; a[j][2] += hi.x; a[j][3] += hi.y; } }
        float s = 0.f;
#pragma unroll
        for (int j = 0; j < 4; ++j) a[j] = a[j] * (1.0f / (float)(1 << F8K_WD));
#pragma unroll
        for (int j = 0; j < 4; ++j) s += (a[j][0] * a[j][0] + a[j][1] * a[j][1]) + (a[j][2] * a[j][2] + a[j][3] * a[j][3]);
        s = wave_sum(s);
        store8bf(x2b + (size_t)m * DM + lane * 16, a[0], a[1]); store8bf(x2b + (size_t)m * DM + lane * 16 + 8, a[2], a[3]);
        if (lane == 0) rstd3[m] = 1.0f / sqrtf(s * (1.0f / DM) + NORM_EPS);
    }
}
#define XB_TMO      128
#define XB_XCNT(j)  (256  + 64 * (j))
#define XB_XSUB(j)  (1280 + 64 * (j))
#define XB_XGEN(j)  (2304 + 64 * (j))
#define XB_TOP      3328
#define XB_TOPGEN   3392
#define XCD_BAR_WORDS 3456
#define XB_SPIN_CAP (1u << 20)
__device__ __forceinline__ unsigned xb_ld(unsigned* p)              { return __hip_atomic_load(p, __ATOMIC_RELAXED, __HIP_MEMORY_SCOPE_AGENT); }
__device__ __forceinline__ unsigned xb_add(unsigned* p, unsigned v) { return __hip_atomic_fetch_add(p, v, __ATOMIC_RELAXED, __HIP_MEMORY_SCOPE_AGENT); }
__device__ __forceinline__ unsigned xb_xcc_id() { return (unsigned)__builtin_amdgcn_s_getreg((3 << 11) | 20) & 0xFu; }
#define XB_SPIN(cond, bar) do { unsigned _sp = 0; while (cond) { __builtin_amdgcn_s_sleep(1); \
    if ((++_sp & 255u) == 0u) { if (xb_ld(&(bar)[XB_TMO])) break; if (_sp > XB_SPIN_CAP) { atomicAdd(&(bar)[XB_TMO], 1u); break; } } } } while (0)
struct XcdBarrier { unsigned* bar; unsigned x; volatile LAS unsigned* st; };
__device__ __forceinline__ XcdBarrier xcd_barrier_post(unsigned* bar, volatile LAS unsigned* st) {
    XcdBarrier b; b.bar = bar; b.x = xb_xcc_id(); b.st = st;
    if (threadIdx.x == 0) (void)xb_add(&bar[XB_XCNT(b.x)], 1u);
    return b;
}
__device__ __forceinline__ void xcd_barrier_complete(unsigned* bar, unsigned x, unsigned& nloc, unsigned& nx) {
    const unsigned G = gridDim.x * gridDim.y * gridDim.z;
    unsigned sum, cnt, mine, sp = 0u;
    for (;;) {
        sum = 0u; cnt = 0u; mine = 0u;
#pragma unroll
        for (unsigned j = 0; j < 16; ++j) { const unsigned c = xb_ld(&bar[XB_XCNT(j)]); sum += c; cnt += (c > 0u) ? 1u : 0u; mine = (j == x) ? c : mine; }
        if (sum == G) break;
        __builtin_amdgcn_s_sleep(1);
        if ((++sp & 255u) == 0u) { if (xb_ld(&bar[XB_TMO])) break; if (sp > XB_SPIN_CAP) { atomicAdd(&bar[XB_TMO], 1u); break; } }
    }
    nloc = mine > 0u ? mine : 1u; nx = cnt > 0u ? cnt : 1u;
}
__device__ __forceinline__ void xcd_barrier(const XcdBarrier& b) {
    asm volatile("s_waitcnt vmcnt(0)" ::: "memory");
    __syncthreads();
    if (threadIdx.x == 0) {
        unsigned* bar = b.bar;
        __builtin_amdgcn_s_waitcnt(0);
        unsigned nloc = b.st[0], nx = b.st[1];
        if (nloc == 0u) { xcd_barrier_complete(bar, b.x, nloc, nx); b.st[0] = nloc; b.st[1] = nx; }
        const unsigned old = xb_add(&bar[XB_XSUB(b.x)], 1u);
        const unsigned gen = old / nloc;
        if (old + 1u == (gen + 1u) * nloc) {
            __builtin_amdgcn_fence(__ATOMIC_RELEASE, "agent");
            asm volatile("s_waitcnt vmcnt(0)" ::: "memory");
            const unsigned og = xb_add(&bar[XB_TOP], 1u);
            const unsigned tg = og / nx;
            if (og + 1u == (tg + 1u) * nx) xb_add(&bar[XB_TOPGEN], 1u);
            else XB_SPIN(xb_ld(&bar[XB_TOPGEN]) == tg, bar);
            __builtin_amdgcn_fence(__ATOMIC_ACQUIRE, "agent");
            xb_add(&bar[XB_XGEN(b.x)], 1u);
            asm volatile("s_waitcnt vmcnt(0)" ::: "memory");
        } else {
            XB_SPIN(xb_ld(&bar[XB_XGEN(b.x)]) == gen, bar);
            __builtin_amdgcn_fence(__ATOMIC_ACQUIRE, "agent");
            asm volatile("s_waitcnt vmcnt(0)" ::: "memory");
        }
    }
    __syncthreads();
}

constexpr int RING_BYTES = 131072, MISC_OFF = RING_BYTES + 320, LDS_BYTES = 147456;
constexpr int N_PHASES = 12;
#ifndef MK_N_LAUNCHES
#define MK_N_LAUNCHES 1
#endif
struct Args { Params P; int ph_lo, ph_hi; };

__global__ void __launch_bounds__(NTHREADS, 2) fwd_kernel(Args args) {
    extern __shared__ __attribute__((aligned(16))) unsigned char lds_raw[];
    Ctx C; C.lds = (LAS unsigned char*)lds_raw; C.ws = args.P.ws; C.tid = threadIdx.x; C.lane = C.tid & 63; C.wave = __builtin_amdgcn_readfirstlane(C.tid >> 6);
    C.G = gridDim.x; C.vcu = vcu_of(blockIdx.x, C.G);
    const Params& P = args.P;
    unsigned char* ws = C.ws;
    volatile LAS unsigned* MISC = (volatile LAS unsigned*)(C.lds + MISC_OFF);
    for (int u = C.tid; u < (LDS_BYTES - RING_BYTES) / 4; u += NTHREADS) ((LAS unsigned*)(C.lds + RING_BYTES))[u] = 0u;
    __syncthreads();
    const int lo = args.ph_lo, hi = args.ph_hi;
    XcdBarrier bar; bar.bar = (unsigned*)(ws + WS_CTL) + CW_BAR; bar.x = 0; bar.st = nullptr;
    if (hi - lo > 1) bar = xcd_barrier_post((unsigned*)(ws + WS_CTL) + CW_BAR, MISC + 8);
#ifdef ONLY_PHASE
#define IN(k) ((k) == ONLY_PHASE && lo <= (k) && (k) < hi)
#else
#define IN(k) (lo <= (k) && (k) < hi)
#endif
#ifdef REPEAT_PHASE
#define NREP(k) ((k) == REPEAT_PHASE ? 2 : 1)
#else
#define NREP(k) 1
#endif
#ifdef CLOCK_PHASE
    unsigned long long ck_c0 = 0, ck_c1 = 0, ck_r0 = 0, ck_r1 = 0;
#define CK_END(k) do { if ((k) == CLOCK_PHASE) { ck_c1 = __builtin_amdgcn_s_memtime(); ck_r1 = __builtin_amdgcn_s_memrealtime(); } } while (0)
#define CK_START(k) do { if ((k) == CLOCK_PHASE) { ck_c0 = __builtin_amdgcn_s_memtime(); ck_r0 = __builtin_amdgcn_s_memrealtime(); } } while (0)
#else
#define CK_END(k) do {} while (0)
#define CK_START(k) do {} while (0)
#endif
#ifdef DILATE_PHASE
    unsigned long long dl_t0 = 0, dl_t1 = 0;
#define DL_MARK(k) do { if ((k) == DILATE_PHASE || (DILATE_PHASE == 99 && (k) == 0)) dl_t0 = __builtin_amdgcn_s_memrealtime(); if ((k) == DILATE_PHASE + 1 || (DILATE_PHASE == 99 && (k) == 12)) dl_t1 = __builtin_amdgcn_s_memrealtime(); } while (0)
#else
#define DL_MARK(k) do {} while (0)
#endif
#define SEAM(k) do { CK_END(k); if (IN(k) && IN((k) + 1)) xcd_barrier(bar); DL_MARK((k) + 1); CK_START((k) + 1); } while (0)
    DL_MARK(0);
    if (IN(0)) { phase_prep0(P, C); } SEAM(0);
    if (IN(1)) {
        DenseSched S{(const char*)(ws + WS_XB), (const char*)(ws + WS_WIN), T_ / 256, NZ / 256, C.G, C.vcu, DM * 2, DM * 2};
        EpiG1 E{ws};
        pg8::gemm_phase<EpiG1, DenseSched, false>(C.lds, pg8::Shape{DM * 2, DM * 2, DM / 64, nullptr}, S, E);
        { const int rem = ((T_ / 256) * (NZ / 256)) % C.G; if (rem == 0) prep_rest(P, C, C.vcu, C.G); else if (C.vcu >= rem) prep_rest(P, C, C.vcu - rem, C.G - rem); }
    } SEAM(1);
    if (IN(2)) { kpe_rows(P, C); phase_sgu(P, C); } SEAM(2);
    if (IN(3)) {
        { DenseSched S{(const char*)(ws + WS_LAT) + 256 * 2, (const char*)(ws + WS_WQB), T_ / 256, QW / 256, C.G, C.vcu, LATW * 2, QLAT * 2};
          EpiQ E{ws, C.lds, P.in[I_GQN], P.in[I_GQR]};
          pg8::gemm_phase<EpiQ, DenseSched, false>(C.lds, pg8::Shape{LATW * 2, QLAT * 2, QLAT / 64, nullptr}, S, E); }
        { DenseSched S{(const char*)(ws + WS_LAT), (const char*)(ws + WS_WKVB), T_ / 256, KVW / 256, C.G, C.vcu, LATW * 2, KVLAT * 2};
          EpiKV E{ws, C.lds, P.in[I_GKN]};
          pg8::gemm_phase<EpiKV, DenseSched, false>(C.lds, pg8::Shape{LATW * 2, KVLAT * 2, KVLAT / 64, nullptr}, S, E); }
    } SEAM(3);
    if (IN(4)) { phase_attn(P, C, false); } SEAM(4);
    if (IN(5)) {
        DenseSched S{(const char*)(ws + WS_YAG), (const char*)(ws + WS_WO), T_ / 256, DM / 256, C.G, C.vcu, DM * 2, DM * 2};
        EpiG4 E{P.in[I_X], (bf16_t*)P.out, ws + WS_X1F8};
        pg8::gemm_phase<EpiG4, DenseSched, false>(C.lds, pg8::Shape{DM * 2, DM * 2, DM / 64, nullptr}, S, E);
    } SEAM(5);
    if (IN(6)) {
        if (C.vcu & 1) { phase_prep_wgu(P, C); __syncthreads(); phase_router(P, C, false); }
        else { phase_router(P, C, false); __syncthreads(); phase_prep_wgu(P, C); }
    } SEAM(6);
    if (IN(7)) { phase_lists(P, C); } SEAM(7);
    const unsigned* ctl = (const unsigned*)(ws + WS_CTL);
    if (IN(8)) {
        const int ntiles = (int)__hip_atomic_load(ctl + CW_FILL + 80, __ATOMIC_RELAXED, __HIP_MEMORY_SCOPE_AGENT), off64 = (int)__hip_atomic_load(ctl + CW_FILL + 81, __ATOMIC_RELAXED, __HIP_MEMORY_SCOPE_AGENT);
        LAS int* tl = (LAS int*)(C.lds + PART_OFF); for (int i = C.tid; i < ntiles; i += NTHREADS) tl[i] = ((const int*)(ws + WS_TILEL))[i]; __syncthreads();
        MoeGuSched S{ws, tl, ntiles, C.G, C.vcu};
        EpiGu E{ws, off64};
        pg8::gemm_phase<EpiGu, MoeGuSched, true, true>(C.lds, pg8::Shape{DM, DM, DM / 128, (const char*)(ws + WS_X1F8)}, S, E);
    } SEAM(8);
    if (IN(9)) {
        const int ntiles = (int)__hip_atomic_load(ctl + CW_FILL + 80, __ATOMIC_RELAXED, __HIP_MEMORY_SCOPE_AGENT), off64 = (int)__hip_atomic_load(ctl + CW_FILL + 81, __ATOMIC_RELAXED, __HIP_MEMORY_SCOPE_AGENT);
        LAS int* tl = (LAS int*)(C.lds + PART_OFF); for (int i = C.tid; i < ntiles; i += NTHREADS) tl[i] = ((const int*)(ws + WS_TILEL))[i]; __syncthreads();
        LAS int* lsh = tl + 1024; if (C.tid < 65) { lsh[C.tid] = (int)ctl[CW_LSH + C.tid]; lsh[128 + C.tid] = (int)ctl[CW_LSH + 128 + C.tid]; } __syncthreads();
        MoeDownSched S{ws, tl, ntiles, C.G, C.vcu, off64};
        EpiDown E{ws, lsh};
        pg8::gemm_phase<EpiDown, MoeDownSched, false, true>(C.lds, pg8::Shape{EFF, EFF, EFF / 128, nullptr}, S, E);
        prep_pb(P, C);
    } SEAM(9);
    if (IN(10)) {
        phase_combine(P, C);
        DenseSched S{(const char*)(ws + WS_PB), (const char*)(ws + WS_WPP), T_ / 256, DM / 256, C.G, C.vcu, PLE * 2, PLE * 2};
        EpiG6 E{(bf16_t*)(ws + WS_PERAW), (float*)(ws + WS_PESTAT)};
        pg8::gemm_phase<EpiG6, DenseSched, false>(C.lds, pg8::Shape{PLE * 2, PLE * 2, PLE / 64, nullptr}, S, E);
    } SEAM(10);
    if (IN(11)) {
        DenseSched S{(const char*)(ws + WS_X2B), (const char*)(ws + WS_WPG), T_ / 256, DM / 256, C.G, C.vcu, DM * 2, DM * 2};
        EpiG5 E{P.out, (const bf16_t*)(ws + WS_PERAW), (const bf16_t*)(ws + WS_X2B), (const float*)(ws + WS_RSTD3), (const float*)(ws + WS_PESTAT), P.in[I_GPO]};
        pg8::gemm_phase<EpiG5, DenseSched, false>(C.lds, pg8::Shape{DM * 2, DM * 2, DM / 64, nullptr}, S, E);
    }
#ifdef CLOCK_PHASE
    CK_END(11);
    { const unsigned long long mhz = (ck_c1 - ck_c0) * 100ull / (ck_r1 - ck_r0 + 1ull); const unsigned long long d = mhz * 10ull, s0 = __builtin_amdgcn_s_memrealtime(); while (__builtin_amdgcn_s_memrealtime() - s0 < d) __builtin_amdgcn_s_sleep(8); }
#endif
#ifdef EXTRA_BARRIERS
    for (int eb = 0; eb < EXTRA_BARRIERS; ++eb) xcd_barrier(bar);
#endif
#ifdef SPIN_US
    { const unsigned long long s0 = __builtin_amdgcn_s_memrealtime(); while (__builtin_amdgcn_s_memrealtime() - s0 < (unsigned long long)(SPIN_US) * 100ull) __builtin_amdgcn_s_sleep(8); }
#endif
#ifdef DILATE_PHASE
    DL_MARK(12);
    { const unsigned long long d = dl_t1 - dl_t0, s0 = __builtin_amdgcn_s_memrealtime(); while (__builtin_amdgcn_s_memrealtime() - s0 < d) __builtin_amdgcn_s_sleep(8); }
#endif
#undef IN
#undef SEAM
}

extern "C" void kernel_launch(void* const* d_in, const int* in_sizes, int n_in, void* d_out, int out_size, void* d_ws, size_t ws_size, hipStream_t stream) {
    static int grid = 0;
    if (grid == 0) {
        if (n_in != 31 || in_sizes[0] != T_ * DM || out_size != T_ * DM || ws_size < WS_END) { fprintf(stderr, "kernel_launch: unexpected shapes (n_in %d, in0 %d, out %d, ws %zu, need %zu)\n", n_in, n_in > 0 ? in_sizes[0] : -1, out_size, ws_size, (size_t)WS_END); grid = -1; return; }
        int dev = 0, cus = 0;
        if (hipGetDevice(&dev) != hipSuccess || hipDeviceGetAttribute(&cus, hipDeviceAttributeMultiprocessorCount, dev) != hipSuccess) { grid = -1; return; }
        if (hipFuncSetAttribute((const void*)fwd_kernel, hipFuncAttributeMaxDynamicSharedMemorySize, LDS_BYTES) != hipSuccess) { fprintf(stderr, "kernel_launch: hipFuncSetAttribute failed\n"); grid = -1; return; }
        grid = cus;
    }
    if (grid < 0) return;
    (void)hipMemsetAsync((char*)d_ws + WS_CTL, 0, CTL_BYTES, stream);
    Args a{};
    for (int i = 0; i < 31; ++i) a.P.in[i] = (const float*)d_in[i];
    a.P.out = (float*)d_out; a.P.ws = (unsigned char*)d_ws;
    constexpr int NL = MK_N_LAUNCHES;
    for (int li = 0; li < NL; ++li) {
        a.ph_lo = (NL == N_PHASES) ? li : (li * N_PHASES) / NL; a.ph_hi = (NL == N_PHASES) ? li + 1 : ((li + 1) * N_PHASES) / NL;
        hipLaunchKernelGGL(fwd_kernel, dim3(grid), dim3(NTHREADS), LDS_BYTES, stream, a);
    }
}
```

```cpp
#include <hip/hip_runtime.h>
#include <hip/hip_bf16.h>
#include <cstdio>
#include <cstdint>

#define LAS __attribute__((address_space(3)))
#define GAS __attribute__((address_space(1)))
typedef unsigned short bf16_t;
typedef short bf16x8 __attribute__((ext_vector_type(8)));
typedef short s16x4 __attribute__((ext_vector_type(4)));
typedef float f32x4 __attribute__((ext_vector_type(4)));
typedef float f32x2 __attribute__((ext_vector_type(2)));
typedef float f32x16 __attribute__((ext_vector_type(16)));
typedef unsigned u32x4 __attribute__((ext_vector_type(4)));
typedef unsigned u32x2 __attribute__((ext_vector_type(2)));

constexpr int T_ = 16384, DM = 1024, NB = 8, SEQ = 2048, NH = 8;
constexpr int NZ = 4864;
constexpr int QLAT = 384, KVLAT = 256, ROPE = 64, LATW = 768;
constexpr int QW = 1536, KVW = 2048;
constexpr int NEXP = 64, EFF = 256, NLIST = 65;
constexpr int PLE = 256;
constexpr float NORM_EPS = 1e-6f, LN_EPS = 1e-5f;
constexpr int NTHREADS = 512, NWAVES = 8;

constexpr size_t MiB = 1u << 20, KiB = 1u << 10;
constexpr size_t WS_CTL = 0, CTL_BYTES = 64 * KiB;
constexpr size_t WS_RSTD0 = 1 * MiB, WS_LNMU = WS_RSTD0 + 64 * KiB, WS_LNRS = WS_LNMU + 64 * KiB, WS_RSTD2 = WS_LNRS + 64 * KiB,
                 WS_RSTD3 = WS_RSTD2 + 64 * KiB, WS_RSTDPE = WS_RSTD3 + 64 * KiB;
constexpr size_t WS_PESTAT = 1 * MiB + 512 * KiB;
constexpr size_t WS_COS = 2 * MiB + 512 * KiB, WS_SIN = 4 * MiB + 512 * KiB;
static_assert(WS_RSTDPE + 64 * KiB <= WS_PESTAT && WS_PESTAT + (size_t)T_ * 64 <= WS_COS && WS_SIN + 2 * MiB <= 6 * MiB + 512 * KiB, "small map");
constexpr size_t WS_WIN = 6 * MiB + 512 * KiB;
constexpr size_t WS_WQB = WS_WIN + (size_t)NZ * DM * 2;
constexpr size_t WS_WKVB = WS_WQB + (size_t)QW * QLAT * 2;
constexpr size_t WS_WO = WS_WKVB + (size_t)KVW * KVLAT * 2;
constexpr size_t WS_SGUW = WS_WO + (size_t)DM * DM * 2;
constexpr size_t WS_WSHGU = WS_SGUW + (size_t)8 * 128 * 128 * 2;
constexpr size_t WS_WSHD = WS_WSHGU + (size_t)512 * DM * 2;
constexpr size_t WS_WPG = WS_WSHD + (size_t)DM * EFF * 2;
constexpr size_t WS_WPP = WS_WPG + (size_t)DM * DM * 2;
constexpr size_t WS_WSMALL_END = WS_WPP + (size_t)DM * PLE * 2;
static_assert(WS_WSMALL_END <= 25 * MiB, "small weights");
constexpr size_t WS_WRH = 25 * MiB, WS_WRL = 25 * MiB + 128 * KiB;
constexpr size_t WS_TOKE = 26 * MiB, WS_TOKW = WS_TOKE + 512 * KiB;
constexpr int LIST_CAP = 164096;
constexpr size_t WS_ENT = 27 * MiB, WS_INV = 30 * MiB, WS_TILEL = 31 * MiB;
constexpr size_t S0 = 32 * MiB, S1 = 64 * MiB, S2 = 96 * MiB, S3 = 128 * MiB, S4 = 160 * MiB, S5 = 192 * MiB, S6 = 224 * MiB, S7 = 256 * MiB;
constexpr size_t WS_XB = S0, WS_YAG = S1, WS_HSH = S0;
constexpr size_t WS_GU = S1, WS_GV = S2, WS_SA = S3, WS_LAT = S5, WS_SB = S7;
constexpr size_t WS_GVSTAT = S6, WS_LATSTAT = S6 + 2 * MiB, WS_KPE = S6 + 20 * MiB;
constexpr size_t WS_KVRAW = S3;
__device__ __forceinline__ size_t q_off(int b) { return b < 5 ? S0 + (size_t)b * 6 * MiB : (b < 7 ? 288 * MiB + (size_t)(b - 5) * 6 * MiB : 216 * MiB); }
constexpr size_t WS_X2Q = S5 + 16 * MiB;
constexpr size_t WS_MQ = S5;
constexpr size_t WS_X1F8 = S1;
constexpr size_t WS_WGU = S3;
constexpr size_t WS_WD = S5;
constexpr size_t WS_ACT = S6;
constexpr size_t WS_YBUF = 47 * MiB;
constexpr size_t WS_X2B = S6, WS_PERAW = S7;
constexpr size_t WS_PB = 296 * MiB;
constexpr size_t WS_END = 304 * MiB;
static_assert((size_t)SEQ * QW * 2 == 6 * MiB && S0 + 5 * 6 * MiB <= S1 && 288 * MiB + 2 * 6 * MiB <= WS_END && S5 + (size_t)T_ * LATW * 2 <= 216 * MiB && 216 * MiB + 6 * MiB <= S6, "q map");
static_assert(WS_KVRAW + (size_t)T_ * KVW * 2 <= S5 && WS_YBUF + (size_t)(T_ * 9) * 1024 <= S5 && WS_HSH + (size_t)T_ * EFF * 2 <= WS_YBUF && WS_ACT + (size_t)147456 * 512 <= WS_PB, "map");
constexpr int CW_CNT = 8192;
constexpr int CW_FILL = 192;
constexpr int CW_LSH = 512;
constexpr int CW_BAR = 4096;

__device__ __forceinline__ unsigned f2bf(float f) { unsigned u = __builtin_bit_cast(unsigned, f); return (u + 0x7fffu + ((u >> 16) & 1u)) >> 16; }
__device__ __forceinline__ float bf2f(unsigned h) { return __builtin_bit_cast(float, h << 16); }
__device__ __forceinline__ unsigned pk2(float lo, float hi) { unsigned r; asm volatile("v_cvt_pk_bf16_f32 %0, %1, %2" : "=v"(r) : "v"(lo), "v"(hi)); return r; }
__device__ __forceinline__ bf16_t f2bf1(float f) { return (bf16_t)pk2(f, f); }
__device__ __forceinline__ float bflo(unsigned w) { return __builtin_bit_cast(float, w << 16); }
__device__ __forceinline__ float bfhi(unsigned w) { return __builtin_bit_cast(float, w & 0xffff0000u); }
template <int CTRL> __device__ __forceinline__ float dppf(float v) { return __builtin_bit_cast(float, __builtin_amdgcn_update_dpp(0, __builtin_bit_cast(int, v), CTRL, 0xf, 0xf, true)); }
__device__ __forceinline__ float wave_sum_dpp(float v) {
    v += dppf<0xB1>(v); v += dppf<0x4E>(v); v += dppf<0x141>(v); v += dppf<0x140>(v);
    const int iv = __builtin_bit_cast(int, v);
    return (__builtin_bit_cast(float, __builtin_amdgcn_readlane(iv, 0)) + __builtin_bit_cast(float, __builtin_amdgcn_readlane(iv, 16))) +
           (__builtin_bit_cast(float, __builtin_amdgcn_readlane(iv, 32)) + __builtin_bit_cast(float, __builtin_amdgcn_readlane(iv, 48)));
}
__device__ __forceinline__ float wave_sum(float v) { return wave_sum_dpp(v); }
__device__ __forceinline__ float rows4_sum(float s) {
    const auto a = __builtin_amdgcn_permlane32_swap(__float_as_uint(s), __float_as_uint(s), false, false); s = __uint_as_float(a[0]) + __uint_as_float(a[1]);
    const auto b = __builtin_amdgcn_permlane16_swap(__float_as_uint(s), __float_as_uint(s), false, false); return __uint_as_float(b[0]) + __uint_as_float(b[1]);
}
__device__ __forceinline__ float fast_sigmoid(float x) { return __builtin_amdgcn_rcpf(1.0f + __builtin_amdgcn_exp2f(-1.4426950408889634f * x)); }
__device__ __forceinline__ float gelu_tanh(float x) {
    return x * __builtin_amdgcn_rcpf(1.0f + __builtin_amdgcn_exp2f(x * fmaf(x * x, -0.10294324f, -2.3022082f)));
}
__device__ __forceinline__ float silu(float x) { return x * fast_sigmoid(x); }
__device__ __forceinline__ float sigmoid_l2(float t) { return __builtin_amdgcn_rcpf(1.0f + __builtin_amdgcn_exp2f(t)); }
__device__ __forceinline__ float gelu_sig(float x, float g2) {
    const float arg = fminf(x * fmaf(x * x, -0.10294324f, -2.3022082f), 126.0f);
    const float t = 1.0f + __builtin_amdgcn_exp2f(arg), eb = __builtin_amdgcn_exp2f(g2);
    return x * __builtin_amdgcn_rcpf(fmaf(t, eb, t));
}
constexpr int F8K_WGU = 9, F8K_WD = 4, F8K_WO = 9, F8K_WPG = 9;
__device__ __forceinline__ float clamp8(float v) { return __builtin_amdgcn_fmed3f(v, -448.0f, 448.0f); }
__device__ __forceinline__ unsigned pk4f8(float a, float b, float c, float d) {
    int w = __builtin_amdgcn_cvt_pk_fp8_f32(clamp8(a), clamp8(b), 0, false); w = __builtin_amdgcn_cvt_pk_fp8_f32(clamp8(c), clamp8(d), w, true); return (unsigned)w; }
__device__ __forceinline__ void store8f8(unsigned char* p, f32x4 a, f32x4 b) { u32x2 w; w.x = pk4f8(a[0], a[1], a[2], a[3]); w.y = pk4f8(b[0], b[1], b[2], b[3]); *(u32x2*)p = w; }

struct Params {
    const float* in[31];
    float* out;
    unsigned char* ws;
};
enum { I_X = 0, I_P, I_POS, I_GMIX, I_WIN, I_LNG, I_LNB, I_SGUW, I_SGUB, I_GQA, I_WQB, I_GKVA, I_WKVB, I_GQN, I_GKN, I_GQR, I_GKR, I_WO, I_GFFN, I_WR, I_BR,
       I_WEG, I_WEU, I_WED, I_WSG, I_WSU, I_WSD, I_GPI, I_WPG, I_WPP, I_GPO };
namespace pg8 {
constexpr int BM = 256, BK = 64, HALF = 128, HTB = HALF * BK * 2  , STAGE_BYTES = 8 * HTB;

__device__ __forceinline__ int lds_byte(int r, int c) { const int st = (r >> 4) * 2 + (c >> 5), rr = r & 15, cc = c & 31, ob = rr * 64 + cc * 2; return st * 1024 + (ob ^ (((ob >> 9) & 1) << 5)); }
__device__ __forceinline__ void stage_rc(int b, int& R, int& C) { const int st = b / 1024, sb = b % 1024, swz = sb ^ (((sb >> 9) & 1) << 5); R = (st >> 1) * 16 + swz / 64; C = (st & 1) * 32 + (swz % 64) / 2; }
__device__ __forceinline__ int perm32(int rho) { const int n = rho >> 4, i = rho & 15; return 8 * (i >> 2) + 4 * n + (i & 3); }
__device__ __forceinline__ int perm64(int rho) { return (rho >> 5) * 64 + 16 * ((rho & 15) >> 2) + 4 * ((rho >> 4) & 1) + (rho & 3); }

struct Unit { const char* A; const char* B; int pm, pn; };
struct Shape { int ldaB, ldbB, nt; const char* Abase; };

typedef int i32x4 __attribute__((ext_vector_type(4)));
typedef int i32x8 __attribute__((ext_vector_type(8)));
__device__ __forceinline__ void mma_f8(f32x4& c, const bf16x8 b0, const bf16x8 b1, const bf16x8 a0, const bf16x8 a1) {
    const i32x4 p0 = __builtin_bit_cast(i32x4, b0), p1 = __builtin_bit_cast(i32x4, b1), q0 = __builtin_bit_cast(i32x4, a0), q1 = __builtin_bit_cast(i32x4, a1);
    const i32x8 bb = __builtin_shufflevector(p0, p1, 0, 1, 2, 3, 4, 5, 6, 7), aa = __builtin_shufflevector(q0, q1, 0, 1, 2, 3, 4, 5, 6, 7);
    asm volatile("v_mfma_f32_16x16x128_f8f6f4 %0, %1, %2, %0" : "+v"(c) : "v"(bb), "v"(aa));
}
__device__ __forceinline__ void mma_f8_z(f32x4& c, const bf16x8 b0, const bf16x8 b1, const bf16x8 a0, const bf16x8 a1) {
    const i32x4 p0 = __builtin_bit_cast(i32x4, b0), p1 = __builtin_bit_cast(i32x4, b1), q0 = __builtin_bit_cast(i32x4, a0), q1 = __builtin_bit_cast(i32x4, a1);
    const i32x8 bb = __builtin_shufflevector(p0, p1, 0, 1, 2, 3, 4, 5, 6, 7), aa = __builtin_shufflevector(q0, q1, 0, 1, 2, 3, 4, 5, 6, 7);
    asm volatile("v_mfma_f32_16x16x128_f8f6f4 %0, %1, %2, 0" : "=v"(c) : "v"(bb), "v"(aa));
}
template <class Epi, class Sched, bool GATHER, bool F8 = false, bool NT2 = false>
__device__ __forceinline__ void gemm_phase(LAS unsigned char* lds, const Shape sh, const Sched& S, const Epi& E) {
    const int tid = threadIdx.x, wid = __builtin_amdgcn_readfirstlane(tid >> 6), lane = tid & 63, wr = wid >> 2, wc = wid & 3, fr = lane & 15, fq = lane >> 4;
    const int nt = sh.nt;
    int Rr[2], Cc[2];
    unsigned voffB[2], voffA[2];
#pragma unroll
    for (int i = 0; i < 2; ++i) { stage_rc(tid * 16 + i * 8192, Rr[i], Cc[i]); const int Rb = (int)Epi::PERM == 2 ? perm64(Rr[i]) : (Epi::PERM ? ((Rr[i] & ~31) + perm32(Rr[i] & 31)) : Rr[i]);
        voffB[i] = (unsigned)(Rb * sh.ldbB + Cc[i] * 2); voffA[i] = (unsigned)(Rr[i] * sh.ldaB + Cc[i] * 2); }
    const size_t kstep = (size_t)(BK * 2);
    const size_t hstepB = (size_t)((int)Epi::PERM == 2 ? 8 : HALF) * sh.ldbB, hstepA = (size_t)HALF * sh.ldaB;
    const unsigned ldsw = (unsigned)wid * 1024u;
    const int aoff = lds_byte(wr * 64 + fr, fq * 8), boff = lds_byte(wc * 32 + fr, fq * 8);
#define PG8_SA(b, h) (((b) * 2 + (h)) * HTB)
#define PG8_SB(b, h) ((4 + (b) * 2 + (h)) * HTB)
#define PG8_STAGE(bufoff, gbase, voff) do { _Pragma("unroll") for (int _i = 0; _i < 2; ++_i) \
        __builtin_amdgcn_global_load_lds((const unsigned*)((const char*)(gbase) + (voff)[_i]), (LAS unsigned*)(lds + (bufoff) + ldsw + _i * 8192), 16, 0, 0); } while (0)
#define PG8_STAGE_A(bufoff, gbase, h, oarr) do { if (GATHER) { PG8_STAGE(bufoff, gbase, (oarr)[h]); } else { PG8_STAGE(bufoff, (gbase) + (h) * hstepA, voffA); } } while (0)
#define PG8_LDA(dst, b, h) do { _Pragma("unroll") for (int m = 0; m < 4; ++m) _Pragma("unroll") for (int k = 0; k < 2; ++k) dst[m][k] = *(const LAS bf16x8*)(lds + PG8_SA(b, h) + aoff + m * 2048 + k * 1024); } while (0)
#define PG8_LDB(dst, b, h) do { _Pragma("unroll") for (int n = 0; n < 2; ++n) _Pragma("unroll") for (int k = 0; k < 2; ++k) dst[n][k] = *(const LAS bf16x8*)(lds + PG8_SB(b, h) + boff + n * 2048 + k * 1024); } while (0)
#define PG8_MMA(ai, bj, At, Bt) do { __builtin_amdgcn_s_setprio(1); _Pragma("unroll") for (int m = 0; m < 4; ++m) _Pragma("unroll") for (int n = 0; n < 2; ++n) { \
        if constexpr (F8) mma_f8(acc[ai][bj][m][n], Bt[n][0], Bt[n][1], At[m][0], At[m][1]); \
        else { _Pragma("unroll") for (int k = 0; k < 2; ++k) acc[ai][bj][m][n] = __builtin_amdgcn_mfma_f32_16x16x32_bf16(Bt[n][k], At[m][k], acc[ai][bj][m][n], 0, 0, 0); } } __builtin_amdgcn_s_setprio(0); } while (0)
#define PG8_MMA_Z(ai, bj, At, Bt) do { __builtin_amdgcn_s_setprio(1); _Pragma("unroll") for (int m = 0; m < 4; ++m) _Pragma("unroll") for (int n = 0; n < 2; ++n) { \
        if constexpr (F8) mma_f8_z(acc[ai][bj][m][n], Bt[n][0], Bt[n][1], At[m][0], At[m][1]); \
        else { acc[ai][bj][m][n] = __builtin_amdgcn_mfma_f32_16x16x32_bf16(Bt[n][0], At[m][0], (f32x4){0.f, 0.f, 0.f, 0.f}, 0, 0, 0); \
               acc[ai][bj][m][n] = __builtin_amdgcn_mfma_f32_16x16x32_bf16(Bt[n][1], At[m][1], acc[ai][bj][m][n], 0, 0, 0); } } __builtin_amdgcn_s_setprio(0); } while (0)
#define PG8_MMA_F(ai, bj, At, Bt) do { if constexpr (NT2) PG8_MMA_Z(ai, bj, At, Bt); else PG8_MMA(ai, bj, At, Bt); } while (0)
#define PG8_WAIT_V(n) asm volatile("s_waitcnt vmcnt(" #n ")" ::: "memory")
#define PG8_WAIT_L(n) asm volatile("s_waitcnt lgkmcnt(" #n ")" ::: "memory")
#define PG8_BAR __builtin_amdgcn_s_barrier()
#define PG8_SCHED __builtin_amdgcn_sched_barrier(0)
#define PG8_AOFF(o, u) do { _Pragma("unroll") for (int _h = 0; _h < 2; ++_h) _Pragma("unroll") for (int _i = 0; _i < 2; ++_i) { \
        if (GATHER) o[_h][_i] = (unsigned)(((const int*)(u).A)[(_h * HALF + Rr[_i]) * 4]) * (unsigned)sh.ldaB + (unsigned)(Cc[_i] * 2); \
        else o[_h][_i] = 0u; } } while (0)
    Unit cur, nxt; int ui = 0;
    if (!S.next(0, cur)) return;
    f32x4 acc[2][2][4][2];
    if constexpr (!NT2) {
#pragma unroll
    for (int a = 0; a < 2; ++a)
#pragma unroll
        for (int b = 0; b < 2; ++b)
#pragma unroll
            for (int m = 0; m < 4; ++m)
#pragma unroll
                for (int n = 0; n < 2; ++n) acc[a][b][m][n] = (f32x4){0.f, 0.f, 0.f, 0.f}; }
    bf16x8 At[4][2], B0[2][2], B1[2][2];
    unsigned oC[2][2], oN[2][2];
    PG8_AOFF(oC, cur);
    const char* cA = GATHER ? sh.Abase : cur.A; const char* cB = cur.B;
    PG8_STAGE(PG8_SB(0, 0), cB, voffB); PG8_STAGE(PG8_SB(0, 1), cB + hstepB, voffB); PG8_STAGE_A(PG8_SA(0, 0), cA, 0, oC); PG8_STAGE_A(PG8_SA(0, 1), cA, 1, oC);
    if (wr == 1) PG8_BAR;
    PG8_WAIT_V(2); PG8_BAR;
    PG8_STAGE(PG8_SB(1, 0), cB + kstep, voffB); PG8_STAGE_A(PG8_SA(1, 0), cA + kstep, 0, oC); PG8_STAGE(PG8_SB(1, 1), cB + hstepB + kstep, voffB);
    PG8_WAIT_V(6); PG8_BAR;
    for (;;) {
        const bool has_next = S.next(ui + 1, nxt);
        const char* nA = GATHER ? cA : (has_next ? nxt.A : cA); const char* nB = has_next ? nxt.B : cB;
        if (GATHER) { if (has_next) { PG8_AOFF(oN, nxt); } else {
#pragma unroll
            for (int h = 0; h < 2; ++h)
#pragma unroll
                for (int i = 0; i < 2; ++i) oN[h][i] = oC[h][i]; } }
#pragma unroll 1
        for (int t = 0; t < nt; t += 2) {
            const bool last = (t == nt - 2);
            const char* a1 = cA + (size_t)(t + 1) * kstep;
            const char* a2 = last ? nA : cA + (size_t)(t + 2) * kstep; const char* b2 = last ? nB : cB + (size_t)(t + 2) * kstep;
            const char* a3 = a2 + kstep; const char* b3 = b2 + kstep;
            unsigned o2[2][2];
#pragma unroll
            for (int h = 0; h < 2; ++h)
#pragma unroll
                for (int i = 0; i < 2; ++i) o2[h][i] = (GATHER && last) ? oN[h][i] : oC[h][i];
            PG8_LDB(B0, 0, 0); PG8_LDB(B1, 0, 1); PG8_SCHED; PG8_LDA(At, 0, 0); PG8_STAGE_A(PG8_SA(1, 1), a1, 1, oC);
            PG8_WAIT_V(8); PG8_WAIT_L(0); PG8_BAR; PG8_MMA_F(0, 0, At, B0); PG8_MMA_F(0, 1, At, B1); PG8_BAR; PG8_SCHED;
            PG8_LDA(At, 0, 1); PG8_STAGE(PG8_SB(0, 0), b2, voffB); PG8_STAGE(PG8_SB(0, 1), b2 + hstepB, voffB); PG8_STAGE_A(PG8_SA(0, 0), a2, 0, o2);
            PG8_WAIT_V(8); PG8_WAIT_L(0); PG8_BAR; PG8_MMA_F(1, 0, At, B0); PG8_MMA_F(1, 1, At, B1); PG8_BAR; PG8_SCHED;
            PG8_LDB(B0, 1, 0); PG8_LDB(B1, 1, 1); PG8_SCHED; PG8_LDA(At, 1, 0); PG8_STAGE_A(PG8_SA(0, 1), a2, 1, o2);
            PG8_WAIT_V(8); PG8_WAIT_L(0); PG8_BAR; PG8_MMA(0, 0, At, B0); PG8_MMA(0, 1, At, B1); PG8_BAR; PG8_SCHED;
            PG8_LDA(At, 1, 1); PG8_STAGE(PG8_SB(1, 0), b3, voffB); PG8_STAGE(PG8_SB(1, 1), b3 + hstepB, voffB); PG8_STAGE_A(PG8_SA(1, 0), a3, 0, o2);
            PG8_WAIT_V(8); PG8_WAIT_L(0); PG8_BAR; PG8_MMA(1, 0, At, B0); PG8_MMA(1, 1, At, B1); PG8_BAR; PG8_SCHED;
        }
        if (wr == 0) PG8_BAR;
        if constexpr (F8) asm volatile("s_nop 15\n\ts_nop 7" ::: "memory");
        E(acc, cur, wr, wc, fr, fq);
        if (!has_next) break;
        if constexpr (!NT2) {
#pragma unroll
        for (int a = 0; a < 2; ++a)
#pragma unroll
            for (int b = 0; b < 2; ++b)
#pragma unroll
                for (int m = 0; m < 4; ++m)
#pragma unroll
                    for (int n = 0; n < 2; ++n) acc[a][b][m][n] = (f32x4){0.f, 0.f, 0.f, 0.f}; }
        cur = nxt; cA = nA; cB = nB; ++ui;
        if (GATHER) {
#pragma unroll
            for (int h = 0; h < 2; ++h)
#pragma unroll
                for (int i = 0; i < 2; ++i) oC[h][i] = oN[h][i]; }
        if (wr == 1) PG8_BAR;
    }
    PG8_WAIT_V(0);
    PG8_BAR;
#undef PG8_SA
#undef PG8_SB
#undef PG8_STAGE
#undef PG8_STAGE_A
#undef PG8_LDA
#undef PG8_LDB
#undef PG8_MMA
#undef PG8_MMA_Z
#undef PG8_MMA_F
#undef PG8_WAIT_V
#undef PG8_WAIT_L
#undef PG8_BAR
#undef PG8_SCHED
#undef PG8_AOFF
}
}
__device__ __forceinline__ int vcu_of(int bx, int G) { return (G % 8 == 0) ? (bx % 8) * (G / 8) + bx / 8 : bx; }

struct DenseSched {
    const char* A; const char* B; int nM, nN, G, c, ldaB, ldbB;
    __device__ __forceinline__ bool next(int i, pg8::Unit& u) const {
        const int L = i * G + c; if (L >= nM * nN) return false;
        const int nig = 8 * nN, gid = L / nig, fm = gid * 8, gsz = (nM - fm) < 8 ? (nM - fm) : 8;
        u.pm = fm + ((L % nig) % gsz); u.pn = (L % nig) / gsz;
        u.A = A + (size_t)u.pm * 256 * ldaB; u.B = B + (size_t)u.pn * 256 * ldbB; return true;
    }
};

__device__ __forceinline__ void store8bf(bf16_t* p, f32x4 a, f32x4 b) { u32x4 w; w.x = pk2(a[0], a[1]); w.y = pk2(a[2], a[3]); w.z = pk2(b[0], b[1]); w.w = pk2(b[2], b[3]); *(u32x4*)p = w; }

struct EpiG1 {
    static constexpr bool PERM = true;
    unsigned char* ws;
    __device__ __forceinline__ void operator()(const f32x4 (&acc)[2][2][4][2], const pg8::Unit& u, int wr, int wc, int fr, int fq) const {
        const float* rstd = (const float*)(ws + WS_RSTD0);
        const int pn = u.pn; const int seg = pn < 8 ? 0 : (pn >> 2) - 1;
        const int row0 = u.pm * 256 + wr * 64 + fr;
        float rsv[2][4];
#pragma unroll
        for (int ai = 0; ai < 2; ++ai)
#pragma unroll
            for (int m = 0; m < 4; ++m) rsv[ai][m] = rstd[row0 + ai * 128 + m * 16];
        if (seg == 0) {
            bf16_t* gs = (bf16_t*)(ws + WS_GU); const int col0 = pn * 128 + wc * 32 + 8 * fq;
#pragma unroll
            for (int ai = 0; ai < 2; ++ai)
#pragma unroll
                for (int m = 0; m < 4; ++m) { const int row = row0 + ai * 128 + m * 16; const float rs = rsv[ai][m];
                    const float rg = rs * -1.4426950408889634f;
                    f32x4 a0 = acc[ai][0][m][0] * rs, a1 = acc[ai][0][m][1] * rs, g0 = acc[ai][1][m][0] * rg, g1 = acc[ai][1][m][1] * rg;
#pragma unroll
                    for (int j = 0; j < 4; ++j) { a0[j] = gelu_sig(a0[j], g0[j]); a1[j] = gelu_sig(a1[j], g1[j]); }
                    store8bf(gs + (size_t)row * DM + col0, a0, a1); }
            return; }
        bf16_t* base; int ldc, colt;
        if (seg == 1) { base = (bf16_t*)(ws + WS_GV); ldc = DM; colt = (pn - 8) * 256; }
        else if (seg == 2) { base = (bf16_t*)(ws + WS_SB); ldc = DM; colt = (pn - 12) * 256; }
        else { base = (bf16_t*)(ws + WS_LAT); ldc = LATW; colt = (pn - 16) * 256; }
        const int act = seg == 1 ? 1 : (seg == 2 ? 2 : 0);
        const int col0 = colt + wc * 32 + 8 * fq;
        float* gvstat = (float*)(ws + WS_GVSTAT); float* latstat = (float*)(ws + WS_LATSTAT);
#pragma unroll
        for (int ai = 0; ai < 2; ++ai)
#pragma unroll
            for (int m = 0; m < 4; ++m) { const int row = row0 + ai * 128 + m * 16; const float rs = rsv[ai][m]; bf16_t* rowp = base + (size_t)row * ldc + col0;
                float s1 = 0.f, q0 = 0.f, q1 = 0.f;
#pragma unroll
                for (int bj = 0; bj < 2; ++bj) { const float rsa = act == 2 ? rs * -1.4426950408889634f : rs; f32x4 v0 = acc[ai][bj][m][0] * rsa, v1 = acc[ai][bj][m][1] * rsa;
                    if (act == 1) {
#pragma unroll
                        for (int j = 0; j < 4; ++j) { v0[j] = gelu_tanh(v0[j]); v1[j] = gelu_tanh(v1[j]); } }
                    else if (act == 2) {
#pragma unroll
                        for (int j = 0; j < 4; ++j) { v0[j] = sigmoid_l2(v0[j]); v1[j] = sigmoid_l2(v1[j]); } }
                    store8bf(rowp + bj * 128, v0, v1);
                    if (seg == 1 || seg == 3) { const float sq = (v0[0] * v0[0] + v0[1] * v0[1]) + (v0[2] * v0[2] + v0[3] * v0[3]) + (v1[0] * v1[0] + v1[1] * v1[1]) + (v1[2] * v1[2] + v1[3] * v1[3]);
                        s1 += (v0[0] + v0[1]) + (v0[2] + v0[3]) + (v1[0] + v1[1]) + (v1[2] + v1[3]); if (bj == 0) q0 = sq; else q1 = sq; } }
                if (seg == 1) { float q = q0 + q1; s1 = rows4_sum(s1); q = rows4_sum(q);
                    if (fq == 0) { f32x2 o = {s1, q}; *(f32x2*)(gvstat + (size_t)row * 32 + 2 * ((pn - 8) * 4 + wc)) = o; } }
                else if (seg == 3) { q0 = rows4_sum(q0); q1 = rows4_sum(q1);
                    if (fq == 0) { if (pn == 16) latstat[row * 16 + wc] = q0 + q1; else if (pn == 17) latstat[row * 16 + 4 + wc] = q0 + q1; else { latstat[row * 16 + 8 + wc] = q0; latstat[row * 16 + 12 + wc] = q1; } } }
            }
    }
};
struct EpiBf16 {
    static constexpr bool PERM = true;
    bf16_t* O; int ldc;
    __device__ __forceinline__ void operator()(const f32x4 (&acc)[2][2][4][2], const pg8::Unit& u, int wr, int wc, int fr, int fq) const {
        const int row0 = u.pm * 256 + wr * 64 + fr, col0 = u.pn * 256 + wc * 32 + 8 * fq;
#pragma unroll
        for (int ai = 0; ai < 2; ++ai)
#pragma unroll
            for (int m = 0; m < 4; ++m) { bf16_t* rowp = O + (size_t)(row0 + ai * 128 + m * 16) * ldc + col0;
#pragma unroll
                for (int bj = 0; bj < 2; ++bj) store8bf(rowp + bj * 128, acc[ai][bj][m][0], acc[ai][bj][m][1]); }
    }
};
constexpr int PART_OFF = 131072 + 1024;
__device__ __forceinline__ float sumsq8(const f32x4 a, const f32x4 b) { return (a[0] * a[0] + a[1] * a[1]) + (a[2] * a[2] + a[3] * a[3]) + (b[0] * b[0] + b[1] * b[1]) + (b[2] * b[2] + b[3] * b[3]); }
struct EpiQ {
    static constexpr bool PERM = true;
    unsigned char* ws; LAS unsigned char* lds; const float* gqn; const float* gqr;
    __device__ __forceinline__ void operator()(const f32x4 (&acc)[2][2][4][2], const pg8::Unit& u, int wr, int wc, int fr, int fq) const {
        LAS float* part = (LAS float*)(lds + PART_OFF);
        const float* latstat = (const float*)(ws + WS_LATSTAT); bf16_t* Q = (bf16_t*)(ws + q_off(u.pm >> 3));
        const float* cs = (const float*)(ws + WS_COS); const float* sn = (const float*)(ws + WS_SIN);
        const float scale = 0.07216878364870322f;
        const int pn = u.pn; const bool rope = pn >= 4;
        { int t_ = threadIdx.x; asm volatile("" : "+v"(t_)); fr = t_ & 15; fq = (t_ >> 4) & 3; wc = (t_ >> 6) & 3; wr = t_ >> 8; }
        const int trow0 = wr * 64 + fr, row0 = u.pm * 256 + trow0;
        float rq[2][4];
        { f32x4 la[2][4], lb[2][4];
#pragma unroll
          for (int ai = 0; ai < 2; ++ai)
#pragma unroll
              for (int m = 0; m < 4; ++m) { const int row = row0 + ai * 128 + m * 16; la[ai][m] = *(const f32x4*)(latstat + row * 16 + 4); lb[ai][m] = *(const f32x4*)(latstat + row * 16 + 8); }
#pragma unroll
          for (int ai = 0; ai < 2; ++ai)
#pragma unroll
              for (int m = 0; m < 4; ++m) { const f32x4 a = la[ai][m], b = lb[ai][m];
                  rq[ai][m] = __builtin_amdgcn_rsqf((((a[0] + a[1]) + (a[2] + a[3])) + ((b[0] + b[1]) + (b[2] + b[3]))) * (1.0f / QLAT) + NORM_EPS); } }
#pragma unroll
        for (int ai = 0; ai < 2; ++ai)
#pragma unroll
            for (int m = 0; m < 4; ++m) {
#pragma unroll
                for (int bj = 0; bj < 2; ++bj) { float s = sumsq8(acc[ai][bj][m][0], acc[ai][bj][m][1]) * (rq[ai][m] * rq[ai][m]); s = rows4_sum(s);
                    if (fq == 0) part[((trow0 + ai * 128 + m * 16) * 2 + bj) * 4 + wc] = s; }
                asm volatile("" ::: "memory"); }
        asm volatile("s_waitcnt lgkmcnt(0)" ::: "memory"); __builtin_amdgcn_s_barrier(); asm volatile("" ::: "memory");
        if (!rope) {
            const f32x4 g0 = *(const f32x4*)(gqn + wc * 32 + 8 * fq), g1 = *(const f32x4*)(gqn + wc * 32 + 8 * fq + 4);
#pragma unroll
            for (int ai = 0; ai < 2; ++ai)
#pragma unroll
                for (int m = 0; m < 4; ++m) { const int tr = trow0 + ai * 128 + m * 16; const int row = u.pm * 256 + tr;
#pragma unroll
                    for (int bj = 0; bj < 2; ++bj) { const f32x4 pp = *(const LAS f32x4*)(part + (tr * 2 + bj) * 4); const float tot = (pp[0] + pp[1]) + (pp[2] + pp[3]);
                        const float f = rq[ai][m] * (__builtin_amdgcn_rsqf(tot * (1.0f / 128) + NORM_EPS)) * scale;
                        store8bf(Q + (size_t)(row & (SEQ - 1)) * QW + (2 * pn + bj) * 192 + wc * 32 + 8 * fq, acc[ai][bj][m][0] * f * g0, acc[ai][bj][m][1] * f * g1); }
                    asm volatile("" ::: "memory"); }
        } else {
            const int g = 4 * (wc & 1) + fq;
            const f32x4 g0 = *(const f32x4*)(gqr + 4 * g), g1 = *(const f32x4*)(gqr + 32 + 4 * g);
#pragma unroll
            for (int ai = 0; ai < 2; ++ai) {
                f32x4 cv[4], sv[4];
#pragma unroll
                for (int m = 0; m < 4; ++m) { const int row = u.pm * 256 + trow0 + ai * 128 + m * 16; cv[m] = *(const f32x4*)(cs + row * 32 + 4 * g); sv[m] = *(const f32x4*)(sn + row * 32 + 4 * g); }
#pragma unroll
                for (int m = 0; m < 4; ++m) { const int tr = trow0 + ai * 128 + m * 16; const int row = u.pm * 256 + tr;
                    const f32x4 c = cv[m], s = sv[m];
#pragma unroll
                    for (int bj = 0; bj < 2; ++bj) { const LAS float* pp = part + (tr * 2 + bj) * 4 + (wc & 2); const float tot = pp[0] + pp[1];
                        const float f = rq[ai][m] * (__builtin_amdgcn_rsqf(tot * (1.0f / ROPE) + NORM_EPS));
                        const f32x4 y1 = acc[ai][bj][m][0] * f * g0, y2 = acc[ai][bj][m][1] * f * g1;
                        const int hd = (pn - 4) * 4 + 2 * bj + (wc >> 1);
                        store8bf(Q + (size_t)(row & (SEQ - 1)) * QW + hd * 192 + 128 + 8 * g, (y1 * c - y2 * s) * scale, (y2 * c + y1 * s) * scale); }
                    asm volatile("" ::: "memory"); } }
        }
    }
};
struct EpiKV {
    static constexpr bool PERM = true;
    unsigned char* ws; LAS unsigned char* lds; const float* gkn;
    __device__ __forceinline__ void operator()(const f32x4 (&acc)[2][2][4][2], const pg8::Unit& u, int wr, int wc, int fr, int fq) const {
        LAS float* part = (LAS float*)(lds + PART_OFF);
        const float* latstat = (const float*)(ws + WS_LATSTAT); bf16_t* KV = (bf16_t*)(ws + WS_KVRAW);
        { int t_ = threadIdx.x; asm volatile("" : "+v"(t_)); fr = t_ & 15; fq = (t_ >> 4) & 3; wc = (t_ >> 6) & 3; wr = t_ >> 8; }
        const int trow0 = wr * 64 + fr, row0 = u.pm * 256 + trow0;
        float rk[2][4];
        { f32x4 la[2][4];
#pragma unroll
          for (int ai = 0; ai < 2; ++ai)
#pragma unroll
              for (int m = 0; m < 4; ++m) la[ai][m] = *(const f32x4*)(latstat + (row0 + ai * 128 + m * 16) * 16);
#pragma unroll
          for (int ai = 0; ai < 2; ++ai)
#pragma unroll
              for (int m = 0; m < 4; ++m) { const f32x4 a = la[ai][m]; rk[ai][m] = __builtin_amdgcn_rsqf(((a[0] + a[1]) + (a[2] + a[3])) * (1.0f / KVLAT) + NORM_EPS); } }
#pragma unroll
        for (int ai = 0; ai < 2; ++ai)
#pragma unroll
            for (int m = 0; m < 4; ++m) {
                float s = sumsq8(acc[ai][0][m][0], acc[ai][0][m][1]) * (rk[ai][m] * rk[ai][m]); s = rows4_sum(s);
                if (fq == 0) part[((trow0 + ai * 128 + m * 16) * 2) * 4 + wc] = s;
                asm volatile("" ::: "memory"); }
        asm volatile("s_waitcnt lgkmcnt(0)" ::: "memory"); __builtin_amdgcn_s_barrier(); asm volatile("" ::: "memory");
        const f32x4 g0 = *(const f32x4*)(gkn + wc * 32 + 8 * fq), g1 = *(const f32x4*)(gkn + wc * 32 + 8 * fq + 4);
#pragma unroll
        for (int ai = 0; ai < 2; ++ai)
#pragma unroll
            for (int m = 0; m < 4; ++m) { const int tr = trow0 + ai * 128 + m * 16; const int row = u.pm * 256 + tr;
                const f32x4 pp = *(const LAS f32x4*)(part + (tr * 2) * 4); const float tot = (pp[0] + pp[1]) + (pp[2] + pp[3]);
                const float f = rk[ai][m] * (__builtin_amdgcn_rsqf(tot * (1.0f / 128) + NORM_EPS));
                bf16_t* rowp = KV + (size_t)row * KVW + u.pn * 256 + wc * 32 + 8 * fq;
                store8bf(rowp, acc[ai][0][m][0] * f * g0, acc[ai][0][m][1] * f * g1);
                store8bf(rowp + 128, acc[ai][1][m][0] * rk[ai][m], acc[ai][1][m][1] * rk[ai][m]);
                asm volatile("" ::: "memory"); }
    }
};
struct EpiG4 {
    static constexpr bool PERM = true;
    const float* x; bf16_t* x1b; unsigned char* x1q;
    __device__ __forceinline__ void loadb(int b, size_t off0, f32x4 (&dst)[8]) const {
#pragma unroll
        for (int mm = 0; mm < 2; ++mm)
#pragma unroll
            for (int bj = 0; bj < 2; ++bj)
#pragma unroll
                for (int hf = 0; hf < 2; ++hf) dst[(mm * 2 + bj) * 2 + hf] = *(const f32x4*)(x + off0 + (size_t)((b >> 1) * 128 + ((b & 1) * 2 + mm) * 16) * DM + bj * 128 + hf * 4);
    }
    __device__ __forceinline__ void operator()(const f32x4 (&acc)[2][2][4][2], const pg8::Unit& u, int wr, int wc, int fr, int fq) const {
        const int row0 = u.pm * 256 + wr * 64 + fr, col0 = u.pn * 256 + wc * 32 + 8 * fq;
        const size_t off0 = (size_t)row0 * DM + col0;
        f32x4 xv[2][8];
        loadb(0, off0, xv[0]);
#pragma unroll
        for (int b = 0; b < 4; ++b) { if (b + 1 < 4) loadb(b + 1, off0, xv[(b + 1) & 1]);
            const int ai = b >> 1;
#pragma unroll
            for (int mm = 0; mm < 2; ++mm) { const int m = (b & 1) * 2 + mm; const size_t off = off0 + (size_t)(ai * 128 + m * 16) * DM;
#pragma unroll
                for (int bj = 0; bj < 2; ++bj) { const size_t o = off + bj * 128;
                    const f32x4 v0 = xv[b & 1][(mm * 2 + bj) * 2] + acc[ai][bj][m][0] * (1.0f / (float)(1 << F8K_WO)), v1 = xv[b & 1][(mm * 2 + bj) * 2 + 1] + acc[ai][bj][m][1] * (1.0f / (float)(1 << F8K_WO));
                    store8bf(x1b + o, v0, v1); store8f8(x1q + o, v0, v1); } } }
    }
};
struct EpiG6 {
    static constexpr bool PERM = true;
    bf16_t* O; float* pestat;
    __device__ __forceinline__ void operator()(const f32x4 (&acc)[2][2][4][2], const pg8::Unit& u, int wr, int wc, int fr, int fq) const {
        const int row0 = u.pm * 256 + wr * 64 + fr, col0 = u.pn * 256 + wc * 32 + 8 * fq;
#pragma unroll
        for (int ai = 0; ai < 2; ++ai)
#pragma unroll
            for (int m = 0; m < 4; ++m) { const int row = row0 + ai * 128 + m * 16; bf16_t* rowp = O + (size_t)row * DM + col0; float s = 0.f;
#pragma unroll
                for (int bj = 0; bj < 2; ++bj) { const f32x4 v0 = acc[ai][bj][m][0], v1 = acc[ai][bj][m][1]; store8bf(rowp + bj * 128, v0, v1);
                    s += (v0[0] * v0[0] + v0[1] * v0[1]) + (v0[2] * v0[2] + v0[3] * v0[3]) + (v1[0] * v1[0] + v1[1] * v1[1]) + (v1[2] * v1[2] + v1[3] * v1[3]); }
                s = rows4_sum(s);
                if (fq == 0) pestat[row * 16 + u.pn * 4 + wc] = s; }
    }
};
struct EpiG5 {
    static constexpr bool PERM = false;
    float* out; const bf16_t* pe; const bf16_t* x2b; const float* rstd3; const float* pestat; const float* gout;
    __device__ __forceinline__ void loadb(int b, size_t off0, u32x2 (&dp)[4], u32x2 (&dx)[4]) const {
#pragma unroll
        for (int bj = 0; bj < 2; ++bj)
#pragma unroll
            for (int n = 0; n < 2; ++n) { const size_t o = off0 + (size_t)((b >> 2) * 128 + (b & 3) * 16) * DM + bj * 128 + n * 16;
                dp[bj * 2 + n] = *(const u32x2*)(pe + o); dx[bj * 2 + n] = *(const u32x2*)(x2b + o); }
    }
    __device__ __forceinline__ void operator()(const f32x4 (&acc)[2][2][4][2], const pg8::Unit& u, int wr, int wc, int fr, int fq) const {
        const int row0 = u.pm * 256 + wr * 64 + fr, col0 = u.pn * 256 + wc * 32 + 4 * fq;
        const size_t off0 = (size_t)row0 * DM + col0;
        float r3v[8], rpv[8];
#pragma unroll
        for (int g = 0; g < 4; ++g) { f32x4 ps[2][4];
#pragma unroll
            for (int k = 0; k < 2; ++k) { const int b = g * 2 + k, row = row0 + (b >> 2) * 128 + (b & 3) * 16; r3v[b] = rstd3[row] * (-1.4426950408889634f / (float)(1 << F8K_WPG));
#pragma unroll
                for (int j = 0; j < 4; ++j) ps[k][j] = ((const f32x4*)(pestat + row * 16))[j]; }
#pragma unroll
            for (int k = 0; k < 2; ++k) { const f32x4 p0 = ps[k][0], p1 = ps[k][1], p2 = ps[k][2], p3 = ps[k][3];
                const float sq = ((p0[0] + p0[1]) + (p0[2] + p0[3])) + ((p1[0] + p1[1]) + (p1[2] + p1[3])) + ((p2[0] + p2[1]) + (p2[2] + p2[3])) + ((p3[0] + p3[1]) + (p3[2] + p3[3]));
                rpv[g * 2 + k] = __builtin_amdgcn_rsqf(sq * (1.0f / DM) + NORM_EPS); }
            asm volatile("" ::: "memory"); }
        f32x4 gv[2][2];
#pragma unroll
        for (int bj = 0; bj < 2; ++bj)
#pragma unroll
            for (int n = 0; n < 2; ++n) gv[bj][n] = *(const f32x4*)(gout + col0 + bj * 128 + n * 16);
        u32x2 dp[2][4], dx[2][4];
        loadb(0, off0, dp[0], dx[0]);
#pragma unroll
        for (int b = 0; b < 8; ++b) { if (b + 1 < 8) loadb(b + 1, off0, dp[(b + 1) & 1], dx[(b + 1) & 1]);
            const int ai = b >> 2, m = b & 3; const size_t off = off0 + (size_t)(ai * 128 + m * 16) * DM; const float r3 = r3v[b], rp = rpv[b];
#pragma unroll
            for (int bj = 0; bj < 2; ++bj)
#pragma unroll
                for (int n = 0; n < 2; ++n) { const size_t o = off + bj * 128 + n * 16; const u32x2 pw = dp[b & 1][bj * 2 + n], xw = dx[b & 1][bj * 2 + n];
                    const f32x4 xv = {bflo(xw.x), bfhi(xw.x), bflo(xw.y), bfhi(xw.y)};
                    const f32x4 a = acc[ai][bj][m][n]; f32x4 r;
                    r[0] = xv[0] + sigmoid_l2(a[0] * r3) * (bflo(pw.x) * rp * gv[bj][n][0]);
                    r[1] = xv[1] + sigmoid_l2(a[1] * r3) * (bfhi(pw.x) * rp * gv[bj][n][1]);
                    r[2] = xv[2] + sigmoid_l2(a[2] * r3) * (bflo(pw.y) * rp * gv[bj][n][2]);
                    r[3] = xv[3] + sigmoid_l2(a[3] * r3) * (bfhi(pw.y) * rp * gv[bj][n][3]);
                    __builtin_nontemporal_store(r, (f32x4*)(out + o)); } }
    }
};

struct MoeGuSched {
    unsigned char* ws; const LAS int* tl; int ntiles, G, c;
    __device__ __forceinline__ bool next(int i, pg8::Unit& u) const {
        const int L = i * G + c; if (L >= ntiles * 2) return false;
        const int rt = L >> 1, pn = L & 1, li = __builtin_amdgcn_readfirstlane(tl[rt]);
        u.pm = rt; u.pn = pn | (li == 64 ? 256 : 0); u.A = (const char*)((const u32x4*)(ws + WS_ENT) + rt * 256);
        u.B = (const char*)(li == 64 ? ws + WS_WSHGU : ws + WS_WGU + (size_t)li * 512 * DM) + (size_t)pn * 256 * DM; return true;
    }
};
struct EpiGu {
    static constexpr bool PERM = true;
    unsigned char* ws; int off64;
    __device__ __forceinline__ void operator()(const f32x4 (&acc)[2][2][4][2], const pg8::Unit& u, int wr, int wc, int fr, int fq) const {
        unsigned char* base = (u.pn & 256) ? ws + WS_HSH - (size_t)off64 * EFF : ws + WS_ACT;
        const u32x4* ent = (const u32x4*)(ws + WS_ENT);
        const int row0 = u.pm * 256 + wr * 64 + fr, col0 = (u.pn & 1) * 128 + wc * 32 + 8 * fq;
        u32x2 ew[2][4];
#pragma unroll
        for (int ai = 0; ai < 2; ++ai)
#pragma unroll
            for (int m = 0; m < 4; ++m) ew[ai][m] = *(const u32x2*)((const unsigned*)(ent + (row0 + ai * 128 + m * 16)) + 2);
#pragma unroll
        for (int ai = 0; ai < 2; ++ai)
#pragma unroll
            for (int m = 0; m < 4; ++m) { const int idx = row0 + ai * 128 + m * 16; const float s = __uint_as_float(ew[ai][m].y) * (1.0f / (float)(1 << F8K_WGU)), w = __uint_as_float(ew[ai][m].x);
                const float sg = s * -1.4426950408889634f, cw = s * s * w;
                f32x4 g0 = acc[ai][0][m][0] * acc[ai][1][m][0], g1 = acc[ai][0][m][1] * acc[ai][1][m][1];
#pragma unroll
                for (int j = 0; j < 4; ++j) { g0[j] = g0[j] * (cw * sigmoid_l2(acc[ai][0][m][0][j] * sg)); g1[j] = g1[j] * (cw * sigmoid_l2(acc[ai][0][m][1][j] * sg)); }
                store8f8(base + (size_t)idx * EFF + col0, g0, g1); }
    }
};
struct MoeDownSched {
    unsigned char* ws; const LAS int* tl; int ntiles, G, c, off64;
    __device__ __forceinline__ bool next(int i, pg8::Unit& u) const {
        const int L = (i >> 1) * G + c; if (L >= ntiles * 2) return false;
        const int rt = L >> 1, pn = (L & 1) * 2 + (i & 1), li = __builtin_amdgcn_readfirstlane(tl[rt]);
        u.pm = rt; u.pn = pn | (li << 8);
        u.A = (const char*)((li == 64) ? ws + WS_HSH + (size_t)(rt * 256 - off64) * EFF : ws + WS_ACT + (size_t)rt * 256 * EFF);
        u.B = (const char*)(li == 64 ? ws + WS_WSHD : ws + WS_WD + (size_t)li * DM * EFF) + (size_t)pn * 256 * EFF; return true;
    }
};
struct EpiDown {
    static constexpr int PERM = 2;
    unsigned char* ws; const LAS int* lsh;
    __device__ __forceinline__ void operator()(const f32x4 (&acc)[2][2][4][2], const pg8::Unit& u, int wr, int wc, int fr, int fq) const {
        unsigned char* ybuf = ws + WS_YBUF; const int li = u.pn >> 8, pn = u.pn & 255;
        const int shift = lsh[li], lim = lsh[128 + li];
        const int row0 = u.pm * 256 + wr * 64 + fr; const unsigned col0 = (unsigned)(pn * 256 + wc * 64 + 16 * fq);
#pragma unroll
        for (int ai = 0; ai < 2; ++ai)
#pragma unroll
            for (int m = 0; m < 4; ++m) { const int row = row0 + ai * 128 + m * 16;
                if (row < lim) { const unsigned o = (unsigned)(row - shift) * 1024u + col0; u32x4 w;
                    { const f32x4 v = acc[ai][0][m][0]; w.x = pk4f8(v[0], v[1], v[2], v[3]); } { const f32x4 v = acc[ai][0][m][1]; w.y = pk4f8(v[0], v[1], v[2], v[3]); }
                    { const f32x4 v = acc[ai][1][m][0]; w.z = pk4f8(v[0], v[1], v[2], v[3]); } { const f32x4 v = acc[ai][1][m][1]; w.w = pk4f8(v[0], v[1], v[2], v[3]); }
                    *(u32x4*)(ybuf + o) = w; } }
    }
};
struct Ctx {
    LAS unsigned char* lds; unsigned char* ws; int tid, lane, wave, vcu, G;
};
#define LDS_WAIT() asm volatile("s_waitcnt lgkmcnt(0)" ::: "memory")

template <bool F8>
__device__ __forceinline__ void tr_item(const float* W, int ldw, int k0, int src0, bf16_t* WT, int ldt, int dst0, const float* gain, LAS float* scr, int lane, bool ropeperm, float qs) {
    const int c4 = (lane & 15) * 4, r0 = lane >> 4;
    f32x4 v[16];
#pragma unroll
    for (int i = 0; i < 16; ++i) v[i] = __builtin_nontemporal_load((const f32x4*)(W + (size_t)(k0 + 4 * i + r0) * ldw + src0 + c4));
    if (gain) {
#pragma unroll
        for (int i = 0; i < 16; ++i) v[i] = v[i] * gain[k0 + 4 * i + r0]; }
    const int c = lane & 7;
#pragma unroll
    for (int half = 0; half < 2; ++half) {
        if (((lane & 15) >> 3) == half) {
#pragma unroll
            for (int i = 0; i < 16; ++i) { LAS float* d = scr + (4 * i + r0) * 33 + (c4 - 32 * half); d[0] = v[i][0]; d[1] = v[i][1]; d[2] = v[i][2]; d[3] = v[i][3]; } }
        LDS_WAIT(); asm volatile("" ::: "memory");
#pragma unroll
        for (int j = 0; j < 4; ++j) { const int n = (lane >> 3) + 8 * j; const LAS float* s = scr + (8 * c) * 33 + n;
            const int drow = ropeperm ? 8 * (n >> 2) + 4 * half + (n & 3) : 32 * half + n;
            if constexpr (F8) { u32x2 o; o.x = pk4f8(s[0 * 33] * qs, s[1 * 33] * qs, s[2 * 33] * qs, s[3 * 33] * qs); o.y = pk4f8(s[4 * 33] * qs, s[5 * 33] * qs, s[6 * 33] * qs, s[7 * 33] * qs);
                *(u32x2*)((unsigned char*)WT + (size_t)(dst0 + drow) * ldt + k0 + 8 * c) = o; }
            else { u32x4 o; o.x = pk2(s[0 * 33], s[1 * 33]); o.y = pk2(s[2 * 33], s[3 * 33]); o.z = pk2(s[4 * 33], s[5 * 33]); o.w = pk2(s[6 * 33], s[7 * 33]);
                *(u32x4*)(WT + (size_t)(dst0 + drow) * ldt + k0 + 8 * c) = o; } }
        LDS_WAIT(); asm volatile("" ::: "memory");
    }
}
struct TrJob { const float* W; int ldw, K, ncols, src0; bf16_t* WT; int dst0; const float* gain; bool ropeperm; int f8k; };
__device__ __forceinline__ int trjob_items(const TrJob& j) { return (j.K / 64) * (j.ncols / 64); }
template <int MODE>
__device__ __forceinline__ void trjob_run(const TrJob& j, int item, LAS float* scr, int lane) {
    const int nblk = j.ncols / 64, kb = item / nblk, nb = item % nblk;
    if (MODE == 1 || (MODE == 2 && j.f8k > 0)) tr_item<true>(j.W, j.ldw, kb * 64, j.src0 + nb * 64, j.WT, j.K, j.dst0 + nb * 64, j.gain, scr, lane, false, (float)(1 << j.f8k));
    else tr_item<false>(j.W, j.ldw, kb * 64, j.src0 + nb * 64, j.WT, j.K, j.dst0 + nb * 64, j.gain, scr, lane, j.ropeperm, 1.0f);
}

struct JobDesc { int in_idx, ldw, K, ncols, src0; unsigned wt_off; int dst0, gain_idx, perm, f8k; };
#define QJ(h) {I_WQB, QW, QLAT, 128, (h) * 192, (unsigned)WS_WQB, (h) * 128, I_GQA, 0, 0}
#define RJ(h) {I_WQB, QW, QLAT, 64, (h) * 192 + 128, (unsigned)WS_WQB, 1024 + (h) * 64, I_GQA, 1, 0}
#define UJ(j) {I_WIN, 4800, DM, 128, 128 * (j), (unsigned)WS_WIN, 256 * (j), I_GMIX, 0, 0}, {I_WIN, 4800, DM, 128, 2752 + 128 * (j), (unsigned)WS_WIN, 256 * (j) + 128, I_GMIX, 0, 0}
constexpr int NJOBS = 46, NESS = 21;
__constant__ JobDesc JOBS[NJOBS] = {
    UJ(0), UJ(1), UJ(2), UJ(3), UJ(4), UJ(5), UJ(6), UJ(7),
    {I_WIN, 4800, DM, 1024, 1024, (unsigned)WS_WIN, 2048, I_GMIX, 0, 0},
    {I_WIN, 4800, DM, 1024, 3776, (unsigned)WS_WIN, 3072, I_GMIX, 0, 0},
    {I_WIN, 4800, DM, 256, 2432, (unsigned)WS_WIN, 4096, I_GMIX, 0, 0},
    {I_WIN, 4800, DM, 384, 2048, (unsigned)WS_WIN, 4352, I_GMIX, 0, 0},
    {I_WIN, 4800, DM, 64, 2688, (unsigned)WS_WIN, 4736, I_GMIX, 0, 0},
    {I_WKVB, KVW, KVLAT, KVW, 0, (unsigned)WS_WKVB, 0, I_GKVA, 0, 0},
    {I_WO, DM, DM, DM, 0, (unsigned)WS_WO, 0, -1, 0, F8K_WO},
    {I_WSG, EFF, DM, 128, 0, (unsigned)WS_WSHGU, 0, I_GFFN, 0, F8K_WGU}, {I_WSG, EFF, DM, 128, 128, (unsigned)WS_WSHGU, 256, I_GFFN, 0, F8K_WGU},
    {I_WSU, EFF, DM, 128, 0, (unsigned)WS_WSHGU, 128, I_GFFN, 0, F8K_WGU}, {I_WSU, EFF, DM, 128, 128, (unsigned)WS_WSHGU, 384, I_GFFN, 0, F8K_WGU},
    {I_WSD, DM, EFF, DM, 0, (unsigned)WS_WSHD, 0, -1, 0, F8K_WD},
    {I_WPG, DM, DM, DM, 0, (unsigned)WS_WPG, 0, I_GPI, 0, F8K_WPG},
    {I_WPP, DM, PLE, DM, 0, (unsigned)WS_WPP, 0, -1, 0, 0},
    QJ(0), QJ(1), QJ(2), QJ(3), QJ(4), QJ(5), QJ(6), QJ(7), RJ(0), RJ(1), RJ(2), RJ(3), RJ(4), RJ(5), RJ(6), RJ(7)};
#undef QJ
#undef RJ
#undef UJ

__device__ __forceinline__ void phase_prep0(const Params& P, const Ctx& C) {
    LAS float* scr = (LAS float*)(C.lds + C.wave * 16384);
    unsigned char* ws = C.ws;
    const int gw = C.vcu * NWAVES + C.wave, NGW = C.G * NWAVES, lane = C.lane;
    int total = 0;
#pragma unroll
    for (int j = 0; j < NESS; ++j) total += (JOBS[j].K / 64) * (JOBS[j].ncols / 64);
    for (int it = gw; it < total; it += NGW) {
        int r = it, jj = 0;
        for (int j = 0; j < NESS; ++j) { const int n = (JOBS[j].K / 64) * (JOBS[j].ncols / 64); if (r >= n) { r -= n; jj = j + 1; } else break; }
        const JobDesc d = JOBS[jj];
        TrJob j{P.in[d.in_idx], d.ldw, d.K, d.ncols, d.src0, (bf16_t*)(ws + d.wt_off), d.dst0, d.gain_idx >= 0 ? P.in[d.gain_idx] : nullptr, d.perm != 0, 0};
        trjob_run<0>(j, r, scr, lane);
    }
    bf16_t* WinT = (bf16_t*)(ws + WS_WIN);
    { const int gt = C.vcu * NTHREADS + C.tid, NT = C.G * NTHREADS; u32x4 z = {0u, 0u, 0u, 0u};
      for (int i = gt; i < 64 * DM / 8; i += NT) *(u32x4*)(WinT + (size_t)4800 * DM + (size_t)i * 8) = z; }
    bf16_t* xb = (bf16_t*)(ws + WS_XB); float* rstd0 = (float*)(ws + WS_RSTD0);
#pragma unroll 2
    for (int m = gw; m < T_; m += NGW) {
        const f32x4* xr = (const f32x4*)(P.in[I_X] + (size_t)m * DM) + lane;
        f32x4 v[4]; float s = 0.f;
#pragma unroll
        for (int j = 0; j < 4; ++j) { v[j] = __builtin_nontemporal_load(xr + 64 * j); s += (v[j][0] * v[j][0] + v[j][1] * v[j][1]) + (v[j][2] * v[j][2] + v[j][3] * v[j][3]); }
        s = wave_sum(s);
        if (lane == 0) rstd0[m] = 1.0f / sqrtf(s * (1.0f / DM) + NORM_EPS);
        u32x2* o8 = (u32x2*)(xb + (size_t)m * DM) + lane;
#pragma unroll
        for (int j = 0; j < 4; ++j) { u32x2 w; w.x = pk2(v[j][0], v[j][1]); w.y = pk2(v[j][2], v[j][3]); o8[64 * j] = w; }
    }
}
__device__ __forceinline__ void prep_rest(const Params& P, const Ctx& C, int widx, int nw) {
    LAS float* scr = (LAS float*)(C.lds + C.wave * 16384);
    unsigned char* ws = C.ws;
    const int gw = widx * NWAVES + C.wave, NGW = nw * NWAVES, lane = C.lane;
    int total = 0;
#pragma unroll
    for (int j = NESS; j < NJOBS; ++j) total += (JOBS[j].K / 64) * (JOBS[j].ncols / 64);
    for (int it = gw; it < total; it += NGW) {
        int r = it, jj = NESS;
        for (int j = NESS; j < NJOBS; ++j) { const int n = (JOBS[j].K / 64) * (JOBS[j].ncols / 64); if (r >= n) { r -= n; jj = j + 1; } else break; }
        const JobDesc d = JOBS[jj];
        TrJob j{P.in[d.in_idx], d.ldw, d.K, d.ncols, d.src0, (bf16_t*)(ws + d.wt_off), d.dst0, d.gain_idx >= 0 ? P.in[d.gain_idx] : nullptr, d.perm != 0, d.f8k};
        trjob_run<2>(j, r, scr, lane);
    }
    { const int gt = widx * NTHREADS + C.tid, NT = nw * NTHREADS;
      bf16_t* sw = (bf16_t*)(ws + WS_SGUW); const float* w = P.in[I_SGUW];
      for (int i = gt; i < 8 * 128 * 128; i += NT) { const int r = (i >> 7) & 127, c = i & 127; sw[i] = (bf16_t)f2bf(c <= r ? w[i] : 0.f); }
      bf16_t* wrh = (bf16_t*)(ws + WS_WRH); bf16_t* wrl = (bf16_t*)(ws + WS_WRL); const float* wrr = P.in[I_WR]; const float* gff = P.in[I_GFFN];
      for (int i = gt; i < NEXP * DM; i += NT) { const int e = i & 63, k = i >> 6; const float wv = wrr[i] * gff[k]; const unsigned h = f2bf(wv); wrh[e * DM + k] = (bf16_t)h; wrl[e * DM + k] = (bf16_t)f2bf(wv - bf2f(h)); }
      float* cs = (float*)(ws + WS_COS); float* sn = (float*)(ws + WS_SIN); const int* pos = (const int*)P.in[I_POS];
      for (int i = gt; i < T_ * 32; i += NT) { const int m = i >> 5, l = i & 31; const float inv_freq = exp2f((float)l * (-13.287712379549449f / 32.0f)); const float ang = (float)pos[m] * inv_freq;
          float sv, cv; sincosf(ang, &sv, &cv); cs[i] = cv; sn[i] = sv; }
    }
}
__device__ __forceinline__ void prep_pb(const Params& P, const Ctx& C) {
    const int gt = C.vcu * NTHREADS + C.tid, NT = C.G * NTHREADS;
    bf16_t* pb = (bf16_t*)(C.ws + WS_PB); const float* p = P.in[I_P];
    constexpr int TOTAL = T_ * PLE / 8;
    for (int i0 = gt; i0 < TOTAL; i0 += 4 * NT) {
        f32x4 a[4], b[4];
#pragma unroll
        for (int k = 0; k < 4; ++k) { const int i = i0 + k * NT; if (i < TOTAL) { a[k] = __builtin_nontemporal_load((const f32x4*)(p + (size_t)i * 8)); b[k] = __builtin_nontemporal_load((const f32x4*)(p + (size_t)i * 8 + 4)); } }
#pragma unroll
        for (int k = 0; k < 4; ++k) { const int i = i0 + k * NT; if (i < TOTAL) store8bf(pb + (size_t)i * 8, a[k], b[k]); }
    }
}
__device__ __forceinline__ void phase_prep_wgu(const Params& P, const Ctx& C) {
    LAS float* scr = (LAS float*)(C.lds + C.wave * 16384);
    const int gw = C.vcu * NWAVES + C.wave, NGW = C.G * NWAVES;
    constexpr int ITEMS = (DM / 64) * (128 / 64);
    const int total = NEXP * 4 * ITEMS;
    for (int it = gw; it < total; it += NGW) {
        const int e = it / (4 * ITEMS), r = it % (4 * ITEMS), q = r / ITEMS, item = r % ITEMS;
        const float* W = ((q & 1) ? P.in[I_WEU] : P.in[I_WEG]) + (size_t)e * DM * EFF;
        TrJob j{W, EFF, DM, 128, (q >> 1) * 128, (bf16_t*)(C.ws + WS_WGU + (size_t)e * 512 * DM), q * 128, P.in[I_GFFN], false, F8K_WGU};
        trjob_run<1>(j, item, scr, C.lane);
    }
}
__device__ __forceinline__ void phase_prep_wd(const Params& P, const Ctx& C, int rem) {
    LAS float* scr = (LAS float*)(C.lds + C.wave * 16384);
    constexpr int ED_ITEMS = (EFF / 64) * (DM / 64), TOTAL = NEXP * ED_ITEMS;
    if (rem <= 0 || rem > C.G) rem = C.G;
    const int S = rem + 6 * (C.G - rem);
    const int w0 = C.vcu < rem ? C.vcu : rem + 6 * (C.vcu - rem), w1 = w0 + (C.vcu < rem ? 1 : 6);
    const int i0 = (int)((long long)TOTAL * w0 / S), i1 = (int)((long long)TOTAL * w1 / S);
    for (int it = i0 + C.wave; it < i1; it += NWAVES) { const int e = it / ED_ITEMS, item = it % ED_ITEMS;
        TrJob j{P.in[I_WED] + (size_t)e * EFF * DM, DM, EFF, DM, 0, (bf16_t*)(C.ws + WS_WD + (size_t)e * DM * EFF), 0, nullptr, false, F8K_WD}; trjob_run<1>(j, item, scr, C.lane); }
}

__device__ __forceinline__ void kpe_rows(const Params& P, const Ctx& C) {
    unsigned char* ws = C.ws; const int gw = C.vcu * NWAVES + C.wave, NGW = C.G * NWAVES, lane = C.lane;
    const bf16_t* lat = (const bf16_t*)(ws + WS_LAT); bf16_t* kpe = (bf16_t*)(ws + WS_KPE);
    const float* cs = (const float*)(ws + WS_COS); const float* sn = (const float*)(ws + WS_SIN);
    const float gkr = P.in[I_GKR][lane];
    const int e = lane & 31, pos = 8 * (e >> 2) + (lane >> 5) * 4 + (e & 3);
    for (int m0 = gw; m0 < T_; m0 += 4 * NGW) {
        float krv[4], cv[4], svv[4];
#pragma unroll
        for (int i = 0; i < 4; ++i) { const int m = m0 + i * NGW; if (m < T_) { krv[i] = bf2f(lat[(size_t)m * LATW + 640 + lane]); cv[i] = cs[m * 32 + e]; svv[i] = sn[m * 32 + e]; } else { krv[i] = 0.f; cv[i] = 0.f; svv[i] = 0.f; } }
#pragma unroll
        for (int i = 0; i < 4; ++i) { const int m = m0 + i * NGW; const float kr = krv[i];
            const float s3 = wave_sum(kr * kr); const float kn = kr * (1.0f / sqrtf(s3 * (1.0f / ROPE) + NORM_EPS)) * gkr;
            float other; { const auto sw_ = __builtin_amdgcn_permlane32_swap(__float_as_uint(kn), __float_as_uint(kn), false, false); other = lane < 32 ? __uint_as_float(sw_[1]) : __uint_as_float(sw_[0]); }
            const float ro = lane < 32 ? kn * cv[i] - other * svv[i] : kn * cv[i] + other * svv[i];
            if (m < T_) kpe[(size_t)m * ROPE + pos] = f2bf1(ro); }
    }
}
__device__ __forceinline__ void phase_sgu(const Params& P, const Ctx& C) {
    unsigned char* ws = C.ws; const int tid = C.tid, lane = C.lane, wid = C.wave;
    const bf16_t* gs = (const bf16_t*)(ws + WS_GU); const bf16_t* gv = (const bf16_t*)(ws + WS_GV);
    bf16_t* yag = (bf16_t*)(ws + WS_YAG); const bf16_t* sw = (const bf16_t*)(ws + WS_SGUW);
    const float* gvstat = (const float*)(ws + WS_GVSTAT);
    const float* lng = P.in[I_LNG]; const float* lnb = P.in[I_LNB]; const float* sgub = P.in[I_SGUB];
    constexpr int VTS = 136;
    LAS bf16_t* VT = (LAS bf16_t*)C.lds;
    LAS float* murs = (LAS float*)(C.lds + 128 * VTS * 2);
    constexpr int OTS = 132;
    LAS float* OT = (LAS float*)(C.lds + 128 * VTS * 2 + 1024);
    const int wi = wid >> 1, wcn = wid & 1, r32 = lane & 31, hi = lane >> 5;
    u32x4 gvr[4]; f32x4 str[8], lnp[4];
#define SGU_LOAD(U) do { const int g_ = (U) & 7, n_ = ((U) >> 3) & 15, b_ = (U) >> 7; const size_t t0_ = (size_t)b_ * SEQ + n_ * 128; const int c0_ = (tid & 15) * 8; \
        if (tid < 128) { const f32x4* st_ = (const f32x4*)(gvstat + (t0_ + tid) * 32); _Pragma("unroll") for (int k = 0; k < 8; ++k) str[k] = st_[k]; } \
        _Pragma("unroll") for (int q = 0; q < 4; ++q) { const int j = 4 * (tid >> 4) + q; gvr[q] = *(const u32x4*)(gv + (t0_ + j) * DM + g_ * 128 + c0_); } \
        lnp[0] = *(const f32x4*)(lng + g_ * 128 + c0_); lnp[1] = *(const f32x4*)(lng + g_ * 128 + c0_ + 4); lnp[2] = *(const f32x4*)(lnb + g_ * 128 + c0_); lnp[3] = *(const f32x4*)(lnb + g_ * 128 + c0_ + 4); } while (0)
    if (C.vcu < NB * 16 * 8) SGU_LOAD(C.vcu);
    for (int unit = C.vcu; unit < NB * 16 * 8; unit += C.G) {
        const int g = unit & 7, n = (unit >> 3) & 15, b = unit >> 7;
        const size_t t0 = (size_t)b * SEQ + n * 128;
        if (tid < 128) { float sm = 0.f, sq = 0.f;
#pragma unroll
            for (int k = 0; k < 8; ++k) { const f32x4 v = str[k]; sm += v[0] + v[2]; sq += v[1] + v[3]; }
            const float mu = sm * (1.0f / DM); const float var = fmaxf(sq * (1.0f / DM) - mu * mu, 0.f);
            murs[2 * tid] = mu; murs[2 * tid + 1] = 1.0f / sqrtf(var + LN_EPS); }
        __syncthreads();
        { const int j0 = 4 * (tid >> 4), c0 = (tid & 15) * 8;
          const f32x4 ga = lnp[0], gb = lnp[1], ba = lnp[2], bb = lnp[3];
          float vals[4][8];
#pragma unroll
          for (int q = 0; q < 4; ++q) { const u32x4 w = gvr[q]; const float mu = murs[2 * (j0 + q)], rs = murs[2 * (j0 + q) + 1];
              const float f[8] = {bflo(w.x), bfhi(w.x), bflo(w.y), bfhi(w.y), bflo(w.z), bfhi(w.z), bflo(w.w), bfhi(w.w)};
#pragma unroll
              for (int e = 0; e < 8; ++e) { const float gg = e < 4 ? ga[e] : gb[e - 4], bv = e < 4 ? ba[e] : bb[e - 4]; vals[q][e] = (f[e] - mu) * rs * gg + bv; } }
#pragma unroll
          for (int e = 0; e < 8; ++e)
#pragma unroll
              for (int pr = 0; pr < 2; ++pr) *(LAS unsigned*)(VT + (c0 + e) * VTS + ((j0 + 2 * pr) ^ c0)) = pk2(vals[2 * pr][e], vals[2 * pr + 1][e]); }
        __syncthreads();
        if (unit + C.G < NB * 16 * 8) SGU_LOAD(unit + C.G);
        u32x4 gw4[4];
#pragma unroll
        for (int q = 0; q < 4; ++q) { const int chunk = tid + 512 * q, i = chunk >> 4, c0 = (chunk & 15) * 8; gw4[q] = *(const u32x4*)(gs + (t0 + i) * DM + g * 128 + c0); }
        f32x16 acc0 = {}, acc1 = {};
        const bf16_t* wrow = sw + (size_t)g * 128 * 128 + (size_t)(wi * 32 + r32) * 128 + hi * 8;
        const int c0r = wcn * 64 + r32, c1r = c0r + 32; const LAS bf16_t* v0p = VT + c0r * VTS; const LAS bf16_t* v1p = VT + c1r * VTS; const int k0s = c0r & 120, k1s = c1r & 120;
        bf16x8 af[8];
#pragma unroll
        for (int ks = 0; ks < 8; ++ks) if (ks < 2 * wi + 2) af[ks] = *(const bf16x8*)(wrow + ks * 16);
#pragma unroll
        for (int ks = 0; ks < 8; ++ks) if (ks < 2 * wi + 2) {
            const bf16x8 b0 = *(const LAS bf16x8*)(v0p + ((ks * 16 + hi * 8) ^ k0s)), b1 = *(const LAS bf16x8*)(v1p + ((ks * 16 + hi * 8) ^ k1s));
            acc0 = __builtin_amdgcn_mfma_f32_32x32x16_bf16(af[ks], b0, acc0, 0, 0, 0);
            acc1 = __builtin_amdgcn_mfma_f32_32x32x16_bf16(af[ks], b1, acc1, 0, 0, 0);
        }
#pragma unroll
        for (int r = 0; r < 16; ++r) { const int i = wi * 32 + (r & 3) + 8 * (r >> 2) + 4 * hi; const float bias = sgub[g * 128 + i];
            OT[i * OTS + wcn * 64 + r32] = acc0[r] + bias; OT[i * OTS + wcn * 64 + 32 + r32] = acc1[r] + bias; }
        __syncthreads();
#pragma unroll
        for (int q = 0; q < 4; ++q) { const int chunk = tid + 512 * q, i = chunk >> 4, c0 = (chunk & 15) * 8;
            const size_t o = (t0 + i) * DM + g * 128 + c0;
            const u32x4 gw = gw4[q];
            const f32x4 m0 = *(const LAS f32x4*)(OT + i * OTS + c0), m1 = *(const LAS f32x4*)(OT + i * OTS + c0 + 4);
            f32x4 r0, r1;
            r0[0] = bflo(gw.x) * m0[0]; r0[1] = bfhi(gw.x) * m0[1]; r0[2] = bflo(gw.y) * m0[2]; r0[3] = bfhi(gw.y) * m0[3];
            r1[0] = bflo(gw.z) * m1[0]; r1[1] = bfhi(gw.z) * m1[1]; r1[2] = bflo(gw.w) * m1[2]; r1[3] = bfhi(gw.w) * m1[3];
            store8bf(yag + o, r0, r1); }
        __syncthreads();
    }
#undef SGU_LOAD
}

namespace att {
constexpr int QBLK = 32, KVBLK = 64, QB = 256;
constexpr int SHM_V = KVBLK * 128 * 2, SHM_KN = KVBLK * 128 * 2, SHM_KR = KVBLK * 64 * 2;
constexpr int LDS_V = 0, LDS_KN = 2 * SHM_V, LDS_KR = LDS_KN + 2 * SHM_KN, LDS_WS = LDS_KR + 2 * SHM_KR, LDS_BYTES = LDS_WS + NWAVES * 64 * 4;
#define KSWZ(row, colB) ((row) * 256 + ((colB) ^ (((row) & 15) << 4)))
#define KRSWZ(row, chunk) ((row) * 128 + ((((chunk) ^ ((row) >> 1)) & 7) << 4))
#define SBAR() __builtin_amdgcn_sched_barrier(0)
__device__ __forceinline__ int v_st(int k, int c) { const int kk = (k & ~0xC) | ((k & 4) << 1) | ((k & 8) >> 1); return ((kk >> 3) * 4 + (c >> 5)) * 512 + ((kk & 7) * 32 + (c & 31)) * 2; }
__device__ __forceinline__ int v_rd_base(int lane) { return ((lane & 3) << 3) | (((lane >> 2) & 3) << 6) | (((lane >> 4) & 1) << 5) | (((lane >> 5) & 1) << 8); }
constexpr int v_rd_off(int d0, int ks, int half) { return d0 * 512 + ks * 4096 + half * 2048; }
__device__ __forceinline__ int crow(int r, int hi) { return (r & 3) + 8 * (r >> 2) + 4 * hi; }

__device__ __forceinline__ void attn_block(int b, int h, int qb, const bf16_t* Q, const bf16_t* KV, const bf16_t* KPE, const bf16_t* SBG, bf16_t* MRG, LAS char* lds, bool dry) {
    const int tid = threadIdx.x, wid = __builtin_amdgcn_readfirstlane(tid >> 6), lane = tid & 63, r32 = lane & 31, hi = lane >> 5;
    LAS char* V_lds = lds + LDS_V; LAS char* KN_lds = lds + LDS_KN; LAS char* KR_lds = lds + LDS_KR;
    LAS float* wsf = (LAS float*)(lds + LDS_WS) + wid * 64; LAS float* li_l = wsf; LAS float* al_l = wsf + 32;
    const int P0 = qb * QB, NT = (P0 + QB) / KVBLK;
    const unsigned tb = (unsigned)b * SEQ;
    const int qlo = P0 + wid * QBLK;
    bf16x8 qr[12];
    { const bf16_t* qp = Q + (unsigned)((qlo + r32) * QW + h * 192 + hi * 8);
#pragma unroll
      for (int d0 = 0; d0 < 12; ++d0) qr[d0] = *(const bf16x8*)(qp + d0 * 16); }
    bf16x8 st_k0, st_k1, st_v0, st_v1, st_r;
#define SLOAD(k0) do { int t3_ = tid; asm volatile("" : "+v"(t3_)); const unsigned kvo = (tb + (t3_ >> 4)) * KVW + h * 256 + (t3_ & 15) * 8, kro = (tb + (t3_ >> 3)) * ROPE + (t3_ & 7) * 8; \
        const bf16_t* p_ = KV + (unsigned)(kvo + (unsigned)(k0) * KVW); st_k0 = *(const bf16x8*)p_; st_k1 = *(const bf16x8*)(p_ + 32 * KVW); \
        st_v0 = *(const bf16x8*)(p_ + 128); st_v1 = *(const bf16x8*)(p_ + 32 * KVW + 128); st_r = *(const bf16x8*)(KPE + (unsigned)(kro + (unsigned)(k0) * ROPE)); } while (0)
#define SWRITE(bf) do { int t2_ = tid; asm volatile("" : "+v"(t2_)); const int sr_ = t2_ >> 4, sc_ = (t2_ & 15) * 8, rr_ = t2_ >> 3, rc_ = t2_ & 7; \
        const int kws = KSWZ(sr_, sc_ * 2), vst0 = v_st(sr_, sc_), vst1 = v_st(32 + sr_, sc_), krs = KRSWZ(rr_, rc_); \
        *(LAS bf16x8*)(KN_lds + (bf) * SHM_KN + kws) = st_k0; *(LAS bf16x8*)(KN_lds + (bf) * SHM_KN + kws + 32 * 256) = st_k1; \
        *(LAS bf16x8*)(V_lds + (bf) * SHM_V + vst0) = st_v0; *(LAS bf16x8*)(V_lds + (bf) * SHM_V + vst1) = st_v1; *(LAS bf16x8*)(KR_lds + (bf) * SHM_KR + krs) = st_r; } while (0)
    SLOAD(0); SWRITE(0);
    __syncthreads();
    float m_reg = -1e30f, l_reg = 0.f; f32x16 o[4] = {};
    if (wid >= 4) __builtin_amdgcn_s_setprio(1);
    const int vb0 = (int)(unsigned)(uintptr_t)V_lds + v_rd_base(lane);
    constexpr float C2 = 1.4426950408889634f;
    for (int t = 0; t < NT; ++t) {
        const int bf = t & 1, kb = t * KVBLK;
        if (t + 1 < NT) SLOAD(kb + KVBLK);
        if (kb <= qlo + QBLK - 1) {
            f32x16 p0 = {}, p1 = {};
            int l2_ = lane; asm volatile("" : "+v"(l2_)); const int r32 = l2_ & 31, hi = l2_ >> 5;
            { LAS const char* kn = KN_lds + bf * SHM_KN;
              LAS const char* kbp[4];
#pragma unroll
              for (int dd = 0; dd < 4; ++dd) kbp[dd] = kn + KSWZ(r32, (dd * 16 + hi * 8) * 2);
#pragma unroll
              for (int d0 = 0; d0 < 8; ++d0) { LAS const char* a = (LAS const char*)((unsigned)(uintptr_t)kbp[d0 & 3] ^ (unsigned)((d0 >> 2) * 128));
                  const bf16x8 b0 = *(LAS const bf16x8*)a, b1 = *(LAS const bf16x8*)(a + 32 * 256);
                  p0 = __builtin_amdgcn_mfma_f32_32x32x16_bf16(b0, qr[d0], p0, 0, 0, 0);
                  p1 = __builtin_amdgcn_mfma_f32_32x32x16_bf16(b1, qr[d0], p1, 0, 0, 0); }
              LAS const char* kr = KR_lds + bf * SHM_KR;
#pragma unroll
              for (int d0 = 0; d0 < 4; ++d0) { LAS const char* a = kr + KRSWZ(r32, 2 * d0 + hi);
                  const bf16x8 b0 = *(LAS const bf16x8*)a, b1 = *(LAS const bf16x8*)(a + 32 * 128);
                  p0 = __builtin_amdgcn_mfma_f32_32x32x16_bf16(b0, qr[8 + d0], p0, 0, 0, 0);
                  p1 = __builtin_amdgcn_mfma_f32_32x32x16_bf16(b1, qr[8 + d0], p1, 0, 0, 0); } }
            if (kb + KVBLK - 1 > qlo) {
                const int dq = qlo + r32 - 4 * hi - kb; const float NEG = -__builtin_inff();
#pragma unroll
                for (int r = 0; r < 16; ++r) { const int c = (r & 3) + 8 * (r >> 2); if (dq - c < 0) p0[r] = NEG; if (dq - c - 32 < 0) p1[r] = NEG; } }
            float pmax = p0[0];
#pragma unroll
            for (int r = 1; r < 16; ++r) pmax = fmaxf(pmax, p0[r]);
#pragma unroll
            for (int r = 0; r < 16; ++r) pmax = fmaxf(pmax, p1[r]);
            { auto sw = __builtin_amdgcn_permlane32_swap(__float_as_uint(pmax), __float_as_uint(pmax), false, false); pmax = fmaxf(__uint_as_float(sw[0]), __uint_as_float(sw[1])); }
            float alpha = 1.f; const bool grow = __any((pmax - m_reg) * C2 > 6.0f);
            if (grow) { const float mn_ = fmaxf(m_reg, pmax); alpha = __builtin_amdgcn_exp2f((m_reg - mn_) * C2); m_reg = mn_; }
            const float mnL = -m_reg * C2; float ps = 0.f;
#pragma unroll
            for (int r = 0; r < 16; ++r) { p0[r] = __builtin_amdgcn_exp2f(fmaf(p0[r], C2, mnL)); p1[r] = __builtin_amdgcn_exp2f(fmaf(p1[r], C2, mnL)); ps += p0[r] + p1[r]; }
            { auto sw = __builtin_amdgcn_permlane32_swap(__float_as_uint(ps), __float_as_uint(ps), false, false); ps = __uint_as_float(sw[0]) + __uint_as_float(sw[1]); }
            l_reg = l_reg * alpha + ps;
            bf16x8 pa0, pa1, pa2, pa3;
#define PK4(Pv, B_, OUT) do { unsigned a0 = pk2(Pv[B_ + 0], Pv[B_ + 1]), a1 = pk2(Pv[B_ + 2], Pv[B_ + 3]); unsigned b0 = pk2(Pv[B_ + 4], Pv[B_ + 5]), b1 = pk2(Pv[B_ + 6], Pv[B_ + 7]); \
        auto r0 = __builtin_amdgcn_permlane32_swap(a0, b0, false, false); auto r1 = __builtin_amdgcn_permlane32_swap(a1, b1, false, false); \
        u32x4 w = {r0[0], r1[0], r0[1], r1[1]}; OUT = *reinterpret_cast<bf16x8*>(&w); } while (0)
            PK4(p0, 0, pa0); PK4(p0, 8, pa1); PK4(p1, 0, pa2); PK4(p1, 8, pa3);
#undef PK4
            if (grow) { if (hi == 0) al_l[r32] = alpha; asm volatile("s_waitcnt lgkmcnt(0)" ::: "memory");
#pragma unroll
                for (int d_ = 0; d_ < 4; ++d_)
#pragma unroll
                    for (int r = 0; r < 16; ++r) o[d_][r] *= al_l[crow(r, hi)]; }
#define TRRD(dst, off) asm volatile("ds_read_b64_tr_b16 %0, %1 offset:%2" : "=&v"(dst) : "v"(vb0), "i"(off) : "memory")
#define PV_D0(VB, d0) do { s16x4 l0, l1, l2, l3, h0, h1, h2, h3; constexpr int b_ = VB * SHM_V + v_rd_off(d0, 0, 0); \
        TRRD(l0, b_); TRRD(h0, b_ + 2048); TRRD(l1, b_ + 4096); TRRD(h1, b_ + 6144); TRRD(l2, b_ + 8192); TRRD(h2, b_ + 10240); TRRD(l3, b_ + 12288); TRRD(h3, b_ + 14336); \
        asm volatile("s_waitcnt lgkmcnt(0)" ::: "memory"); SBAR(); \
        o[d0] = __builtin_amdgcn_mfma_f32_32x32x16_bf16(pa0, (bf16x8){l0[0], l0[1], l0[2], l0[3], h0[0], h0[1], h0[2], h0[3]}, o[d0], 0, 0, 0); \
        o[d0] = __builtin_amdgcn_mfma_f32_32x32x16_bf16(pa1, (bf16x8){l1[0], l1[1], l1[2], l1[3], h1[0], h1[1], h1[2], h1[3]}, o[d0], 0, 0, 0); \
        o[d0] = __builtin_amdgcn_mfma_f32_32x32x16_bf16(pa2, (bf16x8){l2[0], l2[1], l2[2], l2[3], h2[0], h2[1], h2[2], h2[3]}, o[d0], 0, 0, 0); \
        o[d0] = __builtin_amdgcn_mfma_f32_32x32x16_bf16(pa3, (bf16x8){l3[0], l3[1], l3[2], l3[3], h3[0], h3[1], h3[2], h3[3]}, o[d0], 0, 0, 0); } while (0)
            if (bf == 0) { PV_D0(0, 0); PV_D0(0, 1); PV_D0(0, 2); PV_D0(0, 3); } else { PV_D0(1, 0); PV_D0(1, 1); PV_D0(1, 2); PV_D0(1, 3); }
#undef PV_D0
#undef TRRD
        }
        if (t + 1 < NT) SWRITE(bf ^ 1);
        __syncthreads();
    }
#undef SLOAD
#undef SWRITE
    __builtin_amdgcn_s_setprio(0);
    if (hi == 0) li_l[r32] = l_reg; asm volatile("s_waitcnt lgkmcnt(0)" ::: "memory");
    int hi2 = hi; asm volatile("" : "+v"(hi2));
    LAS bf16_t* OT = (LAS bf16_t*)(lds + wid * 8704);
    int l3_ = lane; asm volatile("" : "+v"(l3_));
    u32x4 yv[8], sv[8];
#pragma unroll
    for (int i = 0; i < 8; ++i) { const int id = l3_ + 64 * i, row = id >> 4, ch = id & 15; const unsigned a = (tb + qlo + row) * DM + h * 128 + ch * 8;
        yv[i] = *(const u32x4*)(MRG + a); sv[i] = *(const u32x4*)(SBG + a); }
#pragma unroll
    for (int r = 0; r < 16; ++r) { const int orow = crow(r, hi2); const float rl = __builtin_amdgcn_rcpf(li_l[orow]);
#pragma unroll
        for (int d0 = 0; d0 < 4; ++d0) OT[orow * 136 + d0 * 32 + r32] = f2bf1(o[d0][r] * rl); }
    asm volatile("s_waitcnt lgkmcnt(0)" ::: "memory");
#pragma unroll
    for (int i = 0; i < 8; ++i) { const int id = l3_ + 64 * i, row = id >> 4, ch = id & 15;
        const u32x4 ov = *(const LAS u32x4*)(OT + row * 136 + ch * 8);
        const unsigned a = (tb + qlo + row) * DM + h * 128 + ch * 8;
        const u32x4 y = yv[i], s = sv[i];
        f32x4 r0, r1;
        r0[0] = bflo(y.x) + bflo(s.x) * bflo(ov.x); r0[1] = bfhi(y.x) + bfhi(s.x) * bfhi(ov.x); r0[2] = bflo(y.y) + bflo(s.y) * bflo(ov.y); r0[3] = bfhi(y.y) + bfhi(s.y) * bfhi(ov.y);
        r1[0] = bflo(y.z) + bflo(s.z) * bflo(ov.z); r1[1] = bfhi(y.z) + bfhi(s.z) * bfhi(ov.z); r1[2] = bflo(y.w) + bflo(s.w) * bflo(ov.w); r1[3] = bfhi(y.w) + bfhi(s.w) * bfhi(ov.w);
        if (!dry) store8f8((unsigned char*)MRG + (WS_MQ - WS_YAG) + a, r0, r1); }
    __syncthreads();
}
#undef KSWZ
#undef KRSWZ
#undef SBAR
}

__device__ __forceinline__ void phase_attn(const Params& P, const Ctx& C, bool dry) {
    unsigned char* ws = C.ws;
    const bf16_t* KV = (const bf16_t*)(ws + WS_KVRAW); const bf16_t* KPE = (const bf16_t*)(ws + WS_KPE);
    const bf16_t* SBG = (const bf16_t*)(ws + WS_SB); bf16_t* MRG = (bf16_t*)(ws + WS_YAG);
    for (int item = C.vcu; item < NB * NH * 4; item += C.G) {
        const int grp = item >> 5, c = item & 31;
#pragma unroll 1
        for (int pass = 0; pass < 2; ++pass) { const int bh = grp * 8 + pass * 4 + (c >> 3), j = pass ? 7 - (c & 7) : (c & 7), b = bh >> 3;
            att::attn_block(b, bh & 7, j, (const bf16_t*)(ws + q_off(b)), KV, KPE, SBG, MRG, (LAS char*)C.lds, dry); }
    }
}
__device__ __forceinline__ void phase_router(const Params& P, const Ctx& C, bool dry) {
    unsigned char* ws = C.ws; const int lane = C.lane, w = C.wave;
    const bf16_t* x1 = (const bf16_t*)P.out; const bf16_t* wrh = (const bf16_t*)(ws + WS_WRH); const bf16_t* wrl = (const bf16_t*)(ws + WS_WRL);
    float* rstd2 = (float*)(ws + WS_RSTD2); int* tok_e = (int*)(ws + WS_TOKE); float* tok_w = (float*)(ws + WS_TOKW);
    unsigned* cnt = (unsigned*)(ws + WS_CTL) + CW_CNT;
    const float br = P.in[I_BR][lane];
    LAS float* Lp = (LAS float*)C.lds;
    LAS float* Sq = (LAS float*)(C.lds + PART_OFF);
    LAS unsigned* lcnt = (LAS unsigned*)(Sq + 512);
    LAS unsigned* lbase = lcnt + 64;
    LAS int* lte = (LAS int*)(lbase + 64);
    const int r16 = lane & 15, q = lane >> 4;
    for (int base = C.vcu * 4; base < T_ / 16; base += C.G * 4) {
        const int t0 = base * 16;
        if (C.tid < 64) lcnt[C.tid] = 0u;
        f32x4 acc[4][4];
#pragma unroll
        for (int tk = 0; tk < 4; ++tk)
#pragma unroll
            for (int nt = 0; nt < 4; ++nt) acc[tk][nt] = (f32x4){0.f, 0.f, 0.f, 0.f};
        float ssq[4] = {0.f, 0.f, 0.f, 0.f};
        const bf16_t* xp = x1 + (size_t)(t0 + r16) * DM + w * 128 + q * 8;
        unsigned wo = (unsigned)(r16 * DM + w * 128 + q * 8); asm volatile("" : "+v"(wo));
        u32x4 av[4][4];
#pragma unroll
        for (int tk = 0; tk < 4; ++tk)
#pragma unroll
            for (int ks = 0; ks < 4; ++ks) av[tk][ks] = *(const u32x4*)(xp + tk * 16 * DM + ks * 32);
        asm volatile("" ::: "memory");
        bf16x8 bh[2][4], bl[2][4];
#pragma unroll
        for (int nt = 0; nt < 4; ++nt) { bh[0][nt] = *(const bf16x8*)(wrh + wo + nt * 16 * DM); bl[0][nt] = *(const bf16x8*)(wrl + wo + nt * 16 * DM); }
#pragma unroll
        for (int ks = 0; ks < 4; ++ks) {
            if (ks + 1 < 4) {
#pragma unroll
                for (int nt = 0; nt < 4; ++nt) { bh[(ks + 1) & 1][nt] = *(const bf16x8*)(wrh + wo + nt * 16 * DM + (ks + 1) * 32); bl[(ks + 1) & 1][nt] = *(const bf16x8*)(wrl + wo + nt * 16 * DM + (ks + 1) * 32); } }
#pragma unroll
            for (int tk = 0; tk < 4; ++tk) { const u32x4 hw = av[tk][ks];
                { const float f0 = bflo(hw.x), f1 = bfhi(hw.x), f2 = bflo(hw.y), f3 = bfhi(hw.y), f4 = bflo(hw.z), f5 = bfhi(hw.z), f6 = bflo(hw.w), f7 = bfhi(hw.w);
                  ssq[tk] += (f0 * f0 + f1 * f1) + (f2 * f2 + f3 * f3) + (f4 * f4 + f5 * f5) + (f6 * f6 + f7 * f7); }
                const bf16x8 ah = __builtin_bit_cast(bf16x8, hw);
#pragma unroll
                for (int nt = 0; nt < 4; ++nt) { acc[tk][nt] = __builtin_amdgcn_mfma_f32_16x16x32_bf16(ah, bh[ks & 1][nt], acc[tk][nt], 0, 0, 0); acc[tk][nt] = __builtin_amdgcn_mfma_f32_16x16x32_bf16(ah, bl[ks & 1][nt], acc[tk][nt], 0, 0, 0); } }
            asm volatile("" ::: "memory");
        }
        LAS float* lp = Lp + w * 64 * 64;
#pragma unroll
        for (int tk = 0; tk < 4; ++tk) { float s = ssq[tk]; s = rows4_sum(s); if (q == 0) Sq[w * 64 + tk * 16 + r16] = s;
#pragma unroll
            for (int nt = 0; nt < 4; ++nt)
#pragma unroll
                for (int r = 0; r < 4; ++r) lp[(tk * 16 + 4 * q + r) * 64 + nt * 16 + r16] = acc[tk][nt][r]; }
        __syncthreads();
#pragma unroll 1
        for (int tt = 0; tt < 8; ++tt) {
            const int tok = w * 8 + tt, m = t0 + tok;
            float s = 0.f, lg = 0.f;
#pragma unroll
            for (int k8 = 0; k8 < 8; ++k8) { s += Sq[k8 * 64 + tok]; lg += Lp[(k8 * 64 + tok) * 64 + lane]; }
            const float rs = 1.0f / sqrtf(s * (1.0f / DM) + NORM_EPS);
            const float logit = lg * rs;
            const float score = __builtin_amdgcn_rcpf(1.0f + __builtin_amdgcn_exp2f(-1.4426950408889634f * logit)); const float sel = score + br;
            float m1 = sel, m2 = -__builtin_inff();
#define RT_MERGE(CTRL) { const float p1 = dppf<CTRL>(m1), p2 = dppf<CTRL>(m2); const float hi1 = fmaxf(m1, p1), lo1 = fminf(m1, p1); m2 = fmaxf(lo1, fmaxf(m2, p2)); m1 = hi1; }
            RT_MERGE(0xB1) RT_MERGE(0x4E) RT_MERGE(0x141)
#undef RT_MERGE
            const float gs = m1 + m2;
            int grank = 0; const int mygrp = lane >> 3;
#pragma unroll
            for (int g = 0; g < 8; ++g) { const float og = __builtin_bit_cast(float, __builtin_amdgcn_readlane(__builtin_bit_cast(int, gs), g * 8)); grank += (og > gs || (og == gs && g < mygrp)) ? 1 : 0; }
            const float msel = grank < 4 ? sel : -__builtin_inff();
            unsigned key = __float_as_uint(msel); key ^= (unsigned)((int)key >> 31) | 0x80000000u;
            unsigned thr = 0u;
#pragma unroll
            for (int b = 31; b >= 0; --b) { const unsigned cand = thr | (1u << b); if (__popcll(__ballot(key >= cand)) >= 8) thr = cand; }
            const unsigned long long gm = __ballot(key > thr); unsigned long long em = __ballot(key == thr);
            const int need = 8 - __popcll(gm);
            while (__popcll(em) > need) em &= ~(1ull << (63 - __builtin_clzll(em)));
            const unsigned long long cm = gm | em;
            const bool chosen = (cm >> lane) & 1ull;
            const int rank = __popcll(cm & ((1ull << lane) - 1ull));
            const float wsum = wave_sum_dpp(chosen ? score : 0.f);
            if (lane == 0 && !dry) rstd2[m] = rs;
            unsigned lpos = 0u; if (chosen) lpos = __hip_atomic_fetch_add(lcnt + lane, 1u, __ATOMIC_RELAXED, __HIP_MEMORY_SCOPE_WORKGROUP);
            if (chosen) lte[tok * 8 + rank] = lane | ((int)lpos << 8);
            if (chosen && !dry) tok_w[m * 8 + rank] = score * __builtin_amdgcn_rcpf(wsum) * 2.5f;
        }
        __syncthreads();
        if (C.tid < 64 && !dry) { const unsigned c = lcnt[C.tid]; lbase[C.tid] = c ? __hip_atomic_fetch_add(cnt + 32 * C.tid, c, __ATOMIC_RELAXED, __HIP_MEMORY_SCOPE_AGENT) : 0u; }
        __syncthreads();
        if (!dry) { const int tb0 = base * 16;
            const int v = lte[C.tid]; const int e = v & 255; tok_e[tb0 * 8 + C.tid] = e | ((int)(lbase[e] + (unsigned)(v >> 8)) << 8); }
        __syncthreads();
    }
}
__device__ __forceinline__ void phase_lists(const Params& P, const Ctx& C) {
    unsigned char* ws = C.ws; const int tid = C.tid;
    LAS int* offs = (LAS int*)C.lds;
    LAS int* coff = offs + 80;
    unsigned* ctl = (unsigned*)(ws + WS_CTL); const unsigned* cnt = ctl + CW_CNT;
    u32x4* ent = (u32x4*)(ws + WS_ENT); int* tile_list = (int*)(ws + WS_TILEL); int* inv = (int*)(ws + WS_INV);
    const int* tok_e = (const int*)(ws + WS_TOKE); const float* tok_w = (const float*)(ws + WS_TOKW); const float* rstd2 = (const float*)(ws + WS_RSTD2);
    const int gt0 = C.vcu * NTHREADS + tid; int pv = 0; float pw = 0.f, pr = 0.f;
    if (gt0 < T_ * 8) { pv = tok_e[gt0]; pw = tok_w[gt0]; pr = rstd2[gt0 >> 3]; }
    if (tid < 64) { const int c = (int)__hip_atomic_load(cnt + 32 * tid, __ATOMIC_RELAXED, __HIP_MEMORY_SCOPE_AGENT); const int pc = (c + 255) & ~255;
        int po = pc, co = c;
#pragma unroll
        for (int d = 1; d < 64; d <<= 1) { const int a = __shfl_up(po, d), b = __shfl_up(co, d); if (tid >= d) { po += a; co += b; } }
        offs[tid] = po - pc; coff[tid] = co - c;
        if (C.vcu == 0) { ctl[CW_LSH + tid] = (unsigned)((po - pc) - (co - c)); ctl[CW_LSH + 128 + tid] = (unsigned)(po - pc + c); }
        if (tid == 63) { offs[64] = po; coff[64] = co; offs[65] = po + T_; coff[65] = co + T_;
            if (C.vcu == 0) { ctl[CW_LSH + 64] = (unsigned)(po - co); ctl[CW_LSH + 128 + 64] = (unsigned)(po + T_); } } }
    __syncthreads();
    const int gt = C.vcu * NTHREADS + tid, NT = C.G * NTHREADS;
    for (int i = gt; i < T_ * 8; i += NT) { const bool first = (i == gt0); const int m = i >> 3, k = i & 7, v = first ? pv : tok_e[i], e = v & 255;
        const int pos = v >> 8, idx = offs[e] + pos;
        u32x4 en; en.x = (unsigned)m; en.y = 0u; en.z = __float_as_uint(first ? pw : tok_w[i]); en.w = __float_as_uint(first ? pr : rstd2[m]); ent[idx] = en; inv[m * 9 + k] = coff[e] + pos; }
    for (int m = gt; m < T_; m += NT) { u32x4 en; en.x = (unsigned)m; en.y = 0u; en.z = __float_as_uint(1.0f); en.w = __float_as_uint(rstd2[m]); ent[offs[64] + m] = en; inv[m * 9 + 8] = coff[64] + m; }
    for (int e = C.vcu; e < NEXP; e += C.G) { const int c = (int)__hip_atomic_load(cnt + 32 * e, __ATOMIC_RELAXED, __HIP_MEMORY_SCOPE_AGENT);
        for (int i = offs[e] + c + tid; i < offs[e + 1]; i += NTHREADS) { u32x4 en; en.x = 0u; en.y = 0xffffffffu; en.z = 0u; en.w = 0u; ent[i] = en; } }
    const int ntiles = offs[NLIST] >> 8;
    for (int rt = gt; rt < ntiles; rt += NT) { int li = 0;
        for (int e = 0; e < NLIST; ++e) if (rt * 256 >= offs[e]) li = e;
        tile_list[rt] = li; }
    if (gt == 0) { ctl[CW_FILL + 80] = (unsigned)ntiles; ctl[CW_FILL + 81] = (unsigned)offs[64]; }
    __syncthreads();
}
__device__ __forceinline__ void phase_combine(const Params& P, const Ctx& C) {
    const int gw = C.vcu * NWAVES + C.wave, NGW = C.G * NWAVES, lane = C.lane;
    const unsigned char* ybuf = (const unsigned char*)(C.ws + WS_YBUF); float* out = P.out;
    bf16_t* x2b = (bf16_t*)(C.ws + WS_X2B); float* rstd3 = (float*)(C.ws + WS_RSTD3); const int* inv = (const int*)(C.ws + WS_INV);
#pragma unroll 2
    for (int m = gw; m < T_; m += NGW) {
        const u32x4* xp = (const u32x4*)((const bf16_t*)out + (size_t)m * DM + lane * 16); const u32x4 x0 = __builtin_nontemporal_load(xp), x1v = __builtin_nontemporal_load(xp + 1);
        f32x4 a[4];
        a[0] = (f32x4){bflo(x0.x), bfhi(x0.x), bflo(x0.y), bfhi(x0.y)}; a[1] = (f32x4){bflo(x0.z), bfhi(x0.z), bflo(x0.w), bfhi(x0.w)};
        a[2] = (f32x4){bflo(x1v.x), bfhi(x1v.x), bflo(x1v.y), bfhi(x1v.y)}; a[3] = (f32x4){bflo(x1v.z), bfhi(x1v.z), bflo(x1v.w), bfhi(x1v.w)};
#pragma unroll
        for (int j = 0; j < 4; ++j) a[j] = a[j] * (float)(1 << F8K_WD);
        const int iv = inv[m * 9 + (lane < 9 ? lane : 0)];
#pragma unroll
        for (int k = 0; k < 9; ++k) { const unsigned yr = (unsigned)__builtin_amdgcn_readlane(iv, k); const u32x4 w = __builtin_nontemporal_load((const u32x4*)(ybuf + (size_t)yr * DM + lane * 16));
#pragma unroll
            for (int j = 0; j < 4; ++j) { const f32x2 lo = __builtin_amdgcn_cvt_pk_f32_fp8((int)w[j], false), hi = __builtin_amdgcn_cvt_pk_f32_fp8((int)w[j], true);
                a[j][0] += lo.x; a[j][1] += lo.y; a[j][2] += hi.x; a[j][3] += hi.y; } }
        float s = 0.f;
#pragma unroll
        for (int j = 0; j < 4; ++j) a[j] = a[j] * (1.0f / (float)(1 << F8K_WD));
#pragma unroll
        for (int j = 0; j < 4; ++j) s += (a[j][0] * a[j][0] + a[j][1] * a[j][1]) + (a[j][2] * a[j][2] + a[j][3] * a[j][3]);
        s = wave_sum(s);
        store8bf(x2b + (size_t)m * DM + lane * 16, a[0], a[1]); store8bf(x2b + (size_t)m * DM + lane * 16 + 8, a[2], a[3]);
        { unsigned char* xq = C.ws + WS_X2Q + (size_t)m * DM + lane * 16; store8f8(xq, a[0], a[1]); store8f8(xq + 8, a[2], a[3]); }
        if (lane == 0) rstd3[m] = 1.0f / sqrtf(s * (1.0f / DM) + NORM_EPS);
    }
}
#define XB_TMO      128
#define XB_XCNT(j)  (256  + 64 * (j))
#define XB_XSUB(j)  (1280 + 64 * (j))
#define XB_XGEN(j)  (2304 + 64 * (j))
#define XB_TOP      3328
#define XB_TOPGEN   3392
#define XCD_BAR_WORDS 3456
#define XB_SPIN_CAP (1u << 20)
__device__ __forceinline__ unsigned xb_ld(unsigned* p)              { return __hip_atomic_load(p, __ATOMIC_RELAXED, __HIP_MEMORY_SCOPE_AGENT); }
__device__ __forceinline__ unsigned xb_add(unsigned* p, unsigned v) { return __hip_atomic_fetch_add(p, v, __ATOMIC_RELAXED, __HIP_MEMORY_SCOPE_AGENT); }
__device__ __forceinline__ unsigned xb_xcc_id() { return (unsigned)__builtin_amdgcn_s_getreg((3 << 11) | 20) & 0xFu; }
#define XB_SPIN(cond, bar) do { unsigned _sp = 0; while (cond) { __builtin_amdgcn_s_sleep(1); \
    if ((++_sp & 255u) == 0u) { if (xb_ld(&(bar)[XB_TMO])) break; if (_sp > XB_SPIN_CAP) { atomicAdd(&(bar)[XB_TMO], 1u); break; } } } } while (0)
struct XcdBarrier { unsigned* bar; unsigned x; volatile LAS unsigned* st; };
__device__ __forceinline__ XcdBarrier xcd_barrier_post(unsigned* bar, volatile LAS unsigned* st) {
    XcdBarrier b; b.bar = bar; b.x = xb_xcc_id(); b.st = st;
    if (threadIdx.x == 0) (void)xb_add(&bar[XB_XCNT(b.x)], 1u);
    return b;
}
__device__ __forceinline__ void xcd_barrier_complete(unsigned* bar, unsigned x, unsigned& nloc, unsigned& nx) {
    const unsigned G = gridDim.x * gridDim.y * gridDim.z;
    unsigned sum, cnt, mine, sp = 0u;
    for (;;) {
        sum = 0u; cnt = 0u; mine = 0u;
#pragma unroll
        for (unsigned j = 0; j < 16; ++j) { const unsigned c = xb_ld(&bar[XB_XCNT(j)]); sum += c; cnt += (c > 0u) ? 1u : 0u; mine = (j == x) ? c : mine; }
        if (sum == G) break;
        __builtin_amdgcn_s_sleep(1);
        if ((++sp & 255u) == 0u) { if (xb_ld(&bar[XB_TMO])) break; if (sp > XB_SPIN_CAP) { atomicAdd(&bar[XB_TMO], 1u); break; } }
    }
    nloc = mine > 0u ? mine : 1u; nx = cnt > 0u ? cnt : 1u;
}
__device__ __forceinline__ void xcd_barrier(const XcdBarrier& b) {
    asm volatile("s_waitcnt vmcnt(0)" ::: "memory");
    __syncthreads();
    if (threadIdx.x == 0) {
        unsigned* bar = b.bar;
        __builtin_amdgcn_s_waitcnt(0);
        unsigned nloc = b.st[0], nx = b.st[1];
        if (nloc == 0u) { xcd_barrier_complete(bar, b.x, nloc, nx); b.st[0] = nloc; b.st[1] = nx; }
        const unsigned old = xb_add(&bar[XB_XSUB(b.x)], 1u);
        const unsigned gen = old / nloc;
        if (old + 1u == (gen + 1u) * nloc) {
            __builtin_amdgcn_fence(__ATOMIC_RELEASE, "agent");
            asm volatile("s_waitcnt vmcnt(0)" ::: "memory");
            (void)xb_add(&bar[XB_TOP], 1u);
        }
        const unsigned target = (gen + 1u) * nx;
        XB_SPIN(xb_ld(&bar[XB_TOP]) < target, bar);
        __builtin_amdgcn_fence(__ATOMIC_ACQUIRE, "agent");
        asm volatile("s_waitcnt vmcnt(0)" ::: "memory");
    }
    __syncthreads();
}

constexpr int RING_BYTES = 131072, MISC_OFF = RING_BYTES + 320, LDS_BYTES = 147456;
constexpr int N_PHASES = 12;
#ifndef MK_N_LAUNCHES
#define MK_N_LAUNCHES 1
#endif
struct Args { Params P; int ph_lo, ph_hi; };

__global__ void __launch_bounds__(NTHREADS, 2) fwd_kernel(Args args) {
    extern __shared__ __attribute__((aligned(16))) unsigned char lds_raw[];
    Ctx C; C.lds = (LAS unsigned char*)lds_raw; C.ws = args.P.ws; C.tid = threadIdx.x; C.lane = C.tid & 63; C.wave = __builtin_amdgcn_readfirstlane(C.tid >> 6);
    C.G = gridDim.x; C.vcu = vcu_of(blockIdx.x, C.G);
    const Params& P = args.P;
    unsigned char* ws = C.ws;
    volatile LAS unsigned* MISC = (volatile LAS unsigned*)(C.lds + MISC_OFF);
    for (int u = C.tid; u < (LDS_BYTES - RING_BYTES) / 4; u += NTHREADS) ((LAS unsigned*)(C.lds + RING_BYTES))[u] = 0u;
    __syncthreads();
    const int lo = args.ph_lo, hi = args.ph_hi;
    XcdBarrier bar; bar.bar = (unsigned*)(ws + WS_CTL) + CW_BAR; bar.x = 0; bar.st = nullptr;
    if (hi - lo > 1) bar = xcd_barrier_post((unsigned*)(ws + WS_CTL) + CW_BAR, MISC + 8);
#ifdef ONLY_PHASE
#define IN(k) ((k) == ONLY_PHASE && lo <= (k) && (k) < hi)
#else
#define IN(k) (lo <= (k) && (k) < hi)
#endif
#ifdef REPEAT_PHASE
#define NREP(k) ((k) == REPEAT_PHASE ? 2 : 1)
#else
#define NREP(k) 1
#endif
#ifdef CLOCK_PHASE
    unsigned long long ck_c0 = 0, ck_c1 = 0, ck_r0 = 0, ck_r1 = 0;
#define CK_END(k) do { if ((k) == CLOCK_PHASE) { ck_c1 = __builtin_amdgcn_s_memtime(); ck_r1 = __builtin_amdgcn_s_memrealtime(); } } while (0)
#define CK_START(k) do { if ((k) == CLOCK_PHASE) { ck_c0 = __builtin_amdgcn_s_memtime(); ck_r0 = __builtin_amdgcn_s_memrealtime(); } } while (0)
#else
#define CK_END(k) do {} while (0)
#define CK_START(k) do {} while (0)
#endif
#ifdef DILATE_PHASE
    unsigned long long dl_t0 = 0, dl_t1 = 0;
#define DL_MARK(k) do { if ((k) == DILATE_PHASE || (DILATE_PHASE == 99 && (k) == 0)) dl_t0 = __builtin_amdgcn_s_memrealtime(); if ((k) == DILATE_PHASE + 1 || (DILATE_PHASE == 99 && (k) == 12)) dl_t1 = __builtin_amdgcn_s_memrealtime(); } while (0)
#else
#define DL_MARK(k) do {} while (0)
#endif
#define SEAM(k) do { CK_END(k); if (IN(k) && IN((k) + 1)) xcd_barrier(bar); DL_MARK((k) + 1); CK_START((k) + 1); } while (0)
    DL_MARK(0);
    if (IN(0)) { phase_prep0(P, C); } SEAM(0);
    if (IN(1)) {
        DenseSched S{(const char*)(ws + WS_XB), (const char*)(ws + WS_WIN), T_ / 256, NZ / 256, C.G, C.vcu, DM * 2, DM * 2};
        EpiG1 E{ws};
        pg8::gemm_phase<EpiG1, DenseSched, false>(C.lds, pg8::Shape{DM * 2, DM * 2, DM / 64, nullptr}, S, E);
        { const int rem = ((T_ / 256) * (NZ / 256)) % C.G; if (rem == 0) prep_rest(P, C, C.vcu, C.G); else if (C.vcu >= rem) prep_rest(P, C, C.vcu - rem, C.G - rem); }
    } SEAM(1);
    if (IN(2)) { kpe_rows(P, C); phase_sgu(P, C); } CK_END(2); DL_MARK(3); CK_START(3);
    if (IN(3)) {
        const int hg = C.G / 2;
        if (C.vcu < hg) { DenseSched S{(const char*)(ws + WS_LAT) + 256 * 2, (const char*)(ws + WS_WQB), T_ / 256, QW / 256, hg, C.vcu, LATW * 2, QLAT * 2};
          EpiQ E{ws, C.lds, P.in[I_GQN], P.in[I_GQR]};
          pg8::gemm_phase<EpiQ, DenseSched, false>(C.lds, pg8::Shape{LATW * 2, QLAT * 2, QLAT / 64, nullptr}, S, E); }
        else { DenseSched S{(const char*)(ws + WS_LAT), (const char*)(ws + WS_WKVB), T_ / 256, KVW / 256, C.G - hg, C.vcu - hg, LATW * 2, KVLAT * 2};
          EpiKV E{ws, C.lds, P.in[I_GKN]};
          pg8::gemm_phase<EpiKV, DenseSched, false>(C.lds, pg8::Shape{LATW * 2, KVLAT * 2, KVLAT / 64, nullptr}, S, E); }
    } SEAM(3);
    if (IN(4)) { phase_attn(P, C, false); } SEAM(4);
    if (IN(5)) {
        DenseSched S{(const char*)(ws + WS_MQ), (const char*)(ws + WS_WO), T_ / 256, DM / 256, C.G, C.vcu, DM, DM};
        EpiG4 E{P.in[I_X], (bf16_t*)P.out, ws + WS_X1F8};
        pg8::gemm_phase<EpiG4, DenseSched, false, true>(C.lds, pg8::Shape{DM, DM, DM / 128, nullptr}, S, E);
    } SEAM(5);
    if (IN(6)) {
        if (C.vcu & 1) { phase_prep_wgu(P, C); __syncthreads(); phase_router(P, C, false); }
        else { phase_router(P, C, false); __syncthreads(); phase_prep_wgu(P, C); }
    } SEAM(6);
    if (IN(7)) { phase_lists(P, C); } SEAM(7);
    const unsigned* ctl = (const unsigned*)(ws + WS_CTL);
    if (IN(8)) {
        const int tlv0 = ((const int*)(ws + WS_TILEL))[C.tid], tlv1 = (C.tid + NTHREADS < LIST_CAP / 256) ? ((const int*)(ws + WS_TILEL))[C.tid + NTHREADS] : 0;
        const int ntiles = (int)__hip_atomic_load(ctl + CW_FILL + 80, __ATOMIC_RELAXED, __HIP_MEMORY_SCOPE_AGENT), off64 = (int)__hip_atomic_load(ctl + CW_FILL + 81, __ATOMIC_RELAXED, __HIP_MEMORY_SCOPE_AGENT);
        LAS int* tl = (LAS int*)(C.lds + PART_OFF); tl[C.tid] = tlv0; if (C.tid + NTHREADS < LIST_CAP / 256) tl[C.tid + NTHREADS] = tlv1; __syncthreads();
        MoeGuSched S{ws, tl, ntiles, C.G, C.vcu};
        EpiGu E{ws, off64};
        pg8::gemm_phase<EpiGu, MoeGuSched, true, true>(C.lds, pg8::Shape{DM, DM, DM / 128, (const char*)(ws + WS_X1F8)}, S, E);
        __syncthreads(); phase_prep_wd(P, C, (2 * ntiles) % C.G);
    } SEAM(8);
    if (IN(9)) {
        const int tlv0 = ((const int*)(ws + WS_TILEL))[C.tid], tlv1 = (C.tid + NTHREADS < LIST_CAP / 256) ? ((const int*)(ws + WS_TILEL))[C.tid + NTHREADS] : 0;
        const int ntiles = (int)__hip_atomic_load(ctl + CW_FILL + 80, __ATOMIC_RELAXED, __HIP_MEMORY_SCOPE_AGENT), off64 = (int)__hip_atomic_load(ctl + CW_FILL + 81, __ATOMIC_RELAXED, __HIP_MEMORY_SCOPE_AGENT);
        LAS int* tl = (LAS int*)(C.lds + PART_OFF); tl[C.tid] = tlv0; if (C.tid + NTHREADS < LIST_CAP / 256) tl[C.tid + NTHREADS] = tlv1; __syncthreads();
        LAS int* lsh = tl + 1024; if (C.tid < 65) { lsh[C.tid] = (int)ctl[CW_LSH + C.tid]; lsh[128 + C.tid] = (int)ctl[CW_LSH + 128 + C.tid]; } __syncthreads();
        MoeDownSched S{ws, tl, ntiles, C.G, C.vcu, off64};
        EpiDown E{ws, lsh};
        pg8::gemm_phase<EpiDown, MoeDownSched, false, true, true>(C.lds, pg8::Shape{EFF, EFF, EFF / 128, nullptr}, S, E);
        prep_pb(P, C);
    } SEAM(9);
    if (IN(10)) {
        phase_combine(P, C);
        DenseSched S{(const char*)(ws + WS_PB), (const char*)(ws + WS_WPP), T_ / 256, DM / 256, C.G, C.vcu, PLE * 2, PLE * 2};
        EpiG6 E{(bf16_t*)(ws + WS_PERAW), (float*)(ws + WS_PESTAT)};
        pg8::gemm_phase<EpiG6, DenseSched, false>(C.lds, pg8::Shape{PLE * 2, PLE * 2, PLE / 64, nullptr}, S, E);
    } SEAM(10);
    if (IN(11)) {
        DenseSched S{(const char*)(ws + WS_X2Q), (const char*)(ws + WS_WPG), T_ / 256, DM / 256, C.G, C.vcu, DM, DM};
        EpiG5 E{P.out, (const bf16_t*)(ws + WS_PERAW), (const bf16_t*)(ws + WS_X2B), (const float*)(ws + WS_RSTD3), (const float*)(ws + WS_PESTAT), P.in[I_GPO]};
        pg8::gemm_phase<EpiG5, DenseSched, false, true>(C.lds, pg8::Shape{DM, DM, DM / 128, nullptr}, S, E);
    }
#ifdef CLOCK_PHASE
    CK_END(11);
    { const unsigned long long mhz = (ck_c1 - ck_c0) * 100ull / (ck_r1 - ck_r0 + 1ull); const unsigned long long d = mhz * 10ull, s0 = __builtin_amdgcn_s_memrealtime(); while (__builtin_amdgcn_s_memrealtime() - s0 < d) __builtin_amdgcn_s_sleep(8); }
#endif
#ifdef EXTRA_BARRIERS
    for (int eb = 0; eb < EXTRA_BARRIERS; ++eb) xcd_barrier(bar);
#endif
#ifdef SPIN_US
    { const unsigned long long s0 = __builtin_amdgcn_s_memrealtime(); while (__builtin_amdgcn_s_memrealtime() - s0 < (unsigned long long)(SPIN_US) * 100ull) __builtin_amdgcn_s_sleep(8); }
#endif
#ifdef DILATE_PHASE
    DL_MARK(12);
    { const unsigned long long d = dl_t1 - dl_t0, s0 = __builtin_amdgcn_s_memrealtime(); while (__builtin_amdgcn_s_memrealtime() - s0 < d) __builtin_amdgcn_s_sleep(8); }
#endif
#undef IN
#undef SEAM
}

extern "C" void kernel_launch(void* const* d_in, const int* in_sizes, int n_in, void* d_out, int out_size, void* d_ws, size_t ws_size, hipStream_t stream) {
    static int grid = 0;
    if (grid == 0) {
        if (n_in != 31 || in_sizes[0] != T_ * DM || out_size != T_ * DM || ws_size < WS_END) { fprintf(stderr, "kernel_launch: unexpected shapes (n_in %d, in0 %d, out %d, ws %zu, need %zu)\n", n_in, n_in > 0 ? in_sizes[0] : -1, out_size, ws_size, (size_t)WS_END); grid = -1; return; }
        int dev = 0, cus = 0;
        if (hipGetDevice(&dev) != hipSuccess || hipDeviceGetAttribute(&cus, hipDeviceAttributeMultiprocessorCount, dev) != hipSuccess) { grid = -1; return; }
        if (hipFuncSetAttribute((const void*)fwd_kernel, hipFuncAttributeMaxDynamicSharedMemorySize, LDS_BYTES) != hipSuccess) { fprintf(stderr, "kernel_launch: hipFuncSetAttribute failed\n"); grid = -1; return; }
        grid = cus;
    }
    if (grid < 0) return;
    (void)hipMemsetAsync((char*)d_ws + WS_CTL, 0, CTL_BYTES, stream);
    Args a{};
    for (int i = 0; i < 31; ++i) a.P.in[i] = (const float*)d_in[i];
    a.P.out = (float*)d_out; a.P.ws = (unsigned char*)d_ws;
    constexpr int NL = MK_N_LAUNCHES;
    for (int li = 0; li < NL; ++li) {
        a.ph_lo = (NL == N_PHASES) ? li : (li * N_PHASES) / NL; a.ph_hi = (NL == N_PHASES) ? li + 1 : ((li + 1) * N_PHASES) / NL;
        hipLaunchKernelGGL(fwd_kernel, dim3(grid), dim3(NTHREADS), LDS_BYTES, stream, a);
    }
}
```
